# Optimizing an MI355X kernel written in HIP

```python
import math
import jax
import jax.numpy as jnp
from jax import lax
import numpy as np

D_MODEL = 1024
BATCH = 16
SEQ = 4096
DEPTH = 4

GRID_W = 64
CTX_LEN = 256
N_MIXERS = 3
NORM_EPS = 1e-6
ROPE_BASE = 10000.0
QBLOCK = 128
DA_HEAD = 64
DA_HEADS = D_MODEL // (2 * DA_HEAD)
WA_HEAD = 64
WA_Q_HEADS = D_MODEL // WA_HEAD
WA_KV_HEADS = WA_Q_HEADS // 4
WINDOW = 128
RET_KEY = 256
RET_HEADS = D_MODEL // RET_KEY
RET_VAL = 2 * RET_KEY
RET_CHUNK = 128
FFN_DIM = ((8 * D_MODEL // 3 + 255) // 256) * 256
N_EXPERTS = 8
TOP_K = 2
EXPERT_DIM = 7 * D_MODEL // 2
MOE_BLOCK = 256

kernel_name = 'hybrid_dit_diffattn_swa_retention_moe'


def rms_norm(x, g):
    x32 = x.astype(jnp.float32)
    y = x32 * lax.rsqrt(jnp.mean(x32 * x32, axis=-1, keepdims=True) + NORM_EPS)
    return (y * g.astype(jnp.float32)).astype(x.dtype)


def modulate(x, g, shift, scale):
    return rms_norm(x, g) * (1 + scale) + shift


def grid_positions(n_tokens):
    rows = n_tokens // GRID_W
    row = jnp.repeat(jnp.arange(rows, dtype=jnp.int32), GRID_W)
    col = jnp.tile(jnp.arange(GRID_W, dtype=jnp.int32), rows)
    return row, col


def rope_angles(pos, dim):
    inv = ROPE_BASE ** (-jnp.arange(0, dim, 2, dtype=jnp.float32) / dim)
    ang = pos.astype(jnp.float32)[:, None] * inv[None, :]
    return jnp.concatenate([ang, ang], axis=-1)


def apply_rotary(x, ang):
    shape = (1, x.shape[1]) + (1,) * (x.ndim - 3) + (x.shape[-1],)
    cos = jnp.cos(ang).reshape(shape).astype(x.dtype)
    sin = jnp.sin(ang).reshape(shape).astype(x.dtype)
    x1, x2 = jnp.split(x, 2, axis=-1)
    return x * cos + jnp.concatenate([-x2, x1], axis=-1) * sin


def axial_rotary(x, row, col):
    half = x.shape[-1] // 2
    return jnp.concatenate([apply_rotary(x[..., :half], rope_angles(row, half)),
                            apply_rotary(x[..., half:], rope_angles(col, half))], axis=-1)


def swiglu(h, w_gu, w_down):
    g, u = jnp.split(h @ w_gu, 2, axis=-1)
    return (jax.nn.silu(g) * u) @ w_down


def diff_attend(q, k, v, lam):
    s = jnp.einsum('bqhmd,bkhmd->bhmqk', q, k).astype(jnp.float32) * (q.shape[-1] ** -0.5)
    p = jax.nn.softmax(s, axis=-1)
    a = p[:, :, 0] - lam * p[:, :, 1]
    return jnp.einsum('bhqk,bkhe->bqhe', a.astype(v.dtype), v)


def diff_attention_mixer(a, ac, w_in, w_out, lam_p, subln_g, lam_init, need_ctx):
    B, L, _ = a.shape

    def project(t):
        shp = t.shape[:2]
        q, k, v = jnp.split(t @ w_in, 3, axis=-1)
        return (q.reshape(shp + (DA_HEADS, 2, DA_HEAD)), k.reshape(shp + (DA_HEADS, 2, DA_HEAD)),
                v.reshape(shp + (DA_HEADS, 2 * DA_HEAD)))

    q, k, v = project(a)
    qc, kc, vc = project(ac)
    row, col = grid_positions(L)
    q = axial_rotary(q, row, col)
    k = axial_rotary(k, row, col)
    lp = lam_p.astype(jnp.float32)
    lam = jnp.exp(jnp.sum(lp[0] * lp[1])) - jnp.exp(jnp.sum(lp[2] * lp[3])) + lam_init
    keys = jnp.concatenate([kc, k], axis=1)
    vals = jnp.concatenate([vc, v], axis=1)
    nb = L // QBLOCK
    qb = q.reshape(B, nb, QBLOCK, DA_HEADS, 2, DA_HEAD).swapaxes(0, 1)
    ob = lax.map(lambda qi: diff_attend(qi, keys, vals, lam), qb)
    o = ob.swapaxes(0, 1).reshape(B, L, DA_HEADS, 2 * DA_HEAD)

    def finish(t):
        t = rms_norm(t, subln_g) * (1.0 - lam_init)
        return t.reshape(t.shape[:2] + (D_MODEL,)) @ w_out

    y = finish(o)
    yc = finish(diff_attend(qc, kc, vc, lam)) if need_ctx else None
    return y, yc


def sink_attend(q, k, v, mask, sink):
    s = jnp.einsum('bqgrd,bkgd->bgrqk', q, k).astype(jnp.float32) * (q.shape[-1] ** -0.5)
    if mask is not None:
        s = jnp.where(mask, s, -1e30)
    sink_col = jnp.broadcast_to(sink.astype(jnp.float32).reshape(1, WA_KV_HEADS, -1, 1, 1), s.shape[:-1] + (1,))
    p = jax.nn.softmax(jnp.concatenate([s, sink_col], axis=-1), axis=-1)[..., :-1]
    return jnp.einsum('bgrqk,bkgd->bqgrd', p.astype(v.dtype), v)


def window_gqa_mixer(a, ac, w_in, w_out, sink, need_ctx):
    B, L, _ = a.shape
    rep = WA_Q_HEADS // WA_KV_HEADS

    def project(t):
        shp = t.shape[:2]
        q, k, v = jnp.split(t @ w_in, [WA_Q_HEADS * WA_HEAD, (WA_Q_HEADS + WA_KV_HEADS) * WA_HEAD], axis=-1)
        return (q.reshape(shp + (WA_KV_HEADS, rep, WA_HEAD)), k.reshape(shp + (WA_KV_HEADS, WA_HEAD)),
                v.reshape(shp + (WA_KV_HEADS, WA_HEAD)))

    q, k, v = project(a)
    qc, kc, vc = project(ac)
    row, col = grid_positions(L)
    q = axial_rotary(q, row, col)
    k = axial_rotary(k, row, col)
    pad = ((0, 0), (WINDOW, WINDOW), (0, 0), (0, 0))
    kp = jnp.pad(k, pad)
    vp = jnp.pad(v, pad)
    span = QBLOCK + 2 * WINDOW
    n_ctx = kc.shape[1]
    ctx_ok = jnp.ones((QBLOCK, n_ctx), dtype=bool)

    def block(args):
        qi, i = args
        start = i * QBLOCK
        kw = lax.dynamic_slice_in_dim(kp, start, span, axis=1)
        vw = lax.dynamic_slice_in_dim(vp, start, span, axis=1)
        qpos = start + jnp.arange(QBLOCK)
        kpos = start - WINDOW + jnp.arange(span)
        win = (jnp.abs(qpos[:, None] - kpos[None, :]) <= WINDOW) & (kpos >= 0)[None, :] & (kpos < L)[None, :]
        mask = jnp.concatenate([ctx_ok, win], axis=1)
        return sink_attend(qi, jnp.concatenate([kc, kw], axis=1), jnp.concatenate([vc, vw], axis=1), mask, sink)

    nb = L // QBLOCK
    qb = q.reshape(B, nb, QBLOCK, WA_KV_HEADS, rep, WA_HEAD).swapaxes(0, 1)
    o = lax.map(block, (qb, jnp.arange(nb))).swapaxes(0, 1).reshape(B, L, D_MODEL)
    y = o @ w_out
    yc = sink_attend(qc, kc, vc, None, sink).reshape(B, n_ctx, D_MODEL) @ w_out if need_ctx else None
    return y, yc


def retention_scan(q, k, v, log_g, state0, include_diag):
    B, H, L, _ = q.shape
    dv = v.shape[-1]
    n = L // RET_CHUNK
    idx = jnp.arange(RET_CHUNK, dtype=jnp.float32)
    rel = idx[:, None] - idx[None, :]
    keep = (rel >= 0) if include_diag else (rel > 0)
    lg = log_g[:, None, None]
    intra_decay = jnp.where(keep[None], jnp.exp(jnp.where(keep[None], rel[None] * lg, 0.0)), 0.0)
    q_decay = jnp.exp((idx + 1.0)[None, :] * log_g[:, None])[..., None]
    k_decay = jnp.exp((RET_CHUNK - 1.0 - idx)[None, :] * log_g[:, None])[..., None]
    chunk_decay = jnp.exp(RET_CHUNK * log_g)[:, None, None]

    def to_chunks(t):
        return t.reshape(B, H, n, RET_CHUNK, t.shape[-1]).transpose(2, 0, 1, 3, 4)

    def step(state, xs):
        qi, ki, vi = xs
        inner = jnp.einsum('bhcd,bhmd->bhcm', qi, ki) * intra_decay
        o = jnp.einsum('bhcm,bhmv->bhcv', inner, vi) + jnp.einsum('bhcd,bhdv->bhcv', qi, state) * q_decay
        state = state * chunk_decay + jnp.einsum('bhmd,bhmv->bhdv', ki * k_decay, vi)
        return state, o

    state, o = lax.scan(step, state0, (to_chunks(q), to_chunks(k), to_chunks(v)))
    return o.transpose(1, 2, 0, 3, 4).reshape(B, H, L, dv), state


def retention_mixer(a, ac, w_in, w_out, decay_logit, need_ctx):
    B, L, _ = a.shape
    qk_w = RET_HEADS * RET_KEY
    v_w = RET_HEADS * RET_VAL

    def project(t, pos):
        shp = t.shape[:2]
        q, k, v, g = jnp.split(t @ w_in, [qk_w, 2 * qk_w, 2 * qk_w + v_w], axis=-1)
        q = q.reshape(shp + (RET_HEADS, RET_KEY))
        k = k.reshape(shp + (RET_HEADS, RET_KEY)) * (RET_KEY ** -0.5)
        if pos is not None:
            ang = rope_angles(pos, RET_KEY)
            q = apply_rotary(q, ang)
            k = apply_rotary(k, ang)
        v = v.reshape(shp + (RET_HEADS, RET_VAL))
        heads = lambda t_: t_.transpose(0, 2, 1, 3).astype(jnp.float32)
        return heads(q), heads(k), heads(v), g

    q, k, v, g = project(a, jnp.arange(L))
    qc, kc, vc, gc = project(ac, None)
    log_g = jax.nn.log_sigmoid(decay_logit.astype(jnp.float32))
    zero = jnp.zeros((B, RET_HEADS, RET_KEY, RET_VAL), jnp.float32)
    rev = lambda t: jnp.flip(t, axis=2)
    oc_f, s_f = retention_scan(qc, kc, vc, log_g[0], zero, True)
    oc_b, s_b = retention_scan(rev(qc), rev(kc), rev(vc), log_g[1], zero, False)
    o_f, _ = retention_scan(q, k, v, log_g[0], s_f, True)
    o_b, _ = retention_scan(rev(q), rev(k), rev(v), log_g[1], s_b, False)

    def finish(o, gate):
        o = o * lax.rsqrt(jnp.mean(o * o, axis=-1, keepdims=True) + NORM_EPS)
        o = o.transpose(0, 2, 1, 3).reshape(gate.shape).astype(gate.dtype)
        return (jax.nn.silu(gate) * o) @ w_out

    y = finish(o_f + rev(o_b), g)
    yc = finish(oc_f + rev(oc_b), gc) if need_ctx else None
    return y, yc


def moe_swiglu(h, w_router, w_gu, w_down):
    B, L, D = h.shape
    T = B * L
    xt = h.reshape(T, D)
    logits = (xt @ w_router).astype(jnp.float32)
    top_val, top_idx = lax.top_k(logits, TOP_K)
    gates = jax.nn.softmax(top_val, axis=-1)
    n_assign = T * TOP_K
    flat_e = top_idx.reshape(-1)
    flat_tok = jnp.arange(n_assign) // TOP_K
    order = jnp.argsort(flat_e)
    sorted_e = flat_e[order]
    sorted_tok = flat_tok[order]
    sorted_gate = gates.reshape(-1)[order]
    counts = jnp.bincount(flat_e, length=N_EXPERTS)
    padded = (counts + MOE_BLOCK - 1) // MOE_BLOCK * MOE_BLOCK
    start = jnp.cumsum(counts) - counts
    pstart = jnp.cumsum(padded) - padded
    dest = pstart[sorted_e] + jnp.arange(n_assign) - start[sorted_e]
    n_blocks = -(-n_assign // MOE_BLOCK) + N_EXPERTS
    buf = jnp.zeros((n_blocks * MOE_BLOCK, D), h.dtype).at[dest].set(xt[sorted_tok])
    block_expert = jnp.minimum(jnp.searchsorted(jnp.cumsum(padded), jnp.arange(n_blocks) * MOE_BLOCK, side='right'), N_EXPERTS - 1)

    def run_block(args):
        xb, e = args
        g, u = jnp.split(xb @ w_gu[e], 2, axis=-1)
        return (jax.nn.silu(g) * u) @ w_down[e]

    yb = lax.map(run_block, (buf.reshape(n_blocks, MOE_BLOCK, D), block_expert)).reshape(-1, D)
    y_sorted = yb[dest] * sorted_gate[:, None].astype(h.dtype)
    y = jnp.zeros((T, D), h.dtype).at[sorted_tok].add(y_sorted)
    return y.reshape(B, L, D)


def setup_inputs(seed: int = 0) -> dict:
    key = jax.random.key(seed)
    ks = iter(jax.random.split(key, 32))
    f32 = jnp.float32
    n_da = len(range(0, DEPTH, N_MIXERS))
    n_wa = len(range(1, DEPTH, N_MIXERS))
    n_ret = len(range(2, DEPTH, N_MIXERS))
    n_dense = len(range(0, DEPTH, 2))
    n_moe = len(range(1, DEPTH, 2))

    def normal(shape, scale):
        return jax.random.normal(next(ks), shape, f32) * scale

    def dense(shape, fan_in, gain=1.0):
        return normal(shape, gain * fan_in ** -0.5)

    wa_width = (WA_Q_HEADS + 2 * WA_KV_HEADS) * WA_HEAD
    ret_width = 2 * RET_HEADS * RET_KEY + 2 * RET_HEADS * RET_VAL
    base_logit = jnp.log(jnp.exp2(5.0 + jnp.arange(RET_HEADS, dtype=f32)) - 1.0)
    return {
        'x': normal((BATCH, SEQ, D_MODEL), 1.0),
        'c': normal((BATCH, D_MODEL), 1.0),
        'ctx': normal((BATCH, CTX_LEN, D_MODEL), 1.0),
        'c_ctx': normal((D_MODEL,), 1.0),
        'mod_w': dense((DEPTH, D_MODEL, 6 * D_MODEL), D_MODEL, 0.5),
        'mod_b': normal((DEPTH, 6 * D_MODEL), 0.02),
        'norm_g': 1.0 + normal((DEPTH, 4, D_MODEL), 0.05),
        'da_w_in': dense((n_da, D_MODEL, 3 * D_MODEL), D_MODEL),
        'da_w_out': dense((n_da, D_MODEL, D_MODEL), D_MODEL),
        'da_lambda': normal((n_da, 4, DA_HEAD), 0.1),
        'da_subln_g': 1.0 + normal((n_da, 2 * DA_HEAD), 0.05),
        'wa_w_in': dense((n_wa, D_MODEL, wa_width), D_MODEL),
        'wa_w_out': dense((n_wa, D_MODEL, D_MODEL), D_MODEL),
        'wa_sink': normal((n_wa, WA_Q_HEADS), 1.0),
        'ret_w_in': dense((n_ret, D_MODEL, ret_width), D_MODEL),
        'ret_w_out': dense((n_ret, RET_HEADS * RET_VAL, D_MODEL), RET_HEADS * RET_VAL),
        'ret_decay_logit': base_logit[None, None, :] + normal((n_ret, 2, RET_HEADS), 0.1),
        'ffn_w_gu': dense((n_dense, D_MODEL, 2 * FFN_DIM), D_MODEL),
        'ffn_w_down': dense((n_dense, FFN_DIM, D_MODEL), FFN_DIM),
        'moe_router': dense((n_moe, D_MODEL, N_EXPERTS), D_MODEL),
        'moe_w_gu': dense((n_moe, N_EXPERTS, D_MODEL, 2 * EXPERT_DIM), D_MODEL),
        'moe_w_down': dense((n_moe, N_EXPERTS, EXPERT_DIM, D_MODEL), EXPERT_DIM),
    }


def reference(x, c, ctx, c_ctx, mod_w, mod_b, norm_g, da_w_in, da_w_out, da_lambda, da_subln_g,
              wa_w_in, wa_w_out, wa_sink, ret_w_in, ret_w_out, ret_decay_logit,
              ffn_w_gu, ffn_w_down, moe_router, moe_w_gu, moe_w_down):
    h_ctx = ctx
    mixer_count = [0] * N_MIXERS
    i_dense = 0
    i_moe = 0
    for layer in range(DEPTH):
        last = layer == DEPTH - 1
        mod = (jax.nn.silu(c) @ mod_w[layer] + mod_b[layer])[:, None, :]
        mod_c = (jax.nn.silu(c_ctx) @ mod_w[layer] + mod_b[layer])[None, None, :]
        sh1, sc1, g1, sh2, sc2, g2 = jnp.split(mod, 6, axis=-1)
        csh1, csc1, cg1, csh2, csc2, cg2 = jnp.split(mod_c, 6, axis=-1)

        a = modulate(x, norm_g[layer, 0], sh1, sc1)
        ac = modulate(h_ctx, norm_g[layer, 0], csh1, csc1)
        kind = layer % N_MIXERS
        j = mixer_count[kind]
        mixer_count[kind] += 1
        if kind == 0:
            lam_init = 0.8 - 0.6 * math.exp(-0.3 * layer)
            y, yc = diff_attention_mixer(a, ac, da_w_in[j], da_w_out[j], da_lambda[j], da_subln_g[j], lam_init, not last)
        elif kind == 1:
            y, yc = window_gqa_mixer(a, ac, wa_w_in[j], wa_w_out[j], wa_sink[j], not last)
        else:
            y, yc = retention_mixer(a, ac, ret_w_in[j], ret_w_out[j], ret_decay_logit[j], not last)
        x = x + g1 * rms_norm(y, norm_g[layer, 1])
        if not last:
            h_ctx = h_ctx + cg1 * rms_norm(yc, norm_g[layer, 1])

        a = modulate(x, norm_g[layer, 2], sh2, sc2)
        if layer % 2 == 0:
            w_gu, w_dn = ffn_w_gu[i_dense], ffn_w_down[i_dense]
            i_dense += 1
            ffn = lambda t: swiglu(t, w_gu, w_dn)
        else:
            w_r, w_gu, w_dn = moe_router[i_moe], moe_w_gu[i_moe], moe_w_down[i_moe]
            i_moe += 1
            ffn = lambda t: moe_swiglu(t, w_r, w_gu, w_dn)
        x = x + g2 * rms_norm(ffn(a), norm_g[layer, 3])
        if not last:
            ac = modulate(h_ctx, norm_g[layer, 2], csh2, csc2)
            h_ctx = h_ctx + cg2 * rms_norm(ffn(ac), norm_g[layer, 3])
    return x
```

```cpp
#include <hip/hip_runtime.h>
#include <cstdio>
#include <cstdint>

#ifndef DBG
#define DBG 0
#endif
#ifndef PG8_RELAX
#define PG8_RELAX 1
#endif
#ifndef PG8_ASM_DMA
#define PG8_ASM_DMA 1
#endif
#ifndef MK_MULTI
#define MK_MULTI 0
#endif

__device__ __forceinline__ int opaque_tid(int wv) { int l; asm volatile("v_mbcnt_lo_u32_b32 %0, -1, 0\n\tv_mbcnt_hi_u32_b32 %0, -1, %0" : "=v"(l)); return (wv << 6) | l; }
namespace pg8 {
#define PG8_LAS __attribute__((address_space(3)))
typedef unsigned short bf16_t;
typedef short bf16x8 __attribute__((ext_vector_type(8)));
typedef float f32x4 __attribute__((ext_vector_type(4)));
typedef unsigned u32x4 __attribute__((ext_vector_type(4)));
constexpr int BM = 256, BK = 64, HALF = 128, HTB = HALF * BK * 2  , STAGE_BYTES = 8 * HTB, NXCD = 8, WGM = 4;

__host__ __device__ __forceinline__ int lds_byte(int r, int c) { const int st = (r >> 4) * 2 + (c >> 5), rr = r & 15, cc = c & 31, ob = rr * 64 + cc * 2; return st * 1024 + (ob ^ (((ob >> 9) & 1) << 5)); }
__host__ __device__ __forceinline__ void stage_rc(int b, int& R, int& C) { const int st = b / 1024, sb = b % 1024, swz = sb ^ (((sb >> 9) & 1) << 5); R = (st >> 1) * 16 + swz / 64; C = (st & 1) * 32 + (swz % 64) / 2; }
__host__ __device__ __forceinline__ int perm32(int rho) { const int n = rho >> 4, i = rho & 15; return 8 * (i >> 2) + 4 * n + (i & 3); }

struct Unit { int pm, pn; };
struct Gemm { const bf16_t* A; const bf16_t* Bt; int M, N, K; };

struct StaticOrder {
    int nM, nN, nwg, G, c;
    __host__ __device__ void init(int M, int N, int G_, int c_) { nM = M / BM; nN = N / BM; nwg = nM * nN; G = G_; c = c_; }
    __host__ __device__ bool next(int i, Unit& u) const {
        const long L = (long)i * G + c; if (L >= nwg) return false;
        int wgid = (int)L; { const int q = nwg / NXCD, r = nwg % NXCD, xcd = wgid % NXCD, off = wgid / NXCD; wgid = (xcd < r ? xcd * (q + 1) : r * (q + 1) + (xcd - r) * q) + off; }
        const int nig = WGM * nN, gid = wgid / nig, rem = wgid - gid * nig, fm = gid * WGM, gsz = (nM - fm) < WGM ? (nM - fm) : WGM;
        static_assert(WGM == 4, "the full-group case below shifts by log2(WGM)");
        if (gsz == WGM) { u.pm = fm + (rem & (WGM - 1)); u.pn = rem >> 2; } else { u.pm = fm + (rem % gsz); u.pn = rem / gsz; }
        return true;
    }
    __device__ __forceinline__ void a_ready(const Unit&) const {}
    __device__ __forceinline__ void done(const Unit&) const {}
};

struct StaticOrderLat : StaticOrder {
    __host__ __device__ bool next(int i, Unit& u) const { if (!StaticOrder::next(i, u)) return false; u.pm = (u.pm >> 4) * 17 + 1 + (u.pm & 15); return true; }
};

typedef int v8i __attribute__((ext_vector_type(8)));
typedef float f32x8 __attribute__((ext_vector_type(8)));
typedef int v4i_ __attribute__((ext_vector_type(4)));
__device__ __forceinline__ v8i cat8(bf16x8 lo, bf16x8 hi) { const v4i_ a = __builtin_bit_cast(v4i_, lo), b = __builtin_bit_cast(v4i_, hi); return __builtin_shufflevector(a, b, 0, 1, 2, 3, 4, 5, 6, 7); }
__device__ __forceinline__ bf16x8 lo8(v8i v) { return __builtin_bit_cast(bf16x8, __builtin_shufflevector(v, v, 0, 1, 2, 3)); }
__device__ __forceinline__ bf16x8 hi8(v8i v) { return __builtin_bit_cast(bf16x8, __builtin_shufflevector(v, v, 4, 5, 6, 7)); }
__device__ __forceinline__ unsigned cvt_pk_bf16(float lo, float hi) { unsigned r; asm volatile("v_cvt_pk_bf16_f32 %0, %1, %2" : "=v"(r) : "v"(lo), "v"(hi)); return r; }

#ifndef EPI_NT
#define EPI_NT 0
#endif
#if EPI_NT
#define EPI_ST(p, v) __builtin_nontemporal_store((v), (p))
#else
#define EPI_ST(p, v) (*(p) = (v))
#endif
__device__ __forceinline__ u32x4 pack8(const f32x4 a, const f32x4 b) { u32x4 w; w.x = cvt_pk_bf16(a[0], a[1]); w.y = cvt_pk_bf16(a[2], a[3]); w.z = cvt_pk_bf16(b[0], b[1]); w.w = cvt_pk_bf16(b[2], b[3]); return w; }

struct EpiPlain {
    static constexpr bool PERM = true, AFTER_DRAIN = false; static constexpr int NSTORE = 16;
    bf16_t* O; int ldc; int pn_mod; int pm_off; int mode;
    __device__ __forceinline__ void operator()(const f32x4 (&acc)[2][2][4][2], const Unit& u, int wr, int wc, int fr, int fq) const {
        if (mode == 1) return;
        const int row0 = (u.pm + pm_off) * BM + wr * 64 + fr, col0 = (u.pn % pn_mod) * BM + wc * 32 + 8 * fq;
#pragma unroll
        for (int ai = 0; ai < 2; ++ai)
#pragma unroll
            for (int m = 0; m < 4; ++m) { bf16_t* rowp = O + (size_t)(row0 + ai * HALF + m * 16) * ldc + col0;
#pragma unroll
                for (int bj = 0; bj < 2; ++bj) { const u32x4 w_ = pack8(acc[ai][bj][m][0], acc[ai][bj][m][1]); if (mode == 0 || w_.x == 0x7fc12345u) EPI_ST((u32x4*)(rowp + bj * HALF), w_); } }
    }
};
struct EpiRope2D {
    static constexpr bool PERM = true, AFTER_DRAIN = false; static constexpr int NSTORE = 16;
    bf16_t* O; int ldc; int rope_tiles; const PG8_LAS float* tabc; const PG8_LAS float* tabs; int mode;
    __device__ __forceinline__ void operator()(const f32x4 (&acc)[2][2][4][2], const Unit& u, int wr, int wc, int fr, int fq) const {
        const int row0 = u.pm * BM + wr * 64 + fr, col0 = u.pn * BM + wc * 32 + 8 * fq;
        const int pt = u.pm % 17; const bool rope = (u.pn < rope_tiles) && (pt != 0);
        const int pos0 = (pt - 1) * 256 + wr * 64 + fr;
#pragma unroll
        for (int ai = 0; ai < 2; ++ai)
#pragma unroll
            for (int m = 0; m < 4; ++m) { bf16_t* rowp = O + (size_t)(row0 + ai * HALF + m * 16) * ldc + col0;
                f32x4 cs = (f32x4){1.f, 1.f, 1.f, 1.f}, sn = (f32x4){0.f, 0.f, 0.f, 0.f};
                if (rope) { const int pos = pos0 + ai * HALF + m * 16; const int pidx = (wc & 1) ? (pos & 63) : (pos >> 6);
                    cs = *(const PG8_LAS f32x4*)(tabc + pidx * 16 + 4 * fq); sn = *(const PG8_LAS f32x4*)(tabs + pidx * 16 + 4 * fq); }
#pragma unroll
                for (int bj = 0; bj < 2; ++bj) { const f32x4 x0 = acc[ai][bj][m][0], x1 = acc[ai][bj][m][1];
                    const f32x4 y0 = x0 * cs - x1 * sn, y1 = x1 * cs + x0 * sn;
                    EPI_ST((u32x4*)(rowp + bj * HALF), pack8(y0, y1)); } }
    }
};
struct EpiRope1D {
    static constexpr bool PERM = true, AFTER_DRAIN = false; static constexpr int NSTORE = 16;
    bf16_t* O; int ldc; int rope_tiles; const float* tabc; const float* tabs; int mode;
    __device__ __forceinline__ void operator()(const f32x4 (&acc)[2][2][4][2], const Unit& u, int wr, int wc, int fr, int fq) const {
        const int row0 = u.pm * BM + wr * 64 + fr, col0 = u.pn * BM + wc * 32 + 8 * fq;
        const int pt = u.pm % 17; const bool rope = (u.pn < rope_tiles) && (pt != 0);
        const int pos0 = (pt - 1) * 256 + wr * 64 + fr;
#pragma unroll
        for (int ai = 0; ai < 2; ++ai)
#pragma unroll
            for (int m = 0; m < 4; ++m) { bf16_t* rowp = O + (size_t)(row0 + ai * HALF + m * 16) * ldc + col0;
                f32x4 y0[2], y1[2];
#pragma unroll
                for (int n = 0; n < 2; ++n) { const f32x4 x0 = acc[ai][0][m][n], x1 = acc[ai][1][m][n];
                    if (rope) { const int pos = pos0 + ai * HALF + m * 16; const int i0 = wc * 32 + 8 * fq + 4 * n;
                        const f32x4 cs = *(const f32x4*)(tabc + (size_t)pos * 128 + i0), sn = *(const f32x4*)(tabs + (size_t)pos * 128 + i0);
                        y0[n] = x0 * cs - x1 * sn; y1[n] = x1 * cs + x0 * sn; }
                    else { y0[n] = x0; y1[n] = x1; } }
                EPI_ST((u32x4*)(rowp), pack8(y0[0], y0[1])); EPI_ST((u32x4*)(rowp + HALF), pack8(y1[0], y1[1])); }
    }
};
__device__ __forceinline__ float silu_f(float t) { return t * __builtin_amdgcn_rcpf(1.f + __builtin_amdgcn_exp2f(-t)); }
struct EpiSwiGLU {
    static constexpr bool PERM = true, AFTER_DRAIN = false; static constexpr int NSTORE = 8;
    bf16_t* O; int ldc; int pn_mod; int pm_off; int mode;
    __device__ __forceinline__ void operator()(const f32x4 (&acc)[2][2][4][2], const Unit& u, int wr, int wc, int fr, int fq) const {
        if (mode == 1) return;
        const int row0 = (u.pm + pm_off) * BM + wr * 64 + fr, col0 = (u.pn % pn_mod) * HALF + wc * 32 + 8 * fq;
        if (mode == 3) { f32x4 s_ = (f32x4){0.f, 0.f, 0.f, 0.f};
#pragma unroll
            for (int ai = 0; ai < 2; ++ai)
#pragma unroll
                for (int bj = 0; bj < 2; ++bj)
#pragma unroll
                    for (int m = 0; m < 4; ++m) { s_ += acc[ai][bj][m][0]; s_ += acc[ai][bj][m][1]; }
            if (s_[0] + s_[1] + s_[2] + s_[3] == 1.2345e-30f) O[(size_t)row0 * ldc + col0] = 1; return; }
#pragma unroll
        for (int ai = 0; ai < 2; ++ai)
#pragma unroll
            for (int m = 0; m < 4; ++m) { bf16_t* rowp = O + (size_t)(row0 + ai * HALF + m * 16) * ldc + col0;
                f32x4 h[2];
#pragma unroll
                for (int n = 0; n < 2; ++n) { const f32x4 g = acc[ai][0][m][n], uu = acc[ai][1][m][n];
                    h[n] = (f32x4){silu_f(g[0]) * uu[0], silu_f(g[1]) * uu[1], silu_f(g[2]) * uu[2], silu_f(g[3]) * uu[3]}; }
                { const u32x4 w_ = pack8(h[0], h[1]); if (mode == 0 || w_.x == 0x7fc12345u) EPI_ST((u32x4*)(rowp), w_); } }
    }
};

__device__ __forceinline__ unsigned pack4_fp8(float a, float b, float c, float d) {
    a = __builtin_fminf(__builtin_fmaxf(a, -448.f), 448.f); b = __builtin_fminf(__builtin_fmaxf(b, -448.f), 448.f); c = __builtin_fminf(__builtin_fmaxf(c, -448.f), 448.f); d = __builtin_fminf(__builtin_fmaxf(d, -448.f), 448.f);
    int w = 0; w = __builtin_amdgcn_cvt_pk_fp8_f32(a, b, w, false); w = __builtin_amdgcn_cvt_pk_fp8_f32(c, d, w, true); return (unsigned)w; }
typedef unsigned u32x2 __attribute__((ext_vector_type(2)));
struct EpiSwiGLU8 {
    static constexpr bool PERM = true, AFTER_DRAIN = false; static constexpr int NSTORE = 8;
    unsigned char* O; int ldc; int pn_mod; int pm_off; float oscale; int mode;
    __device__ __forceinline__ void operator()(const f32x4 (&acc)[2][2][4][2], const Unit& u, int wr, int wc, int fr, int fq) const {
        const int row0 = (u.pm + pm_off) * BM + wr * 64 + fr, col0 = (u.pn % pn_mod) * HALF + wc * 32 + 8 * fq;
#pragma unroll
        for (int ai = 0; ai < 2; ++ai)
#pragma unroll
            for (int m = 0; m < 4; ++m) { unsigned char* rowp = O + (size_t)(row0 + ai * HALF + m * 16) * ldc + col0;
                u32x2 w;
#pragma unroll
                for (int n = 0; n < 2; ++n) { const f32x4 g = acc[ai][0][m][n], uu = acc[ai][1][m][n];
                    const unsigned p = pack4_fp8(silu_f(g[0]) * uu[0], silu_f(g[1]) * uu[1], silu_f(g[2]) * uu[2], silu_f(g[3]) * uu[3]);
                    if (n == 0) w.x = p; else w.y = p; }
                EPI_ST((u32x2*)(rowp), w); }
    }
};
struct MoeOrder {
    int t0, t1, ncol, G, c; const PG8_LAS int* tsl;
    __device__ __forceinline__ bool next(int i, Unit& u) const {
        const unsigned L = (unsigned)i * (unsigned)G + (unsigned)c; const int nt = t1 - t0; if (L >= (unsigned)nt * (unsigned)ncol) return false;
        const unsigned nig = 8u * (unsigned)ncol, gid = L / nig, rem = L - gid * nig; const int fm = (int)gid * 8, gsz = (nt - fm) < 8 ? (nt - fm) : 8;
        const int t = t0 + fm + (gsz == 8 ? (int)(rem & 7u) : (int)(rem % (unsigned)gsz)), j = (gsz == 8) ? (int)(rem >> 3) : (int)(rem / (unsigned)gsz);
        int e = 0;
#pragma unroll
        for (int k = 1; k < 8; ++k) e += (t >= tsl[k]) ? 1 : 0;
        u.pm = t; u.pn = e * ncol + j; return true;
    }
    __device__ __forceinline__ void a_ready(const Unit&) const {}
    __device__ __forceinline__ void done(const Unit&) const {}
};
template <class Epi, class Sched, bool ALIGN_EPI = false, bool SP2 = false, int FP8 = 0  >
__device__ __forceinline__ void gemm_phase(PG8_LAS unsigned char* lds, const Gemm g, const Sched& S, const Epi& E, const int wv) {
    const int tid = opaque_tid(wv), wid = __builtin_amdgcn_readfirstlane(tid >> 6), lane = tid & 63, wr = wid >> 2, wc = wid & 3, fr = lane & 15, fq = lane >> 4;
    const int K = g.K, nt = K / BK;
    constexpr bool RELAX_ST = ALIGN_EPI && SP2 && !Epi::AFTER_DRAIN && (PG8_RELAX != 0);
    unsigned voffA[2], voffB[2];
#pragma unroll
    for (int i = 0; i < 2; ++i) { int R, C; stage_rc(tid * 16 + i * 8192, R, C); const int Rb = Epi::PERM ? ((R & ~31) + perm32(R & 31)) : R;
        voffA[i] = (unsigned)(R * K + C) * 2u; voffB[i] = (unsigned)(Rb * K + C) * 2u; }
    const size_t kstep = (size_t)(BK * 2);
    const size_t hstep = (size_t)HALF * K * 2;
    const size_t tstep = 2 * hstep;
    const unsigned ldsw = (unsigned)wid * 1024u; const unsigned ldsbase = (unsigned)(size_t)lds;
    const int aoff = lds_byte(wr * 64 + fr, fq * 8), boff = lds_byte(wc * 32 + fr, fq * 8);
#define PG8_SA(b, h) (((b) * 2 + (h)) * HTB)
#define PG8_SB(b, h) ((4 + (b) * 2 + (h)) * HTB)
#define PG8_STAGE(bufoff, gbase, voff) do { _Pragma("unroll") for (int _i = 0; _i < 2; ++_i) { \
        if constexpr (FP8 == 0 && !PG8_ASM_DMA) __builtin_amdgcn_global_load_lds((const unsigned*)((const char*)(gbase) + (voff)[_i]), (PG8_LAS unsigned*)(lds + (bufoff) + ldsw + _i * 8192), 16, 0, 0); \
        else { unsigned keep_; asm volatile("s_mov_b32 %0, m0\n\ts_mov_b32 m0, %3\n\ts_nop 0\n\tglobal_load_lds_dwordx4 %1, %2\n\ts_mov_b32 m0, %0" : "=&s"(keep_) : "v"((voff)[_i]), "s"((const char*)(gbase)), "s"((unsigned)__builtin_amdgcn_readfirstlane((int)(ldsbase + (unsigned)(bufoff) + ldsw + _i * 8192))) : "memory"); } } } while (0)
#define PG8_LDA(dst, b, h) do { _Pragma("unroll") for (int m = 0; m < 4; ++m) { const bf16x8 f0_ = *(const PG8_LAS bf16x8*)(lds + PG8_SA(b, h) + aoff + m * 2048), f1_ = *(const PG8_LAS bf16x8*)(lds + PG8_SA(b, h) + aoff + m * 2048 + 1024); dst[m] = cat8(f0_, f1_); } } while (0)
#define PG8_LDB(dst, b, h) do { _Pragma("unroll") for (int n = 0; n < 2; ++n) { const bf16x8 f0_ = *(const PG8_LAS bf16x8*)(lds + PG8_SB(b, h) + boff + n * 2048), f1_ = *(const PG8_LAS bf16x8*)(lds + PG8_SB(b, h) + boff + n * 2048 + 1024); dst[n] = cat8(f0_, f1_); } } while (0)
#define PG8_MMA(ai, bj, At, Bt) do { __builtin_amdgcn_s_setprio(1); \
        if constexpr (FP8 == 0) { _Pragma("unroll") for (int m = 0; m < 4; ++m) _Pragma("unroll") for (int n = 0; n < 2; ++n) { \
            acc[ai][bj][m][n] = __builtin_amdgcn_mfma_f32_16x16x32_bf16(lo8(Bt[n]), lo8(At[m]), acc[ai][bj][m][n], 0, 0, 0); \
            acc[ai][bj][m][n] = __builtin_amdgcn_mfma_f32_16x16x32_bf16(hi8(Bt[n]), hi8(At[m]), acc[ai][bj][m][n], 0, 0, 0); } } \
        else { \
            _Pragma("unroll") for (int m = 0; m < 4; ++m) _Pragma("unroll") for (int n = 0; n < 2; ++n) \
            asm volatile("v_mfma_scale_f32_16x16x128_f8f6f4 %0, %1, %2, %0, %3, %4 op_sel_hi:[0,0,0]" : "+v"(acc[ai][bj][m][n]) : "v"(Bt[n]), "v"(At[m]), "v"(scb_), "v"(sca_)); } \
        __builtin_amdgcn_s_setprio(0); } while (0)
#define PG8_MMA0(ai, bj, At, Bt) do { __builtin_amdgcn_s_setprio(1); \
        if constexpr (FP8 == 0) { _Pragma("unroll") for (int m = 0; m < 4; ++m) _Pragma("unroll") for (int n = 0; n < 2; ++n) { \
            acc[ai][bj][m][n] = __builtin_amdgcn_mfma_f32_16x16x32_bf16(lo8(Bt[n]), lo8(At[m]), (f32x4){0.f, 0.f, 0.f, 0.f}, 0, 0, 0); \
            acc[ai][bj][m][n] = __builtin_amdgcn_mfma_f32_16x16x32_bf16(hi8(Bt[n]), hi8(At[m]), acc[ai][bj][m][n], 0, 0, 0); } } \
        else { \
            _Pragma("unroll") for (int m = 0; m < 4; ++m) _Pragma("unroll") for (int n = 0; n < 2; ++n) \
            asm volatile("v_mfma_scale_f32_16x16x128_f8f6f4 %0, %1, %2, 0, %3, %4 op_sel_hi:[0,0,0]" : "+v"(acc[ai][bj][m][n]) : "v"(Bt[n]), "v"(At[m]), "v"(scb_), "v"(sca_)); }   \
        __builtin_amdgcn_s_setprio(0); } while (0)
#define PG8_MMAX(first, ai, bj, At, Bt) do { if (first) PG8_MMA0(ai, bj, At, Bt); else PG8_MMA(ai, bj, At, Bt); } while (0)
#define PG8_WAIT_V(n) asm volatile("s_waitcnt vmcnt(" #n ")" ::: "memory")
#define PG8_WAIT_L(n) asm volatile("s_waitcnt lgkmcnt(" #n ")" ::: "memory")
#define PG8_WAIT_VX(rx) do { if (rx) asm volatile("s_waitcnt vmcnt(%0)" :: "n"(8 + Epi::NSTORE) : "memory"); else PG8_WAIT_V(8); } while (0)
#define PG8_BAR __builtin_amdgcn_s_barrier()
#define PG8_SCHED __builtin_amdgcn_sched_barrier(0)
    Unit cur, nxt; int ui = 0;
    PG8_LAS unsigned* utab = (PG8_LAS unsigned*)(lds + STAGE_BYTES + 1024);
    if (tid < 64) { Unit u_; utab[tid] = S.next(tid, u_) ? ((unsigned)u_.pm | ((unsigned)u_.pn << 16)) : 0xffffffffu; }
    __syncthreads();
#define PG8_NEXT(i, u, ok) do { const int i_ = (i); if (i_ < 64) { const unsigned v_ = (unsigned)__builtin_amdgcn_readfirstlane((int)utab[i_]); ok = (v_ != 0xffffffffu); u.pm = (int)(v_ & 0xffffu); u.pn = (int)(v_ >> 16); } else ok = S.next(i_, u); } while (0)
    { bool ok0_; PG8_NEXT(0, cur, ok0_); if (!ok0_) return; }
    f32x4 acc[2][2][4][2];
    const int sca_ = (FP8 & 0xff) * 0x01010101, scb_ = ((FP8 >> 8) & 0xff) * 0x01010101;
    {
#pragma unroll
    for (int a = 0; a < 2; ++a)
#pragma unroll
        for (int b = 0; b < 2; ++b)
#pragma unroll
            for (int m = 0; m < 4; ++m)
#pragma unroll
                for (int n = 0; n < 2; ++n) acc[a][b][m][n] = (f32x4){0.f, 0.f, 0.f, 0.f};
    }
    v8i At[4], B0[2], B1[2];
    const char* cA = (const char*)g.A + (size_t)cur.pm * tstep; const char* cB = (const char*)g.Bt + (size_t)cur.pn * tstep;
    S.a_ready(cur);
    if constexpr (SP2) {
        PG8_STAGE(PG8_SB(0, 0), cB, voffB); PG8_STAGE(PG8_SB(0, 1), cB + hstep, voffB); PG8_STAGE(PG8_SA(0, 0), cA, voffA); PG8_STAGE(PG8_SA(0, 1), cA + hstep, voffA);
        if (wr == 1) PG8_BAR;
        PG8_WAIT_V(2); PG8_BAR;
        PG8_STAGE(PG8_SB(1, 0), cB + kstep, voffB); PG8_STAGE(PG8_SA(1, 0), cA + kstep, voffA); PG8_STAGE(PG8_SB(1, 1), cB + hstep + kstep, voffB);
        PG8_WAIT_V(6); PG8_BAR;
    } else {
        PG8_STAGE(PG8_SB(0, 0), cB, voffB); PG8_STAGE(PG8_SA(0, 0), cA, voffA); PG8_STAGE(PG8_SB(0, 1), cB + hstep, voffB); PG8_STAGE(PG8_SA(0, 1), cA + hstep, voffA);
        if (wr == 1) PG8_BAR;
        PG8_WAIT_V(4); PG8_BAR;
        PG8_STAGE(PG8_SB(1, 0), cB + kstep, voffB); PG8_STAGE(PG8_SA(1, 0), cA + kstep, voffA); PG8_STAGE(PG8_SB(1, 1), cB + hstep + kstep, voffB);
        PG8_WAIT_V(6); PG8_BAR;
    }
    for (;;) {
        bool has_next; PG8_NEXT(ui + 1, nxt, has_next);
        const char* nA = has_next ? (const char*)g.A + (size_t)nxt.pm * tstep : cA; const char* nB = has_next ? (const char*)g.Bt + (size_t)nxt.pn * tstep : cB;
        for (int t = 0; t < nt; t += 2) {
            const bool last = (t == nt - 2);
            const char* a1 = cA + (size_t)(t + 1) * kstep;
            const char* a2 = last ? nA : cA + (size_t)(t + 2) * kstep; const char* b2 = last ? nB : cB + (size_t)(t + 2) * kstep;
            const char* a3 = a2 + kstep; const char* b3 = b2 + kstep;
            if (last && has_next) S.a_ready(nxt);
            if constexpr (SP2) {
            const bool relax = RELAX_ST && (t == 0) && (ui > 0);
            const bool first0 = SP2 && (t == 0);
            PG8_LDB(B0, 0, 0); PG8_LDB(B1, 0, 1); PG8_SCHED; PG8_LDA(At, 0, 0); if (!relax) PG8_STAGE(PG8_SA(1, 1), a1 + hstep, voffA);
            PG8_WAIT_VX(relax); PG8_WAIT_L(0); PG8_BAR; PG8_MMAX(first0, 0, 0, At, B0); PG8_MMAX(first0, 0, 1, At, B1); PG8_BAR; PG8_SCHED;
            PG8_LDA(At, 0, 1); PG8_STAGE(PG8_SB(0, 0), b2, voffB); PG8_STAGE(PG8_SB(0, 1), b2 + hstep, voffB); PG8_STAGE(PG8_SA(0, 0), a2, voffA);
            PG8_WAIT_VX(relax); PG8_WAIT_L(0); PG8_BAR; PG8_MMAX(first0, 1, 0, At, B0); PG8_MMAX(first0, 1, 1, At, B1); PG8_BAR; PG8_SCHED;
            PG8_LDB(B0, 1, 0); PG8_LDB(B1, 1, 1); PG8_SCHED; PG8_LDA(At, 1, 0); PG8_STAGE(PG8_SA(0, 1), a2 + hstep, voffA);
            PG8_WAIT_VX(relax); PG8_WAIT_L(0); PG8_BAR; PG8_MMA(0, 0, At, B0); PG8_MMA(0, 1, At, B1); PG8_BAR; PG8_SCHED;
            PG8_LDA(At, 1, 1); PG8_STAGE(PG8_SB(1, 0), b3, voffB); PG8_STAGE(PG8_SB(1, 1), b3 + hstep, voffB); PG8_STAGE(PG8_SA(1, 0), a3, voffA);
            PG8_WAIT_V(8); PG8_WAIT_L(0); PG8_BAR; PG8_MMA(1, 0, At, B0); PG8_MMA(1, 1, At, B1); PG8_BAR; PG8_SCHED;
            } else {
            PG8_LDB(B0, 0, 0); PG8_SCHED; PG8_LDA(At, 0, 0); PG8_STAGE(PG8_SA(1, 1), a1 + hstep, voffA);
            PG8_WAIT_L(8); PG8_BAR; PG8_WAIT_L(0); PG8_MMA(0, 0, At, B0); PG8_BAR; PG8_SCHED;
            PG8_LDB(B1, 0, 1); PG8_STAGE(PG8_SB(0, 0), b2, voffB);
            PG8_BAR; PG8_WAIT_L(0); PG8_MMA(0, 1, At, B1); PG8_BAR;
            PG8_LDA(At, 0, 1); PG8_STAGE(PG8_SA(0, 0), a2, voffA);
            PG8_BAR; PG8_WAIT_L(0); PG8_MMA(1, 0, At, B0); PG8_BAR; PG8_SCHED;
            PG8_STAGE(PG8_SB(0, 1), b2 + hstep, voffB);
            PG8_WAIT_V(6); PG8_BAR; PG8_MMA(1, 1, At, B1); PG8_BAR;
            PG8_LDB(B0, 1, 0); PG8_SCHED; PG8_LDA(At, 1, 0); PG8_STAGE(PG8_SA(0, 1), a2 + hstep, voffA);
            PG8_WAIT_L(8); PG8_BAR; PG8_WAIT_L(0); PG8_MMA(0, 0, At, B0); PG8_BAR; PG8_SCHED;
            PG8_LDB(B1, 1, 1); PG8_STAGE(PG8_SB(1, 0), b3, voffB);
            PG8_BAR; PG8_WAIT_L(0); PG8_MMA(0, 1, At, B1); PG8_BAR;
            PG8_LDA(At, 1, 1); PG8_STAGE(PG8_SA(1, 0), a3, voffA);
            PG8_BAR; PG8_WAIT_L(0); PG8_MMA(1, 0, At, B0); PG8_BAR; PG8_SCHED;
            PG8_STAGE(PG8_SB(1, 1), b3 + hstep, voffB);
            PG8_WAIT_V(6); PG8_BAR; PG8_MMA(1, 1, At, B1); PG8_BAR;
            }
        }
        if constexpr (ALIGN_EPI) { if (wr == 0) PG8_BAR; }
        if constexpr (RELAX_ST) { if (has_next) PG8_STAGE(PG8_SA(1, 1), nA + kstep + hstep, voffA); }
        if constexpr (FP8 != 0) asm volatile("s_nop 15\n\ts_nop 15\n\ts_nop 7" ::: "memory");
        if constexpr (!Epi::AFTER_DRAIN) { int tide_ = tid; asm volatile("" : "+v"(tide_)); const int le_ = tide_ & 63;
            E(acc, cur, wr, wc, le_ & 15, le_ >> 4); S.done(cur); }
        if (!has_next) break;
        if constexpr (!SP2) {
#pragma unroll
        for (int a = 0; a < 2; ++a)
#pragma unroll
            for (int b = 0; b < 2; ++b)
#pragma unroll
                for (int m = 0; m < 4; ++m)
#pragma unroll
                    for (int n = 0; n < 2; ++n) acc[a][b][m][n] = (f32x4){0.f, 0.f, 0.f, 0.f};
        }
        cur = nxt; cA = nA; cB = nB; ++ui;
        if constexpr (ALIGN_EPI) { if (wr == 1) PG8_BAR; }
    }
    PG8_WAIT_V(0);
    if constexpr (!ALIGN_EPI) { if (wr == 0) PG8_BAR; }
    PG8_BAR;
    if constexpr (Epi::AFTER_DRAIN) { E.fused(acc, cur, wr, wc, fr, fq, lds, wid, lane); S.done(cur); }
#undef PG8_SA
#undef PG8_SB
#undef PG8_STAGE
#undef PG8_LDA
#undef PG8_LDB
#undef PG8_MMA
#undef PG8_MMA0
#undef PG8_MMAX
#undef PG8_NEXT
#undef PG8_WAIT_V
#undef PG8_WAIT_L
#undef PG8_WAIT_VX
#undef PG8_BAR
#undef PG8_SCHED
}
}

constexpr int DM = 1024, NBATCH = 16, SEQL = 4096, CTXL = 256, RPB = SEQL + CTXL  , TA = NBATCH * RPB  ;
constexpr int FFN = 2816, NEXP = 8, EDIM = 3584, NWAVES = 8;
constexpr float NORM_EPS = 1e-6f;
constexpr float LOG2E_F = 1.4426950408889634f;
constexpr float QSCALE = 0.125f * 1.4426950408889634f;
constexpr int MOE_TILES_MAX = 552, MOE_PASS_TILES = 276;

constexpr size_t MiB = 1u << 20;
constexpr size_t WS_CTL = 0, CTL_ZERO_BYTES = 1 * MiB;
constexpr size_t WS_MODV = 1 * MiB;
constexpr size_t WS_ROPE2 = 3 * MiB;
constexpr size_t WS_SCAL = 3 * MiB + 64 * 1024;
constexpr size_t WS_ROUTW = 3 * MiB + 128 * 1024;
constexpr size_t WS_SMALL = 3 * MiB + 256 * 1024;
constexpr int SM_NORMG = 0, SM_SUBLN = 16384, SM_SINK = 16384 + 256, SM_DECAY = 16384 + 256 + 16;
constexpr size_t WS_ROPE1 = 4 * MiB;
constexpr size_t WS_TOKINFO = 8 * MiB;
constexpr size_t WS_LISTS = 10 * MiB;
constexpr size_t WS_W = 16 * MiB;
constexpr size_t W_DAIN = WS_W, W_DAOUT = W_DAIN + 12 * MiB, W_WAIN = W_DAOUT + 4 * MiB, W_WAOUT = W_WAIN + 3 * MiB, W_RETIN = W_WAOUT + 2 * MiB, W_RETOUT = W_RETIN + 12 * MiB,
                 W_FFNGU = W_RETOUT + 4 * MiB, W_FFNDN = W_FFNGU + 22 * MiB, W_MOEGU = W_FFNDN + 11 * MiB, W_MOEDN = W_MOEGU + 224 * MiB, W_END = W_MOEDN + 112 * MiB;
constexpr size_t WS_X = 424 * MiB;
constexpr size_t WS_RO8 = 560 * MiB;
constexpr size_t WS_BIG = 696 * MiB;
constexpr size_t WS_END = 1792 * MiB;
static_assert(W_END <= WS_X && WS_X + (size_t)TA * DM * 2 <= WS_RO8 && WS_RO8 + (size_t)TA * 2048 <= WS_BIG, "ws map");
constexpr size_t BIG_QKV = WS_BIG, BIG_O = WS_BIG + 408 * MiB;
constexpr size_t BIG_RQ = WS_BIG, BIG_RO = WS_BIG + 816 * MiB;
constexpr size_t BIG_H = WS_BIG;
constexpr size_t BIG_BUF = WS_BIG, BIG_YE = WS_BIG + 138 * MiB, BIG_MH = WS_BIG + 414 * MiB;
static_assert(BIG_RO + (size_t)TA * 2048 * 2 <= WS_END && BIG_MH + (size_t)MOE_TILES_MAX * 256 * EDIM <= WS_END, "ws map (big)");
#ifndef DENSE_FP8
#define DENSE_FP8 2
#endif
#ifndef DENSE_H8
#define DENSE_H8 1
#endif
#ifndef RETOUT_FP8
#define RETOUT_FP8 1
#endif
#ifndef RESID_NR
#define RESID_NR 3
#endif
#ifndef PROJ_FP8
#define PROJ_FP8 5
#endif
constexpr size_t A8_OFF = 136 * MiB;
constexpr float A8_SCALE = 8.f, H8_SCALE = 4.f, WGU8_SCALE = 32.f, WDN8_SCALE = 64.f;
constexpr int FP8_GU = ((127 - 5) << 8) | (127 - 3), FP8_DN = ((127 - 6) << 8) | (127 - 2), FP8_AO = ((127 - 6) << 8) | (127 - 3);

constexpr size_t WS_OBC = 200 * MiB;
static_assert(WS_OBC >= W_MOEGU + 112 * MiB && WS_OBC + (size_t)NBATCH * CTXL * 2048 * 2 <= W_MOEDN, "OBC placement");
constexpr int CW_TMO = 0, CW_CODE = 1, CW_DBG = 2;
constexpr int CW_MOECNT = 64;
constexpr int CW_WQ = 128;
constexpr int CW_BAR = 4096;

constexpr int RING_OFF = 0, RING_BYTES = 131072;
constexpr int LDSCTL_OFF = RING_BYTES, MISC_OFF = LDSCTL_OFF + 320;
constexpr int ROPE2_LDS_OFF = LDSCTL_OFF + 2048;
constexpr int LDS_BYTES = 147456;

#define GAS __attribute__((address_space(1)))
#define LAS __attribute__((address_space(3)))
typedef unsigned short bf16;
typedef unsigned v4u __attribute__((ext_vector_type(4)));
typedef unsigned v2u __attribute__((ext_vector_type(2)));
typedef float f32x4 __attribute__((ext_vector_type(4)));
typedef float f32x2 __attribute__((ext_vector_type(2)));
typedef short bf16x8 __attribute__((ext_vector_type(8)));
typedef short s16x4 __attribute__((ext_vector_type(4)));
typedef float f32x16 __attribute__((ext_vector_type(16)));
typedef GAS unsigned gu32;
#define RLX_AGENT __ATOMIC_RELAXED, __HIP_MEMORY_SCOPE_AGENT
#define LDS_WAIT() asm volatile("s_waitcnt lgkmcnt(0)" ::: "memory")
#define VM_WAIT() asm volatile("s_waitcnt vmcnt(0)" ::: "memory")
__device__ __forceinline__ unsigned f2bf(float f) { unsigned u = __builtin_bit_cast(unsigned, f); return (u + 0x7fffu + ((u >> 16) & 1u)) >> 16; }
typedef __bf16 bf16x2_t_ __attribute__((ext_vector_type(2)));
__device__ __forceinline__ unsigned pk2(float lo, float hi) { const f32x2 v = {lo, hi}; const bf16x2_t_ b = __builtin_convertvector(v, bf16x2_t_); return __builtin_bit_cast(unsigned, b); }
__device__ __forceinline__ float bf2f(unsigned short h) { return __builtin_bit_cast(float, (unsigned)h << 16); }
__device__ __forceinline__ float bflo(unsigned w) { return __builtin_bit_cast(float, w << 16); }
__device__ __forceinline__ float bfhi(unsigned w) { return __builtin_bit_cast(float, w & 0xffff0000u); }
__device__ __forceinline__ float wave_sum(float v) {
#define WS_DPP(ctrl) v += __builtin_bit_cast(float, __builtin_amdgcn_update_dpp(0, __builtin_bit_cast(int, v), (ctrl), 0xF, 0xF, true))
    WS_DPP(0xB1);
    WS_DPP(0x4E);
    WS_DPP(0x141);
    WS_DPP(0x140);
#undef WS_DPP
    { const unsigned u = __builtin_bit_cast(unsigned, v); auto rr = __builtin_amdgcn_permlane16_swap(u, u, false, false); v = __builtin_bit_cast(float, (unsigned)rr[0]) + __builtin_bit_cast(float, (unsigned)rr[1]); }
    { const unsigned u = __builtin_bit_cast(unsigned, v); auto rr = __builtin_amdgcn_permlane32_swap(u, u, false, false); v = __builtin_bit_cast(float, (unsigned)rr[0]) + __builtin_bit_cast(float, (unsigned)rr[1]); }
    return v;
}
#define XB_TMO      128
#define XB_XCNT(j)  (256  + 64 * (j))
#define XB_XSUB(j)  (1280 + 64 * (j))
#define XB_XGEN(j)  (2304 + 64 * (j))
#define XB_TOP      3328
#define XB_TOPGEN   3392
#define XCD_BAR_WORDS 3456
#define XB_SPIN_CAP (1u << 22)

__device__ __forceinline__ unsigned xb_ld(unsigned* p)              { return __hip_atomic_load(p, __ATOMIC_RELAXED, __HIP_MEMORY_SCOPE_AGENT); }
__device__ __forceinline__ unsigned xb_add(unsigned* p, unsigned v) { return __hip_atomic_fetch_add(p, v, __ATOMIC_RELAXED, __HIP_MEMORY_SCOPE_AGENT); }
__device__ __forceinline__ unsigned xb_xcc_id() { return (unsigned)__builtin_amdgcn_s_getreg((3 << 11) | 20) & 0xFu; }
#define XB_SPIN(cond, bar) do { unsigned _sp = 0; while (cond) { __builtin_amdgcn_s_sleep(1); \
    if ((++_sp & 255u) == 0u) { if (xb_ld(&(bar)[XB_TMO])) break; if (_sp > XB_SPIN_CAP) { atomicAdd(&(bar)[XB_TMO], 1u); break; } } } } while (0)

struct XcdBarrier {
    unsigned* bar; unsigned x;
    unsigned wv;
    volatile LAS unsigned* st;
};

__device__ __forceinline__ XcdBarrier xcd_barrier_post(unsigned* bar, volatile LAS unsigned* st, unsigned wv) {
    XcdBarrier b; b.bar = bar; b.x = xb_xcc_id(); b.st = st; b.wv = wv;
    if (opaque_tid((int)wv) == 0) (void)xb_add(&bar[XB_XCNT(b.x)], 1u);
    return b;
}
__device__ __forceinline__ void xcd_barrier_complete(unsigned* bar, unsigned x, unsigned& nloc, unsigned& nx) {
    const unsigned G = gridDim.x * gridDim.y * gridDim.z;
    unsigned sum, cnt, mine, sp = 0u;
    for (;;) {
        sum = 0u; cnt = 0u; mine = 0u;
#pragma unroll
        for (unsigned j = 0; j < 16; ++j) { const unsigned c = xb_ld(&bar[XB_XCNT(j)]); sum += c; cnt += (c > 0u) ? 1u : 0u; mine = (j == x) ? c : mine; }
        if (sum == G) break;
        __builtin_amdgcn_s_sleep(1);
        if ((++sp & 255u) == 0u) { if (xb_ld(&bar[XB_TMO])) break; if (sp > XB_SPIN_CAP) { atomicAdd(&bar[XB_TMO], 1u); break; } }
    }
    nloc = mine > 0u ? mine : 1u; nx = cnt > 0u ? cnt : 1u;
}

__device__ __forceinline__ void xcd_barrier(const XcdBarrier& b) {
    asm volatile("s_waitcnt vmcnt(0)" ::: "memory");
    __syncthreads();
    if (opaque_tid((int)b.wv) == 0) {
        unsigned* bar = b.bar;
        __builtin_amdgcn_s_waitcnt(0);
        unsigned nloc = b.st[0], nx = b.st[1];
        if (nloc == 0u) { xcd_barrier_complete(bar, b.x, nloc, nx); b.st[0] = nloc; b.st[1] = nx; }
        const unsigned old = xb_add(&bar[XB_XSUB(b.x)], 1u);
        const unsigned gen = old / nloc;
        if (old + 1u == (gen + 1u) * nloc) {
            __builtin_amdgcn_fence(__ATOMIC_RELEASE, "agent");
            asm volatile("s_waitcnt vmcnt(0)" ::: "memory");
            const unsigned og = xb_add(&bar[XB_TOP], 1u);
            const unsigned tg = og / nx;
            if (og + 1u == (tg + 1u) * nx) xb_add(&bar[XB_TOPGEN], 1u);
            else XB_SPIN(xb_ld(&bar[XB_TOPGEN]) == tg, bar);
            __builtin_amdgcn_fence(__ATOMIC_ACQUIRE, "agent");
            xb_add(&bar[XB_XGEN(b.x)], 1u);
            asm volatile("s_waitcnt vmcnt(0)" ::: "memory");
        } else {
            XB_SPIN(xb_ld(&bar[XB_XGEN(b.x)]) == gen, bar);
            __builtin_amdgcn_fence(__ATOMIC_ACQUIRE, "agent");
            asm volatile("s_waitcnt vmcnt(0)" ::: "memory");
        }
    }
    __syncthreads();
}

struct Args { const float* in[22]; float* out; unsigned char* ws; int ph_lo, ph_hi; };

struct WJob { const float* src; bf16* dst; int K, Nsrc, Ndst, mode; float f8scale; float upscale; };
__device__ __forceinline__ void wjob_get(const Args& a, int j, WJob& w) {
    unsigned char* ws = a.ws; w.f8scale = 0.f; w.upscale = 1.f;
    if (j < 2)        { w.src = a.in[7] + (size_t)j * 1024 * 3072;  w.dst = (bf16*)(ws + W_DAIN + (size_t)j * 6 * MiB);   w.K = 1024; w.Nsrc = 3072; w.Ndst = 3072; w.mode = 1; w.f8scale = (j == 1 && (PROJ_FP8 & 4)) ? WGU8_SCALE : 0.f; }
    else if (j < 4)   { const int i = j - 2; w.src = a.in[8] + (size_t)i * 1024 * 1024; w.dst = (bf16*)(ws + W_DAOUT + (size_t)i * 2 * MiB); w.K = 1024; w.Nsrc = 1024; w.Ndst = 1024; w.mode = 0; }
    else if (j == 4)  { w.src = a.in[11]; w.dst = (bf16*)(ws + W_WAIN);  w.K = 1024; w.Nsrc = 1536; w.Ndst = 1536; w.mode = 2; }
    else if (j == 5)  { w.src = a.in[12]; w.dst = (bf16*)(ws + W_WAOUT); w.K = 1024; w.Nsrc = 1024; w.Ndst = 1024; w.mode = 0; }
    else if (j == 6)  { w.src = a.in[14]; w.dst = (bf16*)(ws + W_RETIN); w.K = 1024; w.Nsrc = 6144; w.Ndst = 6144; w.mode = 3; w.f8scale = (PROJ_FP8 & 1) ? WGU8_SCALE : 0.f; }
    else if (j == 7)  { w.src = a.in[15]; w.dst = (bf16*)(ws + W_RETOUT); w.K = 2048; w.Nsrc = 1024; w.Ndst = 1024; w.mode = 0; w.f8scale = RETOUT_FP8 ? WDN8_SCALE : 0.f; }
    else if (j < 10)  { const int i = j - 8;  w.src = a.in[17] + (size_t)i * 1024 * 5632; w.dst = (bf16*)(ws + W_FFNGU + (size_t)i * 11 * MiB); w.K = 1024; w.Nsrc = 5632; w.Ndst = 5632; w.mode = 4; w.f8scale = ((DENSE_FP8 >> i) & 1) ? WGU8_SCALE : 0.f; w.upscale = ((((DENSE_FP8 | DENSE_H8) >> i) & 1) ? H8_SCALE : 1.f) * (1.f / LOG2E_F); }
    else if (j < 12)  { const int i = j - 10; w.src = a.in[18] + (size_t)i * 2816 * 1024; w.dst = (bf16*)(ws + W_FFNDN + (size_t)i * 11 * MiB / 2); w.K = 2816; w.Nsrc = 1024; w.Ndst = 1024; w.mode = 0; w.f8scale = (((DENSE_FP8 | DENSE_H8) >> i) & 1) ? WDN8_SCALE : 0.f; }
    else if (j < 28)  { const int i = j - 12; w.src = a.in[20] + (size_t)i * 1024 * 7168; w.dst = (bf16*)(ws + W_MOEGU + (size_t)i * 7 * MiB); w.K = 1024; w.Nsrc = 7168; w.Ndst = 7168; w.mode = 4; w.f8scale = WGU8_SCALE; w.upscale = H8_SCALE * (1.f / LOG2E_F); }
    else              { const int i = j - 28; w.src = a.in[21] + (size_t)i * 3584 * 1024; w.dst = (bf16*)(ws + W_MOEDN + (size_t)i * 7 * MiB / 2);  w.K = 3584; w.Nsrc = 1024; w.Ndst = 1024; w.mode = 0; w.f8scale = WDN8_SCALE; }
}
constexpr int W_ITEMS = 103936;
__device__ __forceinline__ int wsrc_col(int mode, int n, int Nsrc, float upscale, float& scale) {
    scale = 1.f;
    if (mode == 0) return n;
    if (mode == 1 || mode == 2) {
        const int nrope = (mode == 1) ? 2048 : 1280;
        if (n < 1024) scale = QSCALE;
        if (n >= nrope) return n;
        const int n64 = n & 63, half = n64 >> 5, p = n64 & 31, sg = 4 * (p >> 3) + (p & 3) + 16 * ((p >> 2) & 1);
        return (n & ~63) + 32 * half + sg;
    }
    if (mode == 3) { if (n >= 1024 && n < 2048) scale = 0.0625f; return n; }
    const int F = Nsrc >> 1, pn = n >> 8, w = n & 255;
    scale = (w < 128) ? LOG2E_F : upscale;
    return (w < 128) ? (128 * pn + w) : (F + 128 * pn + (w - 128));
}
__device__ __forceinline__ void p0_transpose_item(const WJob& w, LAS float* scr, int item, int lane) {
    const int nblk = w.Ndst / 32, kb = item / nblk, nb = item % nblk, k0 = 64 * kb, n0 = 32 * nb;
    const int r = lane >> 3, c4 = lane & 7;
    float scale; const int sc = wsrc_col(w.mode, n0 + 4 * c4, w.Nsrc, w.upscale, scale);
    if (w.f8scale != 0.f) scale *= w.f8scale;
    const float* W = w.src + (size_t)(k0 + r) * w.Nsrc + sc;
    f32x4 v[8];
#pragma unroll
    for (int i = 0; i < 8; ++i) v[i] = *(const f32x4*)(W + (size_t)(8 * i) * w.Nsrc);
#pragma unroll
    for (int i = 0; i < 8; ++i) { LAS float* d = scr + (8 * i + r) * 33 + 4 * c4; d[0] = v[i][0] * scale; d[1] = v[i][1] * scale; d[2] = v[i][2] * scale; d[3] = v[i][3] * scale; }
    LDS_WAIT(); asm volatile("" ::: "memory");
    const int c = lane & 7;
#pragma unroll
    for (int j = 0; j < 4; ++j) { const int n = (lane >> 3) + 8 * j; const LAS float* s = scr + (8 * c) * 33 + n;
        if (w.f8scale != 0.f) { v2u o; o.x = pg8::pack4_fp8(s[0 * 33], s[1 * 33], s[2 * 33], s[3 * 33]); o.y = pg8::pack4_fp8(s[4 * 33], s[5 * 33], s[6 * 33], s[7 * 33]);
            *(GAS v2u*)((unsigned char*)w.dst + (size_t)(n0 + n) * w.K + k0 + 8 * c) = o; }
        else { v4u o; o.x = pk2(s[0 * 33], s[1 * 33]); o.y = pk2(s[2 * 33], s[3 * 33]); o.z = pk2(s[4 * 33], s[5 * 33]); o.w = pk2(s[6 * 33], s[7 * 33]);
            *(GAS v4u*)(w.dst + (size_t)(n0 + n) * w.K + k0 + 8 * c) = o; } }
    LDS_WAIT(); asm volatile("" ::: "memory");
}
__device__ __forceinline__ void p0_prologue(const Args& a, LAS unsigned char* lds, int G, int wv) {
    const int tid = opaque_tid(wv), lane = tid & 63, wave = __builtin_amdgcn_readfirstlane(tid >> 6);
    unsigned char* ws = a.ws;
    const int bx = blockIdx.x;
    if (bx < 48) {
        LAS float* s = (LAS float*)lds;
        for (int i = tid; i < 17 * 1024; i += NWAVES * 64) { const float v = (i < 16384) ? a.in[1][i] : a.in[3][i - 16384]; s[(i & 1023) * 20 + (i >> 10)] = v / (1.f + __expf(-v)); }
        __syncthreads();
        const int idx = bx * 512 + tid, l = idx / 6144, n = idx - l * 6144;
        float acc[17];
#pragma unroll
        for (int mi = 0; mi < 17; ++mi) acc[mi] = 0.f;
        const float* wp = a.in[4] + (size_t)l * 1024 * 6144 + n;
#pragma unroll 4
        for (int k = 0; k < 1024; ++k) { const float wv = wp[(size_t)k * 6144];
#pragma unroll
            for (int q = 0; q < 4; ++q) { const f32x4 sv = *(const LAS f32x4*)(s + k * 20 + 4 * q); acc[4 * q] += sv[0] * wv; acc[4 * q + 1] += sv[1] * wv; acc[4 * q + 2] += sv[2] * wv; acc[4 * q + 3] += sv[3] * wv; }
            acc[16] += s[k * 20 + 16] * wv; }
        float* modv = (float*)(ws + WS_MODV); const float bb = a.in[5][l * 6144 + n];
#pragma unroll
        for (int mi = 0; mi < 17; ++mi) modv[(size_t)(l * 17 + mi) * 6144 + n] = acc[mi] + bb;
        __syncthreads();
    }
    { const int gt = bx * (NWAVES * 64) + tid, NT = G * NWAVES * 64;
      float* r1c = (float*)(ws + WS_ROPE1); float* r1s = r1c + 4096 * 128;
      for (int idx = gt; idx < 4096 * 128; idx += NT) { const int pos = idx >> 7, i = idx & 127; const float inv = powf(10000.f, -(float)(2 * i) / 256.f); const float ang = (float)pos * inv;
          double sd, cd; sincos((double)ang, &sd, &cd); r1c[idx] = (float)cd; r1s[idx] = (float)sd; }
      float* r2c = (float*)(ws + WS_ROPE2); float* r2s = r2c + 64 * 16;
      for (int idx = gt; idx < 64 * 16; idx += NT) { const int pos = idx >> 4, i = idx & 15; const float inv = powf(10000.f, -(float)(2 * i) / 32.f); const float ang = (float)pos * inv;
          double sd, cd; sincos((double)ang, &sd, &cd); r2c[idx] = (float)cd; r2s[idx] = (float)sd; }
      float* rw = (float*)(ws + WS_ROUTW);
      for (int idx = gt; idx < 2 * 8 * 1024; idx += NT) { const int l = idx >> 13, e = (idx >> 10) & 7, k = idx & 1023; rw[idx] = a.in[19][((size_t)l * 1024 + k) * 8 + e]; }
      { float* sm = (float*)(ws + WS_SMALL);
        for (int idx = gt; idx < 16384; idx += NT) sm[SM_NORMG + idx] = a.in[6][idx];
        if (gt < 256) sm[SM_SUBLN + gt] = a.in[10][gt];
        if (gt < 16) sm[SM_SINK + gt] = a.in[13][gt];
        if (gt < 8) sm[SM_DECAY + gt] = a.in[16][gt]; }
      if (gt < 2) { const float* lp = a.in[9] + gt * 256; float s01 = 0.f, s23 = 0.f;
          for (int i = 0; i < 64; ++i) { s01 += lp[i] * lp[64 + i]; s23 += lp[128 + i] * lp[192 + i]; }
          const float lam_init = 0.8f - 0.6f * expf(-0.3f * (float)(gt == 0 ? 0 : 3));
          ((float*)(ws + WS_SCAL))[gt] = expf(s01) - expf(s23) + lam_init; }
    }
    { LAS float* scr = (LAS float*)(lds + wave * 16384);
      gu32* wq = (gu32*)(ws + WS_CTL) + CW_WQ;
      constexpr int CH = 8;
      int j = 0, base = 0; WJob w; wjob_get(a, 0, w); int n = (w.K / 64) * (w.Ndst / 32);
      for (;;) {
          unsigned i0 = 0; if (lane == 0) i0 = __hip_atomic_fetch_add(wq, (unsigned)CH, RLX_AGENT); i0 = __builtin_amdgcn_readfirstlane(i0);
          if (i0 >= (unsigned)W_ITEMS) break;
          for (int t = 0; t < CH; ++t) { const int it = (int)i0 + t; if (it >= W_ITEMS) break;
              while (it >= base + n) { base += n; ++j; wjob_get(a, j, w); n = (w.K / 64) * (w.Ndst / 32); }
              p0_transpose_item(w, scr, it - base, lane); } } }
}

#define RC(j) (8 * lane + 512 * ((j) >> 1) + 4 * ((j) & 1))
template <int VAR, bool ROUTE, bool FINAL, bool A8 = false, bool NOCTX = false>
__device__ __forceinline__ void resid_phase(unsigned char* ws, float* outp, const float* in_x, const float* in_ctx, LAS unsigned char* lds, const bf16* Ysrc, int layY, int subY, int layA, int subA, int moe_l, int G, int wv) {
    const int tid = opaque_tid(wv), lane = tid & 63, wave = __builtin_amdgcn_readfirstlane(tid >> 6);
    const int gw = blockIdx.x * NWAVES + wave, NGW = G * NWAVES;
    const float* modv = (const float*)(ws + WS_MODV);
    bf16* X = (bf16*)(ws + WS_X); bf16* AY = (bf16*)outp;
    const float* ngY = (const float*)(ws + WS_SMALL) + SM_NORMG + (size_t)(layY * 4 + (subY ? 3 : 1)) * 1024;
    const float* ngA = (const float*)(ws + WS_SMALL) + SM_NORMG + (size_t)(layA * 4 + (subA ? 2 : 0)) * 1024;
    gu32* ctl = (gu32*)(ws + WS_CTL);
    int ts[9];
    if (VAR == 2) { ts[0] = 0;
#pragma unroll
        for (int e = 0; e < 8; ++e) { const unsigned c = (unsigned)__builtin_amdgcn_readfirstlane((int)__hip_atomic_load(ctl + CW_MOECNT + 16 * moe_l + e, RLX_AGENT)); ts[e + 1] = ts[e] + (int)((c + 255u) >> 8); } }
    const int moe_r = ROUTE ? moe_l : 0;
    LAS float* wr = (LAS float*)lds; LAS int* lcnt = (LAS int*)(lds + 32768); LAS int* lbase = lcnt + 8; LAS unsigned* info = (LAS unsigned*)(lds + 33024) + wave * (40 * 4);
    if (ROUTE) { const float* rw = (const float*)(ws + WS_ROUTW) + (size_t)moe_r * 8192;
        for (int i = tid; i < 8192; i += NWAVES * 64) wr[i] = rw[i];
        if (tid < 8) lcnt[tid] = 0;
        __syncthreads(); }
    constexpr int NR = RESID_NR;
    const int RPW = (TA + NGW - 1) / NGW, rbeg = gw * RPW, rend = (rbeg + RPW < TA) ? rbeg + RPW : TA;
    f32x4 ngY_r[4], ngA_r[4], gate_r[4], sh_r[4], sc_r[4]; int miY = -1, miA = -1;
#pragma unroll
    for (int j = 0; j < 4; ++j) { ngY_r[j] = *(const f32x4*)(ngY + RC(j)); ngA_r[j] = *(const f32x4*)(ngA + RC(j)); }
    for (int r0 = rbeg, nrow = 0; r0 < rend; r0 += NR, nrow += NR) {
        int rr[NR], bb[NR], pp[NR], mi[NR]; bool isctx[NR], act[NR];
#pragma unroll
        for (int u = 0; u < NR; ++u) { rr[u] = r0 + u; const bool valid = rr[u] < rend; const int rq = valid ? rr[u] : r0; bb[u] = rq / RPB; pp[u] = rq - bb[u] * RPB; isctx[u] = pp[u] < CTXL; mi[u] = isctx[u] ? 16 : bb[u];
            act[u] = valid && !((NOCTX || FINAL) && isctx[u]);
            if (ROUTE && valid && !act[u] && lane == 0) info[(nrow + u) * 4] = 0xffu;
            rr[u] = rq; }
        f32x4 xv[NR][4]; v2u xraw[NR][4], yraw[NR][4], y1raw[NR][4]; v4u ti[NR];
#pragma unroll
        for (int u = 0; u < NR; ++u) if (act[u]) {
            if (VAR == 0) { const float* src = isctx[u] ? in_ctx + ((size_t)bb[u] * CTXL + pp[u]) * DM : in_x + ((size_t)bb[u] * SEQL + (pp[u] - CTXL)) * DM;
#pragma unroll
                for (int j = 0; j < 4; ++j) xv[u][j] = *(const f32x4*)(src + RC(j)); }
            else { const bf16* xr = X + (size_t)rr[u] * DM;
#pragma unroll
                for (int jj = 0; jj < 2; ++jj) { const v4u w4_ = *(const v4u*)(xr + RC(2 * jj)); xraw[u][2 * jj] = (v2u){w4_.x, w4_.y}; xraw[u][2 * jj + 1] = (v2u){w4_.z, w4_.w}; }
                if (VAR == 1) { const bf16* yr = Ysrc + (size_t)rr[u] * DM;
#pragma unroll
                    for (int jj = 0; jj < 2; ++jj) { const v4u w4_ = *(const v4u*)(yr + RC(2 * jj)); yraw[u][2 * jj] = (v2u){w4_.x, w4_.y}; yraw[u][2 * jj + 1] = (v2u){w4_.z, w4_.w}; } }
                else ti[u] = *(const v4u*)(ws + WS_TOKINFO + (size_t)rr[u] * 16); } }
        float g0v[NR], g1v[NR];
        if (VAR == 2) {
#pragma unroll
            for (int u = 0; u < NR; ++u) if (act[u]) {
                const int e0 = ti[u].x & 15, e1 = ti[u].y & 15; int s0 = 0, s1 = 0;
#pragma unroll
                for (int e = 0; e < 8; ++e) { s0 = (e == e0) ? ts[e] : s0; s1 = (e == e1) ? ts[e] : s1; }
                s0 = s0 * 256 + (int)(ti[u].x >> 4); s1 = s1 * 256 + (int)(ti[u].y >> 4);
                const unsigned gz_ = ti[u].z, gw_ = ti[u].w;
                g0v[u] = __uint_as_float(gz_); g1v[u] = __uint_as_float(gw_);
                const bf16* y0 = (const bf16*)(ws + BIG_YE) + (size_t)s0 * DM; const bf16* y1 = (const bf16*)(ws + BIG_YE) + (size_t)s1 * DM;
#pragma unroll
                for (int jj = 0; jj < 2; ++jj) { const v4u a4_ = *(const v4u*)(y0 + RC(2 * jj)), b4_ = *(const v4u*)(y1 + RC(2 * jj));
                    yraw[u][2 * jj] = (v2u){a4_.x, a4_.y}; yraw[u][2 * jj + 1] = (v2u){a4_.z, a4_.w}; y1raw[u][2 * jj] = (v2u){b4_.x, b4_.y}; y1raw[u][2 * jj + 1] = (v2u){b4_.z, b4_.w}; } } }
#pragma unroll
        for (int u = 0; u < NR; ++u) if (act[u]) {
        const int r = rr[u], b = bb[u], p = pp[u];
        if (VAR != 0) {
            f32x4 yv[4];
#pragma unroll
            for (int j = 0; j < 4; ++j) { const v2u w = yraw[u][j]; yv[j] = (f32x4){bflo(w.x), bfhi(w.x), bflo(w.y), bfhi(w.y)};
                if (VAR == 2) { const v2u w1 = y1raw[u][j]; yv[j] = yv[j] * g0v[u] + (f32x4){bflo(w1.x), bfhi(w1.x), bflo(w1.y), bfhi(w1.y)} * g1v[u]; } }
            float ss = 0.f;
#pragma unroll
            for (int j = 0; j < 4; ++j) ss += (yv[j].x * yv[j].x + yv[j].y * yv[j].y) + (yv[j].z * yv[j].z + yv[j].w * yv[j].w);
            const float rstd = __builtin_amdgcn_rsqf(wave_sum(ss) * (1.f / DM) + NORM_EPS);
            if (mi[u] != miY) { miY = mi[u]; const float* gate = modv + ((size_t)(layY * 17 + miY) * 6 + (subY ? 5 : 2)) * 1024;
#pragma unroll
                for (int j = 0; j < 4; ++j) gate_r[j] = *(const f32x4*)(gate + RC(j)) * ngY_r[j]; }
#pragma unroll
            for (int j = 0; j < 4; ++j) { const f32x4 g = gate_r[j]; const v2u xw_ = xraw[u][j]; const f32x4 x0 = (f32x4){bflo(xw_.x), bfhi(xw_.x), bflo(xw_.y), bfhi(xw_.y)};
                xv[u][j] = x0 + g * (yv[j] * rstd); }
        }
        if (FINAL) { float* orow = outp + ((size_t)b * SEQL + (p - CTXL)) * DM;
#pragma unroll
                for (int j = 0; j < 4; ++j) *(f32x4*)(orow + RC(j)) = xv[u][j]; }
        else {
            bf16* xw = X + (size_t)r * DM;
#pragma unroll
            for (int jj = 0; jj < 2; ++jj) { v4u w; w.x = pk2(xv[u][2 * jj].x, xv[u][2 * jj].y); w.y = pk2(xv[u][2 * jj].z, xv[u][2 * jj].w); w.z = pk2(xv[u][2 * jj + 1].x, xv[u][2 * jj + 1].y); w.w = pk2(xv[u][2 * jj + 1].z, xv[u][2 * jj + 1].w);
                *(v4u*)(xw + RC(2 * jj)) = w;
                xv[u][2 * jj] = (f32x4){bflo(w.x), bfhi(w.x), bflo(w.y), bfhi(w.y)}; xv[u][2 * jj + 1] = (f32x4){bflo(w.z), bfhi(w.z), bflo(w.w), bfhi(w.w)}; }
            float ss = 0.f;
#pragma unroll
            for (int j = 0; j < 4; ++j) ss += (xv[u][j].x * xv[u][j].x + xv[u][j].y * xv[u][j].y) + (xv[u][j].z * xv[u][j].z + xv[u][j].w * xv[u][j].w);
            const float rstd = __builtin_amdgcn_rsqf(wave_sum(ss) * (1.f / DM) + NORM_EPS);
            if (mi[u] != miA) { miA = mi[u]; const float* sh = modv + ((size_t)(layA * 17 + miA) * 6 + (subA ? 3 : 0)) * 1024; const float* sc = sh + 1024;
#pragma unroll
                for (int j = 0; j < 4; ++j) { sh_r[j] = *(const f32x4*)(sh + RC(j)); sc_r[j] = (*(const f32x4*)(sc + RC(j)) + 1.f) * ngA_r[j]; } }
            bf16* ar = AY + (size_t)r * DM; f32x4 av[4];
#pragma unroll
            for (int j = 0; j < 4; ++j) { const f32x4 s1 = sc_r[j], s0 = sh_r[j]; av[j] = (xv[u][j] * rstd) * s1 + s0; }
#pragma unroll
            for (int jj = 0; jj < 2; ++jj) { const int c = RC(2 * jj); const f32x4 a0 = av[2 * jj], a1 = av[2 * jj + 1];
                if (A8) { v2u w8; w8.x = pg8::pack4_fp8(a0.x * A8_SCALE, a0.y * A8_SCALE, a0.z * A8_SCALE, a0.w * A8_SCALE); w8.y = pg8::pack4_fp8(a1.x * A8_SCALE, a1.y * A8_SCALE, a1.z * A8_SCALE, a1.w * A8_SCALE);
                    *(v2u*)((unsigned char*)outp + A8_OFF + (size_t)r * DM + c) = w8; }
                else { v4u w; w.x = pk2(a0.x, a0.y); w.y = pk2(a0.z, a0.w); w.z = pk2(a1.x, a1.y); w.w = pk2(a1.z, a1.w); *(v4u*)(ar + c) = w; } }
            if (ROUTE) {
                float lg[8];
#pragma unroll
                for (int e = 0; e < 8; ++e) { float s = 0.f;
#pragma unroll
                    for (int j = 0; j < 4; ++j) { const f32x4 w4 = *(const LAS f32x4*)(wr + e * 1024 + RC(j)); s += (av[j].x * w4.x + av[j].y * w4.y) + (av[j].z * w4.z + av[j].w * w4.w); }
                    lg[e] = wave_sum(s); }
                int i0 = 0; float v0 = lg[0];
#pragma unroll
                for (int e = 1; e < 8; ++e) if (lg[e] > v0) { v0 = lg[e]; i0 = e; }
                int i1 = 0; float v1 = -3.0e38f;
#pragma unroll
                for (int e = 0; e < 8; ++e) if (e != i0 && lg[e] > v1) { v1 = lg[e]; i1 = e; }
                const float g0 = 1.f / (1.f + __expf(v1 - v0)), g1 = 1.f - g0;
                if (lane == 0) { const int q0_ = __hip_atomic_fetch_add(lcnt + i0, 1, __ATOMIC_RELAXED, __HIP_MEMORY_SCOPE_WORKGROUP), q1_ = __hip_atomic_fetch_add(lcnt + i1, 1, __ATOMIC_RELAXED, __HIP_MEMORY_SCOPE_WORKGROUP);
                    LAS unsigned* q = info + (nrow + u) * 4; q[0] = (unsigned)i0; q[1] = (unsigned)q0_; q[2] = (unsigned)i1; q[3] = (unsigned)q1_;
                    v2u gg; gg.x = __builtin_bit_cast(unsigned, g0); gg.y = __builtin_bit_cast(unsigned, g1); *(v2u*)(ws + WS_TOKINFO + (size_t)r * 16 + 8) = gg; }
            }
        }
        }
    }
    if (ROUTE) {
        __syncthreads();
        if (tid < 8) lbase[tid] = (int)__hip_atomic_fetch_add(ctl + CW_MOECNT + 16 * moe_r + tid, (unsigned)lcnt[tid], RLX_AGENT);
        __syncthreads();
        if (lane == 0) { int k = 0; int* lists = (int*)(ws + WS_LISTS);
            for (int r = rbeg; r < rend; ++r, ++k) { const LAS unsigned* q = info + k * 4; if (q[0] == 0xffu) continue; const int e0 = (int)q[0], e1 = (int)q[2]; const int r0 = (int)q[1] + lbase[e0], r1 = (int)q[3] + lbase[e1];
                lists[(size_t)e0 * TA + r0] = r; lists[(size_t)e1 * TA + r1] = r;
                v2u ti; ti.x = (unsigned)e0 | ((unsigned)r0 << 4); ti.y = (unsigned)e1 | ((unsigned)r1 << 4);
                *(v2u*)(ws + WS_TOKINFO + (size_t)r * 16) = ti; } }
        __syncthreads();
    }
}

namespace att {
#define SBAR() __builtin_amdgcn_sched_barrier(0)
#define SWZX(v, k) __builtin_bit_cast(float, __builtin_amdgcn_ds_swizzle(__builtin_bit_cast(int, (float)(v)), ((k) << 10) | 0x1f))
constexpr float THRL = 8.f;
__device__ __forceinline__ int crow(int r, int hi) { return (r & 3) + 8 * (r >> 2) + 4 * hi; }
__device__ __forceinline__ unsigned cvtpk(float lo, float hi) { unsigned r; asm volatile("v_cvt_pk_bf16_f32 %0, %1, %2" : "=v"(r) : "v"(lo), "v"(hi)); return r; }
__device__ __forceinline__ void partialSM(f32x16& p0, f32x16& p1, float& m_reg, float& mn, float& alpha) {
    float pmax = p0[0];
#pragma unroll
    for (int r = 1; r < 16; ++r) pmax = fmaxf(pmax, p0[r]);
#pragma unroll
    for (int r = 0; r < 16; ++r) pmax = fmaxf(pmax, p1[r]);
    { auto rr = __builtin_amdgcn_permlane32_swap(__float_as_uint(pmax), __float_as_uint(pmax), false, false);
      pmax = fmaxf(__uint_as_float(rr[0]), __uint_as_float(rr[1])); }
    if (__builtin_expect(__all(pmax - m_reg <= THRL), 1)) { mn = m_reg; alpha = 1.f; }
    else { mn = fmaxf(m_reg, pmax); alpha = __builtin_amdgcn_exp2f(m_reg - mn); m_reg = mn; }
#pragma unroll
    for (int r = 0; r < 16; ++r) p0[r] = p0[r] - mn;
#pragma unroll
    for (int r = 0; r < 16; ++r) p1[r] = p1[r] - mn;
#pragma unroll
    for (int r = 0; r < 16; ++r) p0[r] = __builtin_amdgcn_exp2f(p0[r]);
}

__device__ __forceinline__ float sm_max16(const f32x16& p) { float a = p[0];
#pragma unroll
    for (int r = 1; r < 16; ++r) a = fmaxf(a, p[r]);
    return a; }
__device__ __forceinline__ void sm_decide(float pmax, float& m_reg, float& mn, float& alpha) {
    { auto rr = __builtin_amdgcn_permlane32_swap(__float_as_uint(pmax), __float_as_uint(pmax), false, false);
      pmax = fmaxf(__uint_as_float(rr[0]), __uint_as_float(rr[1])); }
    if (__builtin_expect(__all(pmax - m_reg <= THRL), 1)) { mn = m_reg; alpha = 1.f; }
    else { mn = fmaxf(m_reg, pmax); alpha = __builtin_amdgcn_exp2f(m_reg - mn); m_reg = mn; } }
__device__ __forceinline__ void sm_subexp(f32x16& p, float mn) {
#pragma unroll
    for (int r = 0; r < 16; ++r) p[r] = __builtin_amdgcn_exp2f(p[r] - mn); }
__device__ __forceinline__ void sm_sub(f32x16& p, float mn) {
#pragma unroll
    for (int r = 0; r < 16; ++r) p[r] = p[r] - mn; }
__device__ __forceinline__ void finishSM(f32x16& p0, f32x16& p1, float alpha, float& l_reg, bf16x8& pa0, bf16x8& pa1, bf16x8& pa2, bf16x8& pa3) {
#pragma unroll
    for (int r = 0; r < 16; ++r) p1[r] = __builtin_amdgcn_exp2f(p1[r]);
    float ps = 0;
#pragma unroll
    for (int r = 0; r < 16; ++r) ps += p0[r];
#pragma unroll
    for (int r = 0; r < 16; ++r) ps += p1[r];
    { auto rr = __builtin_amdgcn_permlane32_swap(__float_as_uint(ps), __float_as_uint(ps), false, false);
      ps = __uint_as_float(rr[0]) + __uint_as_float(rr[1]); }
    l_reg = l_reg * alpha + ps;
#define PK4(P, BASE, OUT) do { unsigned a0 = cvtpk(P[BASE + 0], P[BASE + 1]), a1 = cvtpk(P[BASE + 2], P[BASE + 3]);   \
    unsigned b0 = cvtpk(P[BASE + 4], P[BASE + 5]), b1 = cvtpk(P[BASE + 6], P[BASE + 7]);                              \
    v4u w = {a0, a1, b0, b1}; OUT = __builtin_bit_cast(bf16x8, w); } while (0)
    PK4(p0, 0, pa0); PK4(p0, 8, pa1); PK4(p1, 0, pa2); PK4(p1, 8, pa3);
#undef PK4
}
template <int NCB> __device__ __forceinline__ int v_st(int k, int c) { const int kk = k; return ((kk >> 3) * NCB + (c >> 5)) * 512 + ((kk & 7) * 32 + (c & 31)) * 2; }
__device__ __forceinline__ int v_rd_base(int lane) { return ((lane & 3) << 3) | (((lane >> 2) & 3) << 6) | (((lane >> 4) & 1) << 5) | (((lane >> 5) & 1) << 8); }
template <int OFF> __device__ __forceinline__ s16x4 tr_read(int vb) { s16x4 r; asm volatile("ds_read_b64_tr_b16 %0, %1 offset:%2" : "=&v"(r) : "v"(vb), "i"(OFF) : "memory"); return r; }
template <int D0, int NCB> __device__ __forceinline__ void pv_one(f32x16& od, int vb, bf16x8 pa0, bf16x8 pa1, bf16x8 pa2, bf16x8 pa3) {
#define VOFF(ks, half) (((2 * (ks) + (half)) * NCB + D0) * 512)
    const s16x4 l0 = tr_read<VOFF(0, 0)>(vb), h0 = tr_read<VOFF(0, 1)>(vb), l1 = tr_read<VOFF(1, 0)>(vb), h1 = tr_read<VOFF(1, 1)>(vb);
    const s16x4 l2 = tr_read<VOFF(2, 0)>(vb), h2 = tr_read<VOFF(2, 1)>(vb), l3 = tr_read<VOFF(3, 0)>(vb), h3 = tr_read<VOFF(3, 1)>(vb);
#undef VOFF
    asm volatile("s_waitcnt lgkmcnt(0)" ::: "memory"); SBAR();
#define PK(L, H) (bf16x8){L[0], L[1], L[2], L[3], H[0], H[1], H[2], H[3]}
    od = __builtin_amdgcn_mfma_f32_32x32x16_bf16(pa0, PK(l0, h0), od, 0, 0, 0);
    od = __builtin_amdgcn_mfma_f32_32x32x16_bf16(pa1, PK(l1, h1), od, 0, 0, 0);
    od = __builtin_amdgcn_mfma_f32_32x32x16_bf16(pa2, PK(l2, h2), od, 0, 0, 0);
    od = __builtin_amdgcn_mfma_f32_32x32x16_bf16(pa3, PK(l3, h3), od, 0, 0, 0);
#undef PK
}

constexpr int DA_LD = 3072, SHM_T = 64 * 128 * 2;
#define KSWZ(row, colB) ((row) * 256 + ((colB) ^ (((row) & 7) << 4)))
__device__ __forceinline__ void da_unit64(const bf16* __restrict__ QKV_, bf16* __restrict__ O_, int b, int h, int q0, int nkeys, float lam, float oscale, const float* __restrict__ subg, char* lds, int wv) {
    const int tid = opaque_tid(wv), wid = __builtin_amdgcn_readfirstlane(tid >> 6), lane = tid & 63, r32 = lane & 31, hi = lane >> 5, mp = wid >> 2, rgi = wid & 3;
    const bf16* QKV = QKV_; bf16* O = O_; asm volatile("" : "+s"(QKV), "+s"(O));
    char* V_lds = lds; char* K_lds = lds + 2 * SHM_T;
    char* Q1_lds = lds + 4 * SHM_T;
    float* wsf = (float*)(lds + 6 * SHM_T) + wid * 128;
    const size_t rb0 = (size_t)b * RPB;
    float m_reg[2] = {0.f, 0.f}, l_reg[2] = {0.f, 0.f}; f32x16 o[2][4] = {}; bf16x8 qr[4]; asm volatile("" : "+v"(m_reg[0]), "+v"(m_reg[1]));
    { const bf16* Qw = QKV + (rb0 + q0 + rgi * 64 + r32) * DA_LD + h * 128 + mp * 64 + hi * 8;
#pragma unroll
        for (int d0 = 0; d0 < 4; ++d0) qr[d0] = *(const bf16x8*)(Qw + d0 * 16);
#pragma unroll
        for (int i = 0; i < 4; ++i) { const int p = tid + 512 * i, row = p >> 4, ch = p & 15;
            const bf16x8 v = *(const bf16x8*)(QKV + (rb0 + q0 + (row >> 5) * 64 + 32 + (row & 31)) * DA_LD + h * 128 + ch * 8);
            *(bf16x8*)(Q1_lds + row * 256 + ((ch ^ (row & 7)) << 4)) = v; } }
    const int q1off = (rgi * 32 + r32) * 256;
    const bf16* Kh = QKV + rb0 * DA_LD + 1024 + h * 128; const bf16* Vh = Kh + 1024;
    const int vb0 = (int)(uintptr_t)V_lds + v_rd_base(lane);
    const unsigned ldsK = (unsigned)(uintptr_t)K_lds + wid * 2048u, ldsV = (unsigned)(uintptr_t)V_lds + wid * 2048u;
#define DMA1(voffs, gbase, ldsdst) do { unsigned keep_; asm volatile("s_mov_b32 %0, m0\n\ts_mov_b32 m0, %3\n\ts_nop 0\n\tglobal_load_lds_dwordx4 %1, %2\n\ts_mov_b32 m0, %0" : "=&s"(keep_) : "v"(voffs), "s"(gbase), "s"((unsigned)__builtin_amdgcn_readfirstlane((int)(ldsdst))) : "memory"); } while (0)
#define DMA_TILE(k0, bq) do { const char* kb_ = (const char*)(Kh + (size_t)(k0) * DA_LD); const char* vb_ = (const char*)(Vh + (size_t)(k0) * DA_LD); \
    int t_ = tid; asm volatile("" : "+v"(t_)); const int ln = t_ & 63;       \
    _Pragma("unroll") for (int t = 0; t < 2; ++t) { const int i = wid * 2 + t; \
        const int row = 4 * i + (ln >> 4), chp = ln & 15, gch = chp ^ (row & 7); const unsigned koff_ = __umul24((unsigned)row, (unsigned)(DA_LD * 2)) + (unsigned)(gch * 16);   \
        const int p16 = 64 * i + ln, sub = p16 >> 5, within = p16 & 31, kk = (sub >> 2) * 8 + (within >> 2), c = (sub & 3) * 32 + (within & 3) * 8; \
        const int k = kk; const unsigned voff_ = __umul24((unsigned)k, (unsigned)(DA_LD * 2)) + (unsigned)(c * 2); \
        DMA1(koff_, kb_, ldsK + (bq) * SHM_T + 1024u * t); DMA1(voff_, vb_, ldsV + (bq) * SHM_T + 1024u * t); } } while (0)
#define DMA_WAIT_BAR() do { asm volatile("s_waitcnt vmcnt(0)" ::: "memory"); __syncthreads(); } while (0)
    const int NT = nkeys / 64;
    DMA_TILE(0, 0); DMA_WAIT_BAR();
    for (int j = 0; j < NT; ++j) {
        const char* Kb = K_lds + (j & 1) * SHM_T; const int vb = vb0 + (j & 1) * SHM_T;
        if (j + 1 < NT) DMA_TILE((j + 1) * 64, (j + 1) & 1);
        f32x16 p[2][2];
#define QK_ALL() do { _Pragma("unroll") for (int rb = 0; rb < 2; ++rb) { \
            const v4u aw = {hi ? 0u : 0x3F80u, 0u, 0u, 0u}, bw = {__float_as_uint(-m_reg[rb]) >> 16, 0u, 0u, 0u}; \
            p[rb][0] = __builtin_amdgcn_mfma_f32_32x32x16_bf16(__builtin_bit_cast(bf16x8, aw), __builtin_bit_cast(bf16x8, bw), f32x16{}, 0, 0, 0); \
            p[rb][1] = __builtin_amdgcn_mfma_f32_32x32x16_bf16(__builtin_bit_cast(bf16x8, aw), __builtin_bit_cast(bf16x8, bw), f32x16{}, 0, 0, 0); } \
        _Pragma("unroll") for (int d0 = 0; d0 < 4; ++d0) { const int cb = ((mp * 4 + d0) * 16 + hi * 8) * 2; \
            const bf16x8 k0 = *(const bf16x8*)(Kb + KSWZ(r32, cb)), k1 = *(const bf16x8*)(Kb + KSWZ(32 + r32, cb)); \
            const bf16x8 q1 = *(const bf16x8*)(Q1_lds + q1off + (((mp * 8 + d0 * 2 + hi) ^ (r32 & 7)) << 4)); \
            p[0][0] = __builtin_amdgcn_mfma_f32_32x32x16_bf16(k0, qr[d0], p[0][0], 0, 0, 0); p[0][1] = __builtin_amdgcn_mfma_f32_32x32x16_bf16(k1, qr[d0], p[0][1], 0, 0, 0); \
            p[1][0] = __builtin_amdgcn_mfma_f32_32x32x16_bf16(k0, q1, p[1][0], 0, 0, 0); p[1][1] = __builtin_amdgcn_mfma_f32_32x32x16_bf16(k1, q1, p[1][1], 0, 0, 0); \
            SBAR(); } } while (0)
#define EXPSUM(rb) do { _Pragma("unroll") for (int r = 0; r < 16; ++r) { p[rb][0][r] = __builtin_amdgcn_exp2f(p[rb][0][r]); p[rb][1][r] = __builtin_amdgcn_exp2f(p[rb][1][r]); } \
            float ps_ = p[rb][0][0]; _Pragma("unroll") for (int r = 1; r < 16; ++r) ps_ += p[rb][0][r]; _Pragma("unroll") for (int r = 0; r < 16; ++r) ps_ += p[rb][1][r]; \
            { auto rr = __builtin_amdgcn_permlane32_swap(__float_as_uint(ps_), __float_as_uint(ps_), false, false); ps_ = __uint_as_float(rr[0]) + __uint_as_float(rr[1]); } psv[rb] = ps_; } while (0)
#define QK_ONE(rb) do { int tq_ = tid; asm volatile("" : "+v"(tq_)); const int r32q = tq_ & 31, hiq = (tq_ >> 5) & 1; \
        { const v4u aw = {hiq ? 0u : 0x3F80u, 0u, 0u, 0u}, bw = {__float_as_uint(-m_reg[rb]) >> 16, 0u, 0u, 0u}; \
            p[rb][0] = __builtin_amdgcn_mfma_f32_32x32x16_bf16(__builtin_bit_cast(bf16x8, aw), __builtin_bit_cast(bf16x8, bw), f32x16{}, 0, 0, 0); \
            p[rb][1] = __builtin_amdgcn_mfma_f32_32x32x16_bf16(__builtin_bit_cast(bf16x8, aw), __builtin_bit_cast(bf16x8, bw), f32x16{}, 0, 0, 0); } \
        _Pragma("unroll") for (int d0 = 0; d0 < 4; ++d0) { const int cb = ((mp * 4 + d0) * 16 + hiq * 8) * 2; \
            const bf16x8 k0 = *(const bf16x8*)(Kb + KSWZ(r32q, cb)), k1 = *(const bf16x8*)(Kb + KSWZ(32 + r32q, cb)); \
            const bf16x8 qq = (rb) ? *(const bf16x8*)(Q1_lds + (rgi * 32 + r32q) * 256 + (((mp * 8 + d0 * 2 + hiq) ^ (r32q & 7)) << 4)) : qr[d0]; \
            p[rb][0] = __builtin_amdgcn_mfma_f32_32x32x16_bf16(k0, qq, p[rb][0], 0, 0, 0); p[rb][1] = __builtin_amdgcn_mfma_f32_32x32x16_bf16(k1, qq, p[rb][1], 0, 0, 0); \
            SBAR(); } } while (0)
#define ROWMAX(rb, pm) do { pm = fmaxf(sm_max16(p[rb][0]), sm_max16(p[rb][1])); \
        auto rr = __builtin_amdgcn_permlane32_swap(__float_as_uint(pm), __float_as_uint(pm), false, false); pm = fmaxf(__uint_as_float(rr[0]), __uint_as_float(rr[1])); } while (0)
        QK_ALL();
        bf16x8 pa[2][4]; float psv[2];
#pragma unroll
        for (int rb = 0; rb < 2; ++rb) {
            float al = 1.f; bool raw = (j == 0);
            if (!raw) {
                EXPSUM(rb);
                if (__builtin_expect(__any(!(psv[rb] <= 256.f)), 0)) {
                    float pm; ROWMAX(rb, pm);
                    if (__any(!(pm < 3e38f))) raw = true;
                    else { float d = fmaxf(__builtin_amdgcn_logf(pm), 0.f); const float mnew = __uint_as_float(pk2(0.f, m_reg[rb] + d) & 0xffff0000u); d = mnew - m_reg[rb]; m_reg[rb] = mnew;
                        al = __builtin_amdgcn_exp2f(-d); psv[rb] *= al;
#pragma unroll
                        for (int r = 0; r < 16; ++r) { p[rb][0][r] *= al; p[rb][1][r] *= al; } } } }
            if (__builtin_expect(raw, 0)) {
                if (j != 0) QK_ONE(rb);
                float pm; ROWMAX(rb, pm);
                const float mnew = __uint_as_float(pk2(0.f, m_reg[rb] + (j == 0 ? pm : fmaxf(pm, 0.f))) & 0xffff0000u), d = mnew - m_reg[rb];
                m_reg[rb] = mnew; al = __builtin_amdgcn_exp2f(-d); sm_sub(p[rb][0], d); sm_sub(p[rb][1], d);
                EXPSUM(rb); }
            const float ps = psv[rb];
            l_reg[rb] = l_reg[rb] * al + ps;
#define PK4(P, BASE, OUT) do { unsigned a0 = cvtpk(P[BASE + 0], P[BASE + 1]), a1 = cvtpk(P[BASE + 2], P[BASE + 3]);   \
    unsigned b0 = cvtpk(P[BASE + 4], P[BASE + 5]), b1 = cvtpk(P[BASE + 6], P[BASE + 7]);                              \
    v4u w = {a0, a1, b0, b1}; OUT = __builtin_bit_cast(bf16x8, w); } while (0)
            PK4(p[rb][0], 0, pa[rb][0]); PK4(p[rb][0], 8, pa[rb][1]); PK4(p[rb][1], 0, pa[rb][2]); PK4(p[rb][1], 8, pa[rb][3]);
#undef PK4
            if (__any(al < 1.f)) { float* al_l = wsf + 64 + rb * 32; if (hi == 0) al_l[r32] = al; asm volatile("s_waitcnt lgkmcnt(0)" ::: "memory");
#pragma unroll
                for (int d = 0; d < 4; ++d)
#pragma unroll
                    for (int r = 0; r < 16; ++r) o[rb][d][r] *= al_l[crow(r, hi)]; }
        }
#undef QK_ALL
#undef QK_ONE
#undef ROWMAX
#undef EXPSUM
#define PV_READ(D0, v) do { v[0] = tr_read<((0) * 4 + D0) * 512>(vb); v[1] = tr_read<((1) * 4 + D0) * 512>(vb); v[2] = tr_read<((2) * 4 + D0) * 512>(vb); v[3] = tr_read<((3) * 4 + D0) * 512>(vb); \
        v[4] = tr_read<((4) * 4 + D0) * 512>(vb); v[5] = tr_read<((5) * 4 + D0) * 512>(vb); v[6] = tr_read<((6) * 4 + D0) * 512>(vb); v[7] = tr_read<((7) * 4 + D0) * 512>(vb); } while (0)
#define PV_MMA(D0, v) do { \
        const bf16x8 f0 = (bf16x8){v[0][0], v[0][1], v[0][2], v[0][3], v[1][0], v[1][1], v[1][2], v[1][3]}, f1 = (bf16x8){v[2][0], v[2][1], v[2][2], v[2][3], v[3][0], v[3][1], v[3][2], v[3][3]}; \
        const bf16x8 f2 = (bf16x8){v[4][0], v[4][1], v[4][2], v[4][3], v[5][0], v[5][1], v[5][2], v[5][3]}, f3 = (bf16x8){v[6][0], v[6][1], v[6][2], v[6][3], v[7][0], v[7][1], v[7][2], v[7][3]}; \
        _Pragma("unroll") for (int rb = 0; rb < 2; ++rb) { o[rb][D0] = __builtin_amdgcn_mfma_f32_32x32x16_bf16(pa[rb][0], f0, o[rb][D0], 0, 0, 0); o[rb][D0] = __builtin_amdgcn_mfma_f32_32x32x16_bf16(pa[rb][1], f1, o[rb][D0], 0, 0, 0); \
            o[rb][D0] = __builtin_amdgcn_mfma_f32_32x32x16_bf16(pa[rb][2], f2, o[rb][D0], 0, 0, 0); o[rb][D0] = __builtin_amdgcn_mfma_f32_32x32x16_bf16(pa[rb][3], f3, o[rb][D0], 0, 0, 0); } } while (0)
        { s16x4 va[8], vc[8];
          PV_READ(0, va);
          PV_READ(1, vc); asm volatile("s_waitcnt lgkmcnt(8)" ::: "memory"); SBAR(); PV_MMA(0, va); SBAR();
          PV_READ(2, va); asm volatile("s_waitcnt lgkmcnt(8)" ::: "memory"); SBAR(); PV_MMA(1, vc); SBAR();
          PV_READ(3, vc); asm volatile("s_waitcnt lgkmcnt(8)" ::: "memory"); SBAR(); PV_MMA(2, va); SBAR();
          asm volatile("s_waitcnt lgkmcnt(0)" ::: "memory"); SBAR(); PV_MMA(3, vc); }
#undef PV_READ
#undef PV_MMA
        DMA_WAIT_BAR();
    }
    float* xch = (float*)lds;
    int tide_ = tid; asm volatile("" : "+v"(tide_)); const int lanee = tide_ & 63, r32e = lanee & 31, hie = lanee >> 5;
#pragma unroll
    for (int rb = 0; rb < 2; ++rb) {
        float* li_l = wsf + rb * 32;
        if (hie == 0) li_l[r32e] = l_reg[rb]; asm volatile("s_waitcnt lgkmcnt(0)" ::: "memory");
        float rli[16];
#pragma unroll
        for (int r = 0; r < 16; ++r) rli[r] = __builtin_amdgcn_rcpf(li_l[crow(r, hie)]);
        if (rb) __syncthreads();
        if (mp == 1) {
#pragma unroll
            for (int d0 = 0; d0 < 4; ++d0)
#pragma unroll
                for (int r = 0; r < 16; ++r) xch[((rgi * 4 + d0) * 16 + r) * 64 + lanee] = o[rb][d0][r] * rli[r] * lam; }
        __syncthreads();
        if (mp == 0) {
#pragma unroll
            for (int d0 = 0; d0 < 4; ++d0)
#pragma unroll
                for (int r = 0; r < 16; ++r) o[rb][d0][r] = o[rb][d0][r] * rli[r] - xch[((rgi * 4 + d0) * 16 + r) * 64 + lanee];
            float g4[4];
#pragma unroll
            for (int d0 = 0; d0 < 4; ++d0) g4[d0] = subg[d0 * 32 + r32e] * oscale;
#pragma unroll
            for (int r = 0; r < 16; ++r) {
                float s = (o[rb][0][r] * o[rb][0][r] + o[rb][1][r] * o[rb][1][r]) + (o[rb][2][r] * o[rb][2][r] + o[rb][3][r] * o[rb][3][r]);
#define S_DPP(ctrl) s += __builtin_bit_cast(float, __builtin_amdgcn_update_dpp(0, __builtin_bit_cast(int, s), (ctrl), 0xF, 0xF, true))
                S_DPP(0xB1); S_DPP(0x4E); S_DPP(0x141); S_DPP(0x140);
#undef S_DPP
                { const unsigned u_ = __builtin_bit_cast(unsigned, s); auto rr_ = __builtin_amdgcn_permlane16_swap(u_, u_, false, false); s = __builtin_bit_cast(float, (unsigned)rr_[0]) + __builtin_bit_cast(float, (unsigned)rr_[1]); }
                const float rstd = __builtin_amdgcn_rsqf(s * (1.f / 128.f) + NORM_EPS);
                bf16* orow = O + (rb0 + q0 + rgi * 64 + rb * 32 + crow(r, hie)) * DM + h * 128 + r32e;
#pragma unroll
                for (int d0 = 0; d0 < 4; ++d0) orow[d0 * 32] = (bf16)(pk2(o[rb][d0][r] * rstd * g4[d0], 0.f) & 0xffffu);
            }
        }
    }
    __syncthreads();
#undef DMA1
#undef DMA_TILE
#undef DMA_WAIT_BAR
}

constexpr int WA_LD = 1536, SHM_T64 = 64 * 64 * 2;
#define KSWZ64(row, colB) ((row) * 128 + ((colB) ^ (((row) & 7) << 4)))
__device__ __forceinline__ void wa_unit(const bf16* __restrict__ QKV, bf16* __restrict__ O, int b, int g, int blk, const float* __restrict__ sink, char* lds, int wv) {
    const int tid = opaque_tid(wv), wid = tid >> 6, lane = tid & 63, r32 = lane & 31, hi = lane >> 5, hd = wid >> 1, hf = wid & 1;
    char* V_lds = lds; char* K_lds = lds + 2 * SHM_T;
    float* wsf = (float*)(lds + 4 * SHM_T) + wid * 64; float* li_l = wsf; float* al_l = wsf + 32;
    const size_t rb = (size_t)b * RPB;
    const bool isctx = blk < 4; const int q0 = (blk - 4) * 64;
    const int NT = isctx ? 4 : 10;
    float m_reg = -1e30f, l_reg = 0.f; f32x16 o[2] = {}; bf16x8 qr[4];
    const bf16* Qw = QKV + (rb + blk * 64 + hf * 32 + r32) * WA_LD + (g * 4 + hd) * 64 + hi * 8;
#pragma unroll
    for (int d0 = 0; d0 < 4; ++d0) qr[d0] = *(const bf16x8*)(Qw + d0 * 16);
    const bf16* Kh = QKV + rb * WA_LD + 1024 + g * 64; const bf16* Vh = Kh + 256;
    const int sr = tid >> 3, sc = (tid & 7) * 8, vst = v_st<2>(sr, sc);
    const int vb0 = (int)(uintptr_t)V_lds + v_rd_base(lane);
    const int qp = q0 + hf * 32 + r32;
#define TKP(t) (q0 - 128 + 64 * ((t) - 4))
#define TROW(t) (((t) < 4) ? 64 * (t) : (((t) < 9 && TKP(t) >= 0 && TKP(t) < SEQL) ? CTXL + TKP(t) : 0))
    bf16x8 vsA, ksA, vsB, ksB;
#define SLOADA(t) do { const int k0_ = TROW(t); vsA = *(const bf16x8*)(Vh + (size_t)(k0_ + sr) * WA_LD + sc); ksA = *(const bf16x8*)(Kh + (size_t)(k0_ + sr) * WA_LD + sc); } while (0)
#define SLOADB(t) do { const int k0_ = TROW(t); vsB = *(const bf16x8*)(Vh + (size_t)(k0_ + sr) * WA_LD + sc); ksB = *(const bf16x8*)(Kh + (size_t)(k0_ + sr) * WA_LD + sc); } while (0)
#define SWRITE(bq, V0, K0) do { *(bf16x8*)(V_lds + (bq) * SHM_T + vst) = V0; *(bf16x8*)(K_lds + (bq) * SHM_T + KSWZ64(sr, sc * 2)) = K0; } while (0)
#define SWAIT() asm volatile("s_waitcnt vmcnt(2)" ::: "memory")
#define RESC(al) do { if (__any((al) < 1.f)) { if (hi == 0) al_l[r32] = (al); asm volatile("s_waitcnt lgkmcnt(0)" ::: "memory"); \
    _Pragma("unroll") for (int d = 0; d < 2; ++d) _Pragma("unroll") for (int r = 0; r < 16; ++r) o[d][r] *= al_l[crow(r, hi)]; } } while (0)
#define MASKT(P0, P1, t) do { if ((t) >= 4) { const int kp0_ = TKP(t); const bool tv_ = ((t) < 9) && kp0_ >= 0 && kp0_ < SEQL; \
    if (!tv_) { _Pragma("unroll") for (int r = 0; r < 16; ++r) { P0[r] = -1e30f; P1[r] = -1e30f; } }                  \
    else if ((t) == 4 || (t) == 8) {                                                                                  \
    _Pragma("unroll") for (int r = 0; r < 16; ++r) { const int d0_ = qp - (kp0_ + crow(r, hi)); const int d1_ = d0_ - 32; \
        if (d0_ > 128 || d0_ < -128) P0[r] = -1e30f; if (d1_ > 128 || d1_ < -128) P1[r] = -1e30f; } } } } while (0)
#define QKT(P0, P1, KB, t) do { P0 = f32x16{}; P1 = f32x16{}; _Pragma("unroll") for (int d0 = 0; d0 < 4; ++d0) { const int cb = (d0 * 16 + hi * 8) * 2; \
    const bf16x8 b0 = *(const bf16x8*)((KB) + KSWZ64(r32, cb)); const bf16x8 b1 = *(const bf16x8*)((KB) + KSWZ64(32 + r32, cb)); \
    P0 = __builtin_amdgcn_mfma_f32_32x32x16_bf16(b0, qr[d0], P0, 0, 0, 0); P1 = __builtin_amdgcn_mfma_f32_32x32x16_bf16(b1, qr[d0], P1, 0, 0, 0); } MASKT(P0, P1, t); } while (0)
#define PV2(VB) do { pv_one<0, 2>(o[0], VB, pa0, pa1, pa2, pa3); pv_one<1, 2>(o[1], VB, pa0, pa1, pa2, pa3); } while (0)
    f32x16 pA0, pA1, pB0, pB1; float mnA, mnB, alA, alB; bf16x8 pa0, pa1, pa2, pa3;
    SLOADA(0); asm volatile("s_waitcnt vmcnt(0)" ::: "memory"); SWRITE(0, vsA, ksA); __syncthreads();
    QKT(pA0, pA1, K_lds, 0); partialSM(pA0, pA1, m_reg, mnA, alA);
    SLOADB(1); if (2 < NT) SLOADA(2);
    SWAIT(); SWRITE(1, vsB, ksB); __syncthreads();
    for (int j = 1; j + 1 < NT; j += 2) {
        SBAR(); QKT(pB0, pB1, K_lds + SHM_T, j);
        finishSM(pA0, pA1, alA, l_reg, pa0, pa1, pa2, pa3); SBAR();
        SLOADB(j + 2); SBAR();
        PV2(vb0); partialSM(pB0, pB1, m_reg, mnB, alB);
        __syncthreads(); SWAIT(); SWRITE(0, vsA, ksA);
        RESC(alB); __syncthreads();
        SBAR(); QKT(pA0, pA1, K_lds, j + 1);
        finishSM(pB0, pB1, alB, l_reg, pa0, pa1, pa2, pa3); SBAR();
        if (j + 3 < NT) SLOADA(j + 3); SBAR();
        PV2(vb0 + SHM_T); partialSM(pA0, pA1, m_reg, mnA, alA);
        __syncthreads(); SWAIT(); SWRITE(1, vsB, ksB);
        RESC(alA); __syncthreads();
    }
    SBAR(); QKT(pB0, pB1, K_lds + SHM_T, NT - 1);
    finishSM(pA0, pA1, alA, l_reg, pa0, pa1, pa2, pa3); SBAR();
    PV2(vb0); partialSM(pB0, pB1, m_reg, mnB, alB);
    __syncthreads(); RESC(alB);
    finishSM(pB0, pB1, alB, l_reg, pa0, pa1, pa2, pa3); SBAR();
    PV2(vb0 + SHM_T);
    l_reg += __builtin_amdgcn_exp2f(sink[g * 4 + hd] * 1.4426950408889634f - m_reg);
    if (hi == 0) li_l[r32] = l_reg; asm volatile("s_waitcnt lgkmcnt(0)" ::: "memory");
#pragma unroll
    for (int r = 0; r < 16; ++r) { const float rl = __builtin_amdgcn_rcpf(li_l[crow(r, hi)]);
        bf16* orow = O + (rb + blk * 64 + hf * 32 + crow(r, hi)) * DM + (g * 4 + hd) * 64 + r32;
        orow[0] = (bf16)(pk2(o[0][r] * rl, 0.f) & 0xffffu); orow[32] = (bf16)(pk2(o[1][r] * rl, 0.f) & 0xffffu); }
    __syncthreads();
#undef TKP
#undef TROW
#undef SLOADA
#undef SLOADB
#undef SWRITE
#undef SWAIT
#undef RESC
#undef MASKT
#undef QKT
#undef PV2
}
#undef KSWZ
#undef KSWZ64
#undef SBAR
}

namespace ret {
constexpr int LD = 6144, QS = 528, VS = 272, PS = 144, C = 64;
constexpr int L_Q = 0, L_K = 64 * QS, L_V = 2 * 64 * QS, L_P = L_V + 64 * VS, L_T = L_P + 64 * PS  , L_END = L_T + 80 * 4;
static_assert(L_END <= 131072, "retention LDS");
template <int O0, int O1, int O2, int O3> __device__ __forceinline__ void tr4(unsigned base, s16x4& a, s16x4& b, s16x4& c, s16x4& d) {
    asm volatile("ds_read_b64_tr_b16 %0, %4 offset:%5\n\tds_read_b64_tr_b16 %1, %4 offset:%6\n\tds_read_b64_tr_b16 %2, %4 offset:%7\n\tds_read_b64_tr_b16 %3, %4 offset:%8\n\ts_waitcnt lgkmcnt(0)"
                 : "=&v"(a), "=&v"(b), "=&v"(c), "=&v"(d) : "v"(base), "i"(O0), "i"(O1), "i"(O2), "i"(O3) : "memory");
}
template <int O0, int O1, int O2, int O3> __device__ __forceinline__ void tr4n(unsigned base, s16x4& a, s16x4& b, s16x4& c, s16x4& d) {
    asm volatile("ds_read_b64_tr_b16 %0, %4 offset:%5\n\tds_read_b64_tr_b16 %1, %4 offset:%6\n\tds_read_b64_tr_b16 %2, %4 offset:%7\n\tds_read_b64_tr_b16 %3, %4 offset:%8"
                 : "=&v"(a), "=&v"(b), "=&v"(c), "=&v"(d) : "v"(base), "i"(O0), "i"(O1), "i"(O2), "i"(O3) : "memory");
}
template <int O0, int O1, int O2, int O3> __device__ __forceinline__ void tr8(unsigned base0, unsigned base1, s16x4& a, s16x4& b, s16x4& c, s16x4& d, s16x4& e, s16x4& f, s16x4& g, s16x4& h) {
    asm volatile("ds_read_b64_tr_b16 %0, %8 offset:%10\n\tds_read_b64_tr_b16 %1, %8 offset:%11\n\tds_read_b64_tr_b16 %2, %8 offset:%12\n\tds_read_b64_tr_b16 %3, %8 offset:%13\n\t"
                 "ds_read_b64_tr_b16 %4, %9 offset:%10\n\tds_read_b64_tr_b16 %5, %9 offset:%11\n\tds_read_b64_tr_b16 %6, %9 offset:%12\n\tds_read_b64_tr_b16 %7, %9 offset:%13\n\ts_waitcnt lgkmcnt(0)"
                 : "=&v"(a), "=&v"(b), "=&v"(c), "=&v"(d), "=&v"(e), "=&v"(f), "=&v"(g), "=&v"(h) : "v"(base0), "v"(base1), "i"(O0), "i"(O1), "i"(O2), "i"(O3) : "memory");
}
__device__ __forceinline__ bf16x8 cat4(s16x4 l, s16x4 h) { return (bf16x8){l[0], l[1], l[2], l[3], h[0], h[1], h[2], h[3]}; }
__device__ __forceinline__ bf16x8 scale8(bf16x8 v, const float* sc) {
    v4u w = __builtin_bit_cast(v4u, v); v4u o;
    o.x = pk2(bflo(w.x) * sc[0], bfhi(w.x) * sc[1]); o.y = pk2(bflo(w.y) * sc[2], bfhi(w.y) * sc[3]);
    o.z = pk2(bflo(w.z) * sc[4], bfhi(w.z) * sc[5]); o.w = pk2(bflo(w.w) * sc[6], bfhi(w.w) * sc[7]);
    return __builtin_bit_cast(bf16x8, o);
}
constexpr int VS2 = 528, L2_Q = 0, L2_K = 64 * QS, L2_V = 2 * 64 * QS, L2_P = 3 * 64 * QS, L2_T = L2_P + 64 * PS, L2_END = L2_T + 80 * 4;
static_assert(L2_END <= 131072, "retention LDS (v2)");
__device__ __forceinline__ void ret_unit2(const bf16* __restrict__ QKVG, bf16* __restrict__ OB, bf16* __restrict__ OBL, bf16* __restrict__ OBC, const float* __restrict__ dlogit, int b, int h, int dir, int hv, char* lds, int wv) {
    const int tid0 = opaque_tid(wv), wid = __builtin_amdgcn_readfirstlane(tid0 >> 6);
    const size_t rb = (size_t)b * RPB;
    const unsigned ldsb = (unsigned)(uintptr_t)lds;
    const bf16* Qg = QKVG + rb * LD + h * 256; const bf16* Kg = Qg + 1024; const bf16* Vg = QKVG + rb * LD + 2048 + h * 512 + hv * 256;
    const int ocol = h * 512 + hv * 256 + wid * 32;
    bf16x8 sq[4], sk[4], sv[4];
#define R2LOADQK(row0) do { _Pragma("unroll") for (int i = 0; i < 4; ++i) { const int p = tid + 512 * i; sq[i] = *(const bf16x8*)(Qg + (size_t)((row0) + (p >> 5)) * LD + (p & 31) * 8); sk[i] = *(const bf16x8*)(Kg + (size_t)((row0) + (p >> 5)) * LD + (p & 31) * 8); } } while (0)
#define R2LOADV(row0) do { _Pragma("unroll") for (int i = 0; i < 4; ++i) { const int p = tid + 512 * i; sv[i] = *(const bf16x8*)(Vg + (size_t)((row0) + (p >> 5)) * LD + (p & 31) * 8); } } while (0)
#define R2WRITEQK() do { _Pragma("unroll") for (int i = 0; i < 4; ++i) { const int p = tid + 512 * i; *(bf16x8*)(lds + L2_Q + (p >> 5) * QS + (p & 31) * 16) = sq[i]; *(bf16x8*)(lds + L2_K + (p >> 5) * QS + (p & 31) * 16) = sk[i]; } } while (0)
#define R2WRITEV() do { _Pragma("unroll") for (int i = 0; i < 4; ++i) { const int p = tid + 512 * i; *(bf16x8*)(lds + L2_V + (p >> 5) * VS2 + (p & 31) * 16) = sv[i]; } } while (0)
    const float x = dlogit[dir * 4 + h];
    const float lg2d = -log1pf(expf(-x)) * 1.4426950408889634f;
    f32x4 S[16][2];
#pragma unroll
    for (int mb = 0; mb < 16; ++mb) { S[mb][0] = (f32x4){0.f, 0.f, 0.f, 0.f}; S[mb][1] = (f32x4){0.f, 0.f, 0.f, 0.f}; }
    const float gC = __builtin_amdgcn_exp2f(lg2d * (float)C);
    __syncthreads(); if (tid0 < 65) ((float*)(lds + L2_T))[tid0] = __builtin_amdgcn_exp2f(lg2d * (float)tid0); __syncthreads();
    const float* DT = (const float*)(lds + L2_T);
#define CROW(step) ((dir == 0) ? 64 * (step) : (((step) < 4) ? 64 * (3 - (step)) : CTXL + 64 * (67 - (step))))
    { int tid = tid0; asm volatile("" : "+v"(tid)); R2LOADQK(CROW(0)); }
    for (int step = 0; step < 68; ++step) {
        const int row0 = CROW(step);
        int tid = tid0; asm volatile("" : "+v"(tid));
        R2WRITEQK(); R2LOADV(row0); __syncthreads();
        if (step + 1 < 68) { const int rown = CROW(step + 1); R2LOADQK(rown); }
        asm volatile("" : "+v"(tid)); const int lane = tid & 63, l15 = lane & 15, g = lane >> 4;
        { const int qb = wid >> 1, tb0 = 2 * (wid & 1); f32x4 sc2[2] = {(f32x4){0.f, 0.f, 0.f, 0.f}, (f32x4){0.f, 0.f, 0.f, 0.f}};
#pragma unroll
          for (int s = 0; s < 8; ++s) { const bf16x8 af = *(const bf16x8*)(lds + L2_Q + (16 * qb + l15) * QS + (32 * s + 8 * g) * 2);
              const bf16x8 bf0 = *(const bf16x8*)(lds + L2_K + (16 * tb0 + l15) * QS + (32 * s + 8 * g) * 2), bf1 = *(const bf16x8*)(lds + L2_K + (16 * tb0 + 16 + l15) * QS + (32 * s + 8 * g) * 2);
              sc2[0] = __builtin_amdgcn_mfma_f32_16x16x32_bf16(af, bf0, sc2[0], 0, 0, 0); sc2[1] = __builtin_amdgcn_mfma_f32_16x16x32_bf16(af, bf1, sc2[1], 0, 0, 0); }
#pragma unroll
          for (int tt = 0; tt < 2; ++tt) { const int tb = tb0 + tt; const f32x4 sc = sc2[tt];
#pragma unroll
              for (int r = 0; r < 4; ++r) { const int i = 16 * qb + 4 * g + r, j = 16 * tb + l15; const int d = (dir == 0) ? (i - j) : (j - i);
                  const bool keep = (dir == 0) ? (d >= 0) : (d > 0);
                  const float pv = keep ? sc[r] * DT[d & 63] : 0.f;
                  *(bf16*)(lds + L2_P + i * PS + j * 2) = (bf16)(pk2(pv, 0.f) & 0xffffu); } } }
        f32x4 oi[4][2];
#pragma unroll
          for (int qb = 0; qb < 4; ++qb) { oi[qb][0] = (f32x4){0.f, 0.f, 0.f, 0.f}; oi[qb][1] = (f32x4){0.f, 0.f, 0.f, 0.f}; }
#pragma unroll
          for (int s = 0; s < 8; ++s) { v4u bw[2];
#pragma unroll
              for (int nb = 0; nb < 2; ++nb) { bw[nb].x = pk2(S[2 * s][nb][0], S[2 * s][nb][1]); bw[nb].y = pk2(S[2 * s][nb][2], S[2 * s][nb][3]); bw[nb].z = pk2(S[2 * s + 1][nb][0], S[2 * s + 1][nb][1]); bw[nb].w = pk2(S[2 * s + 1][nb][2], S[2 * s + 1][nb][3]); }
#pragma unroll
              for (int qb = 0; qb < 4; ++qb) { const char* qp = lds + L2_Q + (16 * qb + l15) * QS + (32 * s + 4 * g) * 2;
                  const v2u a0 = *(const v2u*)qp, a1 = *(const v2u*)(qp + 32);
                  v4u aw = {a0.x, a0.y, a1.x, a1.y};
                  oi[qb][0] = __builtin_amdgcn_mfma_f32_16x16x32_bf16(__builtin_bit_cast(bf16x8, aw), __builtin_bit_cast(bf16x8, bw[0]), oi[qb][0], 0, 0, 0);
                  oi[qb][1] = __builtin_amdgcn_mfma_f32_16x16x32_bf16(__builtin_bit_cast(bf16x8, aw), __builtin_bit_cast(bf16x8, bw[1]), oi[qb][1], 0, 0, 0); } }
        R2WRITEV();
        __syncthreads();
        int tid2 = tid0; asm volatile("" : "+v"(tid2)); const int lane2 = tid2 & 63, trq = (lane2 & 15) >> 2, trp = lane2 & 3, g2 = lane2 >> 4;
        const unsigned vtr = ldsb + L2_V + (8 * g2 + trq) * VS2 + (wid * 32 + 4 * trp) * 2;
        const unsigned ktr = ldsb + L2_K + (8 * g2 + trq) * QS + (4 * trp) * 2;
        bf16x8 vf[2][2];
#pragma unroll
        for (int nb = 0; nb < 2; ++nb) { s16x4 v00, v01, v10, v11; tr4<0, 4 * VS2, 32 * VS2, 36 * VS2>(vtr + nb * 32, v00, v01, v10, v11); vf[0][nb] = cat4(v00, v01); vf[1][nb] = cat4(v10, v11); }
        {
          bf16* Obase = (dir == 0) ? OB + (rb + row0) * 2048 : ((row0 < CTXL) ? OBC + ((size_t)b * CTXL + row0) * 2048 : OBL + ((size_t)b * SEQL + (row0 - CTXL)) * 2048);
#pragma unroll
          for (int qb = 0; qb < 4; ++qb) {
            const bf16x8 p0 = *(const bf16x8*)(lds + L2_P + (16 * qb + l15) * PS + (8 * g) * 2), p1 = *(const bf16x8*)(lds + L2_P + (16 * qb + l15) * PS + (32 + 8 * g) * 2);
#pragma unroll
            for (int nb = 0; nb < 2; ++nb) { f32x4 oo;
#pragma unroll
                for (int r = 0; r < 4; ++r) { const int i = 16 * qb + 4 * g + r; oo[r] = oi[qb][nb][r] * DT[dir == 0 ? (i + 1) : (C - i)]; }
                oo = __builtin_amdgcn_mfma_f32_16x16x32_bf16(p0, vf[0][nb], oo, 0, 0, 0);
                oo = __builtin_amdgcn_mfma_f32_16x16x32_bf16(p1, vf[1][nb], oo, 0, 0, 0);
#pragma unroll
                for (int r = 0; r < 4; ++r) *(Obase + (size_t)(16 * qb + 4 * g + r) * 2048 + ocol + nb * 16 + l15) = (bf16)(pk2(oo[r], 0.f) & 0xffffu); } } }
        { float vsc0[8], vsc1[8];
#pragma unroll
          for (int j = 0; j < 8; ++j) { const int t = 8 * g2 + j; vsc0[j] = DT[dir == 0 ? (C - 1 - t) : t]; vsc1[j] = DT[dir == 0 ? (C - 33 - t) : (t + 32)]; }
          bf16x8 vs[2][2];
#pragma unroll
          for (int nb = 0; nb < 2; ++nb) { vs[0][nb] = scale8(vf[0][nb], vsc0); vs[1][nb] = scale8(vf[1][nb], vsc1); }
#pragma unroll
          for (int mg = 0; mg < 8; ++mg) { s16x4 kk[2][4];
              tr8<0, 4 * QS, 32 * QS, 36 * QS>(ktr + (mg * 2) * 32, ktr + (mg * 2 + 1) * 32, kk[0][0], kk[0][1], kk[0][2], kk[0][3], kk[1][0], kk[1][1], kk[1][2], kk[1][3]);
#pragma unroll
              for (int q = 0; q < 2; ++q) { const int mb = mg * 2 + q; const bf16x8 k0f = cat4(kk[q][0], kk[q][1]), k1f = cat4(kk[q][2], kk[q][3]);
#pragma unroll
                  for (int nb = 0; nb < 2; ++nb) { f32x4 sn = S[mb][nb] * gC;
                      sn = __builtin_amdgcn_mfma_f32_16x16x32_bf16(k0f, vs[0][nb], sn, 0, 0, 0);
                      sn = __builtin_amdgcn_mfma_f32_16x16x32_bf16(k1f, vs[1][nb], sn, 0, 0, 0);
                      S[mb][nb] = sn; } } } }
        __syncthreads();
    }
#undef CROW
#undef R2LOADQK
#undef R2LOADV
#undef R2WRITEQK
#undef R2WRITEV
}
__device__ __forceinline__ void ret_finish2(const bf16* __restrict__ QKVG, bf16* __restrict__ OB, const bf16* __restrict__ OBL, const bf16* __restrict__ OBC, unsigned char* __restrict__ O8, int G, int wv) {
    const int tid = opaque_tid(wv), lane = tid & 63, gw = (int)blockIdx.x * NWAVES + __builtin_amdgcn_readfirstlane(tid >> 6), NGW = G * NWAVES;
    constexpr int FB = 8;
    for (int it0 = gw; it0 < TA * 4; it0 += FB * NGW) {
        v4u ow[FB], gwv[FB], bw[FB]; bf16* opv[FB]; bool ok[FB];
#pragma unroll
        for (int u = 0; u < FB; ++u) { const int it = it0 + u * NGW; ok[u] = it < TA * 4; const int itq = ok[u] ? it : it0; const int r = itq >> 2, h = itq & 3; const int b = r / RPB, p = r - b * RPB;
            opv[u] = OB + (size_t)r * 2048 + h * 512 + lane * 8; const bf16* gp = QKVG + (size_t)r * LD + 4096 + h * 512 + lane * 8;
            const bf16* bp = ((p < CTXL) ? OBC + ((size_t)b * CTXL + p) * 2048 : OBL + ((size_t)b * SEQL + (p - CTXL)) * 2048) + h * 512 + lane * 8;
            ow[u] = *(const v4u*)opv[u]; gwv[u] = *(const v4u*)gp; bw[u] = *(const v4u*)bp; }
#pragma unroll
        for (int u = 0; u < FB; ++u) if (ok[u]) {
            float o[8] = {bflo(ow[u].x) + bflo(bw[u].x), bfhi(ow[u].x) + bfhi(bw[u].x), bflo(ow[u].y) + bflo(bw[u].y), bfhi(ow[u].y) + bfhi(bw[u].y), bflo(ow[u].z) + bflo(bw[u].z), bfhi(ow[u].z) + bfhi(bw[u].z), bflo(ow[u].w) + bflo(bw[u].w), bfhi(ow[u].w) + bfhi(bw[u].w)};
            float gg[8] = {bflo(gwv[u].x), bfhi(gwv[u].x), bflo(gwv[u].y), bfhi(gwv[u].y), bflo(gwv[u].z), bfhi(gwv[u].z), bflo(gwv[u].w), bfhi(gwv[u].w)};
            float ss = 0.f;
#pragma unroll
            for (int j = 0; j < 8; ++j) ss += o[j] * o[j];
            const float rstd = __builtin_amdgcn_rsqf(wave_sum(ss) * (1.f / 512.f) + NORM_EPS);
#pragma unroll
            for (int j = 0; j < 8; ++j) o[j] = o[j] * rstd * (gg[j] * __builtin_amdgcn_rcpf(1.f + __builtin_amdgcn_exp2f(-LOG2E_F * gg[j])));
            v4u w; w.x = pk2(o[0], o[1]); w.y = pk2(o[2], o[3]); w.z = pk2(o[4], o[5]); w.w = pk2(o[6], o[7]);
            if (O8) { const int it = it0 + u * NGW; const int r = it >> 2, h = it & 3; v2u w8; w8.x = pg8::pack4_fp8(o[0] * A8_SCALE, o[1] * A8_SCALE, o[2] * A8_SCALE, o[3] * A8_SCALE); w8.y = pg8::pack4_fp8(o[4] * A8_SCALE, o[5] * A8_SCALE, o[6] * A8_SCALE, o[7] * A8_SCALE);
                *(v2u*)(O8 + (size_t)r * 2048 + h * 512 + lane * 8) = w8; }
            else *(v4u*)opv[u] = w; } }
}
}

__device__ __forceinline__ void moe_gather(unsigned char* ws, const float* outp, int ml, int G, int wv) {
    const int tid = opaque_tid(wv), lane = tid & 63, gw = (int)blockIdx.x * NWAVES + __builtin_amdgcn_readfirstlane(tid >> 6), NGW = G * NWAVES;
    gu32* ctl = (gu32*)(ws + WS_CTL);
    int cum[9], ts[9]; cum[0] = 0; ts[0] = 0;
#pragma unroll
    for (int e = 0; e < 8; ++e) { const unsigned c = (unsigned)__builtin_amdgcn_readfirstlane((int)__hip_atomic_load(ctl + CW_MOECNT + 16 * ml + e, RLX_AGENT)); cum[e + 1] = cum[e] + (int)c; ts[e + 1] = ts[e] + (int)((c + 255u) >> 8); }
    const int* lists = (const int*)(ws + WS_LISTS); unsigned char* BUF = ws + BIG_BUF;
    for (int i = gw; i < cum[8]; i += 4 * NGW) {
        int tok[4]; size_t slot[4]; bool ok[4];
#pragma unroll
        for (int u = 0; u < 4; ++u) { const int iu = i + u * NGW; ok[u] = iu < cum[8];
            int e = 0;
#pragma unroll
            for (int k = 1; k < 8; ++k) e += (iu >= cum[k]) ? 1 : 0;
            int ce = 0, te = 0;
#pragma unroll
            for (int k = 0; k < 8; ++k) { ce = (k == e) ? cum[k] : ce; te = (k == e) ? ts[k] : te; }
            const int rank = iu - ce; tok[u] = ok[u] ? lists[(size_t)e * TA + rank] : 0; slot[u] = (size_t)te * 256 + rank; }
        v4u o[4];
#pragma unroll
        for (int u = 0; u < 4; ++u) o[u] = *((const v4u*)((const unsigned char*)outp + A8_OFF + (size_t)tok[u] * DM) + lane);
#pragma unroll
        for (int u = 0; u < 4; ++u) if (ok[u]) *((v4u*)(BUF + slot[u] * DM) + lane) = o[u];
    }
}

__global__ void __launch_bounds__(NWAVES * 64, 2) hybrid_fwd(Args args) {
    extern __shared__ __attribute__((aligned(16))) unsigned char lds[];
    LAS unsigned char* ldsl = (LAS unsigned char*)lds;
    volatile LAS unsigned* MISC = (volatile LAS unsigned*)(ldsl + MISC_OFF);
    const int tid = threadIdx.x;
    const int WV = __builtin_amdgcn_readfirstlane(tid >> 6);
    const int G = gridDim.x;
    unsigned char* ws = args.ws;
    gu32* ctl = (gu32*)(ws + WS_CTL);
    for (int u = tid; u < (LDS_BYTES - LDSCTL_OFF) / 4; u += NWAVES * 64) ((LAS unsigned*)(ldsl + LDSCTL_OFF))[u] = 0u;
    __syncthreads();
#if MK_MULTI
    XcdBarrier bar; bar.bar = (unsigned*)(ctl + CW_BAR); bar.x = 0; bar.st = nullptr; bar.wv = (unsigned)WV;
#define GRID_BAR() do { } while (0)
#else
    XcdBarrier bar = xcd_barrier_post((unsigned*)(ctl + CW_BAR), MISC + 8, (unsigned)WV);
#define GRID_BAR() xcd_barrier(bar)
#endif
#ifdef PH_ONLY
    const int lo = PH_ONLY, hi = PH_ONLY + 1; int ph = 0;
#else
    const int lo = args.ph_lo, hi = args.ph_hi; int ph = 0;
#endif
#ifndef REPEAT_PH
#define REPEAT_PH -1
#endif
    enum { PH_BASE = __COUNTER__ + 1 };
#define PHASE_BEGIN if (lo <= ph && ph < hi) { constexpr int pid_ = __COUNTER__ - PH_BASE; constexpr int nrep_ = (pid_ == REPEAT_PH) ? 2 : 1; asm volatile("; PHASE_MARK %0" :: "i"(pid_)); \
    _Pragma("unroll") for (int rep_ = 0; rep_ < nrep_; ++rep_) { if (rep_) GRID_BAR();
#define PHASE_END   } if (ph + 1 < hi) GRID_BAR(); } ++ph;

#define AY ((bf16*)args.out)
#define r2c ((const float*)(ws + WS_ROPE2))
#define r2s ((const float*)(ws + WS_ROPE2) + 64 * 16)
#define r1c ((const float*)(ws + WS_ROPE1))
#define r1s ((const float*)(ws + WS_ROPE1) + 4096 * 128)

    PHASE_BEGIN p0_prologue(args, ldsl, G, WV); PHASE_END
    PHASE_BEGIN resid_phase<0, false, false>(ws, args.out, args.in[0], args.in[2], ldsl, AY, 0, 0, 0, 0, 0, G, WV); PHASE_END

#define GEMM_PHASE8(F8, EPI, ORDER, AP, BP, NN, KK, SINIT, ...) { int kk_ = (KK); asm volatile("" : "+s"(kk_)); pg8::Gemm g{(const bf16*)(AP), (const bf16*)(BP), TA, NN, kk_}; ORDER S; SINIT; EPI E{__VA_ARGS__}; EPI_SETMODE \
        pg8::gemm_phase<EPI, ORDER, true, true, F8>(ldsl + RING_OFF, g, S, E, WV); }
#define GEMM_PHASE(...) GEMM_PHASE8(0, __VA_ARGS__)
#ifdef EPI_MODE
#define EPI_SETMODE E.mode = rep_ ? EPI_MODE : 0;
#else
#define EPI_SETMODE
#endif
#define SO_INIT(NN) S.init(TA, NN, G, (int)blockIdx.x)
#define ROPE2_LDS { LAS float* rl_ = (LAS float*)(ldsl + ROPE2_LDS_OFF); const float* rg_ = (const float*)(ws + WS_ROPE2); for (int i_ = opaque_tid(WV); i_ < 2048; i_ += NWAVES * 64) rl_[i_] = rg_[i_]; __syncthreads(); }
#define r2cl ((const LAS float*)(ldsl + ROPE2_LDS_OFF))
#define r2sl ((const LAS float*)(ldsl + ROPE2_LDS_OFF) + 64 * 16)
#define DA_INPROJ(j) PHASE_BEGIN ROPE2_LDS GEMM_PHASE(pg8::EpiRope2D, pg8::StaticOrder, AY, ws + W_DAIN + (size_t)(j) * 6 * MiB, 3072, 1024, SO_INIT(3072), (bf16*)(ws + BIG_QKV), 3072, 8, r2cl, r2sl) PHASE_END
#define DA_INPROJ8(j) PHASE_BEGIN ROPE2_LDS GEMM_PHASE8(FP8_GU, pg8::EpiRope2D, pg8::StaticOrder, (unsigned char*)args.out + A8_OFF, ws + W_DAIN + (size_t)(j) * 6 * MiB, 3072, 512, SO_INIT(3072), (bf16*)(ws + BIG_QKV), 3072, 8, r2cl, r2sl) PHASE_END
#define DA_LAYER(j, lam_init) \
    PHASE_BEGIN { const float lam = ((const float*)(ws + WS_SCAL))[j]; \
        for (int L = blockIdx.x; L < ((j) == 1 ? 2048 : 2176); L += G) { int bh, q0r, nk;     if (L < 2048) { const int c_ = L & 255; bh = 16 * (L >> 8) + (c_ & 7) + 8 * (c_ >> 7); q0r = CTXL + 256 * ((c_ >> 3) & 15); nk = RPB; } else { bh = L - 2048; q0r = 0; nk = CTXL; } \
            att::da_unit64((const bf16*)(ws + BIG_QKV), (bf16*)(ws + BIG_O), bh >> 3, bh & 7, q0r, nk, lam, 1.f - (lam_init), (const float*)(ws + WS_SMALL) + SM_SUBLN + (j) * 128, (char*)lds + RING_OFF, WV); } } PHASE_END \
    PHASE_BEGIN if ((j) == 1) GEMM_PHASE(pg8::EpiPlain, pg8::StaticOrderLat, ws + BIG_O, ws + W_DAOUT + (size_t)(j) * 2 * MiB, 1024, 1024, S.init(NBATCH * SEQL, 1024, G, (int)blockIdx.x), AY, 1024, 4, 0) \
                else GEMM_PHASE(pg8::EpiPlain, pg8::StaticOrder, ws + BIG_O, ws + W_DAOUT + (size_t)(j) * 2 * MiB, 1024, 1024, SO_INIT(1024), AY, 1024, 4, 0) PHASE_END
#define DENSE_FFN8(i) \
    PHASE_BEGIN GEMM_PHASE8(FP8_GU, pg8::EpiSwiGLU8, pg8::StaticOrder, (unsigned char*)args.out + A8_OFF, ws + W_FFNGU + (size_t)(i) * 11 * MiB, 5632, 512, SO_INIT(5632), ws + BIG_H, FFN, 22, 0, H8_SCALE) PHASE_END \
    PHASE_BEGIN GEMM_PHASE8(FP8_DN, pg8::EpiPlain, pg8::StaticOrder, ws + BIG_H, ws + W_FFNDN + (size_t)(i) * 11 * MiB / 2, 1024, FFN / 2, SO_INIT(1024), AY, 1024, 4, 0) PHASE_END
#define DENSE_FFN_H8(i) \
    PHASE_BEGIN GEMM_PHASE(pg8::EpiSwiGLU8, pg8::StaticOrder, AY, ws + W_FFNGU + (size_t)(i) * 11 * MiB, 5632, 1024, SO_INIT(5632), ws + BIG_H, FFN, 22, 0, H8_SCALE) PHASE_END \
    PHASE_BEGIN GEMM_PHASE8(FP8_DN, pg8::EpiPlain, pg8::StaticOrder, ws + BIG_H, ws + W_FFNDN + (size_t)(i) * 11 * MiB / 2, 1024, FFN / 2, SO_INIT(1024), AY, 1024, 4, 0) PHASE_END
#define DENSE_FFN(i) \
    PHASE_BEGIN GEMM_PHASE(pg8::EpiSwiGLU, pg8::StaticOrder, AY, ws + W_FFNGU + (size_t)(i) * 11 * MiB, 5632, 1024, SO_INIT(5632), (bf16*)(ws + BIG_H), FFN, 22, 0) PHASE_END \
    PHASE_BEGIN GEMM_PHASE(pg8::EpiPlain, pg8::StaticOrder, ws + BIG_H, ws + W_FFNDN + (size_t)(i) * 11 * MiB / 2, 1024, FFN, SO_INIT(1024), AY, 1024, 4, 0) PHASE_END
#define MOE_INIT(NCOL, T0, T1) { LAS int* tsl_ = (LAS int*)(ldsl + MISC_OFF + 64); int tsum_ = 0; \
        if (opaque_tid(WV) == 0) { tsl_[0] = 0; for (int e = 0; e < 8; ++e) { const unsigned c_ = __hip_atomic_load(ctl + CW_MOECNT + 16 * ml_ + e, RLX_AGENT); tsum_ += (int)((c_ + 255u) >> 8); tsl_[e + 1] = tsum_; } } \
        __syncthreads(); \
        S.ncol = NCOL; S.G = G; S.c = (int)blockIdx.x; S.tsl = tsl_; S.t0 = (T0); { const int t8_ = __builtin_amdgcn_readfirstlane(tsl_[8]); S.t1 = t8_ < (T1) ? t8_ : (T1); } }
#define MOE_FFN(ml) \
    PHASE_BEGIN moe_gather(ws, args.out, ml, G, WV); PHASE_END \
    { const int ml_ = (ml); \
        PHASE_BEGIN GEMM_PHASE8(FP8_GU, pg8::EpiSwiGLU8, pg8::MoeOrder, ws + BIG_BUF, ws + W_MOEGU + (size_t)(ml) * 56 * MiB, 7168, 512, MOE_INIT(28, 0, MOE_TILES_MAX), ws + BIG_MH, EDIM, 28, 0, H8_SCALE) PHASE_END \
        PHASE_BEGIN GEMM_PHASE8(FP8_DN, pg8::EpiPlain, pg8::MoeOrder, ws + BIG_MH, ws + W_MOEDN + (size_t)(ml) * 28 * MiB, 1024, EDIM / 2, MOE_INIT(4, 0, MOE_TILES_MAX), (bf16*)(ws + BIG_YE), 1024, 4, 0) PHASE_END }

    DA_INPROJ(0)
    DA_LAYER(0, 0.2f)
    PHASE_BEGIN resid_phase<1, false, false, (DENSE_FP8 & 1) != 0>(ws, args.out, nullptr, nullptr, ldsl, AY, 0, 0, 0, 1, 0, G, WV); PHASE_END
#if DENSE_FP8 & 1
    DENSE_FFN8(0)
#elif DENSE_H8 & 1
    DENSE_FFN_H8(0)
#else
    DENSE_FFN(0)
#endif
    PHASE_BEGIN resid_phase<1, false, false>(ws, args.out, nullptr, nullptr, ldsl, AY, 0, 1, 1, 0, 0, G, WV); PHASE_END

    PHASE_BEGIN ROPE2_LDS GEMM_PHASE(pg8::EpiRope2D, pg8::StaticOrder, AY, ws + W_WAIN, 1536, 1024, SO_INIT(1536), (bf16*)(ws + BIG_QKV), 1536, 5, r2cl, r2sl) PHASE_END
    PHASE_BEGIN { for (int L = blockIdx.x; L < 16 * 4 * 68; L += G) { const int bg = L / 68, blk = L - bg * 68;
            att::wa_unit((const bf16*)(ws + BIG_QKV), (bf16*)(ws + BIG_O), bg >> 2, bg & 3, blk, (const float*)(ws + WS_SMALL) + SM_SINK, (char*)lds + RING_OFF, WV); } } PHASE_END
    PHASE_BEGIN GEMM_PHASE(pg8::EpiPlain, pg8::StaticOrder, ws + BIG_O, ws + W_WAOUT, 1024, 1024, SO_INIT(1024), AY, 1024, 4, 0) PHASE_END
    PHASE_BEGIN resid_phase<1, true, false, true>(ws, args.out, nullptr, nullptr, ldsl, AY, 1, 0, 1, 1, 0, G, WV); PHASE_END
    MOE_FFN(0)
    PHASE_BEGIN resid_phase<2, false, false, (PROJ_FP8 & 1) != 0>(ws, args.out, nullptr, nullptr, ldsl, AY, 1, 1, 2, 0, 0, G, WV); PHASE_END

#if PROJ_FP8 & 1
    PHASE_BEGIN GEMM_PHASE8(FP8_GU, pg8::EpiRope1D, pg8::StaticOrder, (unsigned char*)args.out + A8_OFF, ws + W_RETIN, 6144, 512, SO_INIT(6144), (bf16*)(ws + BIG_RQ), 6144, 8, r1c, r1s) PHASE_END
#else
    PHASE_BEGIN GEMM_PHASE(pg8::EpiRope1D, pg8::StaticOrder, AY, ws + W_RETIN, 6144, 1024, SO_INIT(6144), (bf16*)(ws + BIG_RQ), 6144, 8, r1c, r1s) PHASE_END
#endif
    PHASE_BEGIN { for (int L = blockIdx.x; L < 256; L += G) ret::ret_unit2((const bf16*)(ws + BIG_RQ), (bf16*)(ws + BIG_RO), (bf16*)args.out, (bf16*)(ws + WS_OBC), (const float*)(ws + WS_SMALL) + SM_DECAY, L >> 4, (L >> 2) & 3, (L >> 1) & 1, L & 1, (char*)lds + RING_OFF, WV); } PHASE_END
    PHASE_BEGIN ret::ret_finish2((const bf16*)(ws + BIG_RQ), (bf16*)(ws + BIG_RO), (const bf16*)args.out, (const bf16*)(ws + WS_OBC), RETOUT_FP8 ? ws + WS_RO8 : nullptr, G, WV); PHASE_END
#if RETOUT_FP8
    PHASE_BEGIN GEMM_PHASE8(FP8_AO, pg8::EpiPlain, pg8::StaticOrder, ws + WS_RO8, ws + W_RETOUT, 1024, 1024, SO_INIT(1024), AY, 1024, 4, 0) PHASE_END
#else
    PHASE_BEGIN GEMM_PHASE(pg8::EpiPlain, pg8::StaticOrder, ws + BIG_RO, ws + W_RETOUT, 1024, 2048, SO_INIT(1024), AY, 1024, 4, 0) PHASE_END
#endif
    PHASE_BEGIN resid_phase<1, false, false, (DENSE_FP8 & 2) != 0>(ws, args.out, nullptr, nullptr, ldsl, AY, 2, 0, 2, 1, 0, G, WV); PHASE_END
#if DENSE_FP8 & 2
    DENSE_FFN8(1)
#else
    DENSE_FFN(1)
#endif
    PHASE_BEGIN resid_phase<1, false, false, (PROJ_FP8 & 4) != 0>(ws, args.out, nullptr, nullptr, ldsl, AY, 2, 1, 3, 0, 0, G, WV); PHASE_END

#if PROJ_FP8 & 4
    DA_INPROJ8(1)
#else
    DA_INPROJ(1)
#endif
    DA_LAYER(1, 0.55605820f)
    PHASE_BEGIN resid_phase<1, true, false, true, true>(ws, args.out, nullptr, nullptr, ldsl, AY, 3, 0, 3, 1, 1, G, WV); PHASE_END
    MOE_FFN(1)
    PHASE_BEGIN resid_phase<2, false, true>(ws, args.out, nullptr, nullptr, ldsl, AY, 3, 1, 3, 0, 1, G, WV); PHASE_END
#undef PHASE_BEGIN
#undef PHASE_END
}
constexpr int N_PHASES = 33;

extern "C" void kernel_launch(void* const* d_in, const int* in_sizes, int n_in, void* d_out, int out_size, void* d_ws, size_t ws_size, hipStream_t stream) {
    static int grid = 0;
    if (grid == 0) {
        if (n_in != 22 || in_sizes[0] != NBATCH * SEQL * DM || out_size != NBATCH * SEQL * DM || ws_size < WS_END) {
            fprintf(stderr, "kernel_launch: shape mismatch (n_in %d, in0 %d, out %d, ws %zu; need ws >= %zu); nothing launched\n", n_in, n_in > 0 ? in_sizes[0] : -1, out_size, ws_size, (size_t)WS_END); grid = -1; return; }
        int dev = 0, cus = 0, per_cu = 0;
        if (hipGetDevice(&dev) != hipSuccess || hipDeviceGetAttribute(&cus, hipDeviceAttributeMultiprocessorCount, dev) != hipSuccess) { fprintf(stderr, "kernel_launch: device query failed\n"); grid = -1; return; }
        if (hipFuncSetAttribute((const void*)hybrid_fwd, hipFuncAttributeMaxDynamicSharedMemorySize, LDS_BYTES) != hipSuccess) { fprintf(stderr, "kernel_launch: hipFuncSetAttribute failed\n"); grid = -1; return; }
        if (hipOccupancyMaxActiveBlocksPerMultiprocessor(&per_cu, (const void*)hybrid_fwd, NWAVES * 64, LDS_BYTES) != hipSuccess || per_cu < 1) {
            fprintf(stderr, "kernel_launch: occupancy query reports %d workgroups per CU\n", per_cu); }
        (void)hipGetLastError();
        if ((long)cus * NWAVES * 40 < (long)TA) { fprintf(stderr, "kernel_launch: %d CUs are too few for the routing phase's per-wave row table; nothing launched\n", cus); grid = -1; return; }
        grid = cus;
        if (grid != 256) fprintf(stderr, "kernel_launch: note: %d CUs (built and tuned for 256)\n", grid);
    }
    if (grid < 0) return;
    if (hipMemsetAsync((char*)d_ws + WS_CTL, 0, CTL_ZERO_BYTES, stream) != hipSuccess) { fprintf(stderr, "kernel_launch: memset failed\n"); return; }
    Args a{};
    for (int i = 0; i < 22; ++i) a.in[i] = (const float*)d_in[i];
    a.out = (float*)d_out; a.ws = (unsigned char*)d_ws;
#if MK_MULTI
    for (int p = 0; p < N_PHASES; ++p) { a.ph_lo = p; a.ph_hi = p + 1; hipLaunchKernelGGL(hybrid_fwd, dim3(grid), dim3(NWAVES * 64), LDS_BYTES, stream, a); }
#else
    a.ph_lo = 0; a.ph_hi = N_PHASES;
    hipLaunchKernelGGL(hybrid_fwd, dim3(grid), dim3(NWAVES * 64), LDS_BYTES, stream, a);
#endif
    const hipError_t le = hipPeekAtLastError();
    if (le != hipSuccess) fprintf(stderr, "kernel_launch: launch failed: %s\n", hipGetErrorName(le));
}
```

```cpp
#include <hip/hip_runtime.h>
#include <cstdio>
#include <cstdint>

#ifndef DBG
#define DBG 0
#endif
#ifndef PG8_RELAX
#define PG8_RELAX 1
#endif
#ifndef PG8_ASM_DMA
#define PG8_ASM_DMA 1
#endif
#ifndef MK_MULTI
#define MK_MULTI 0
#endif

__device__ __forceinline__ int opaque_tid(int wv) { int l; asm volatile("v_mbcnt_lo_u32_b32 %0, -1, 0\n\tv_mbcnt_hi_u32_b32 %0, -1, %0" : "=v"(l)); return (wv << 6) | l; }
namespace pg8 {
#define PG8_LAS __attribute__((address_space(3)))
typedef unsigned short bf16_t;
typedef short bf16x8 __attribute__((ext_vector_type(8)));
typedef float f32x4 __attribute__((ext_vector_type(4)));
typedef unsigned u32x4 __attribute__((ext_vector_type(4)));
constexpr int BM = 256, BK = 64, HALF = 128, HTB = HALF * BK * 2  , STAGE_BYTES = 8 * HTB, NXCD = 8, WGM = 4;

__host__ __device__ __forceinline__ int lds_byte(int r, int c) { const int st = (r >> 4) * 2 + (c >> 5), rr = r & 15, cc = c & 31, ob = rr * 64 + cc * 2; return st * 1024 + (ob ^ (((ob >> 9) & 1) << 5)); }
__host__ __device__ __forceinline__ void stage_rc(int b, int& R, int& C) { const int st = b / 1024, sb = b % 1024, swz = sb ^ (((sb >> 9) & 1) << 5); R = (st >> 1) * 16 + swz / 64; C = (st & 1) * 32 + (swz % 64) / 2; }
__host__ __device__ __forceinline__ int perm32(int rho) { const int n = rho >> 4, i = rho & 15; return 8 * (i >> 2) + 4 * n + (i & 3); }

struct Unit { int pm, pn; };
struct Gemm { const bf16_t* A; const bf16_t* Bt; int M, N, K; };

struct StaticOrder {
    int nM, nN, nwg, G, c;
    __host__ __device__ void init(int M, int N, int G_, int c_) { nM = M / BM; nN = N / BM; nwg = nM * nN; G = G_; c = c_; }
    __host__ __device__ bool next(int i, Unit& u) const {
        const long L = (long)i * G + c; if (L >= nwg) return false;
        int wgid = (int)L; { const int q = nwg / NXCD, r = nwg % NXCD, xcd = wgid % NXCD, off = wgid / NXCD; wgid = (xcd < r ? xcd * (q + 1) : r * (q + 1) + (xcd - r) * q) + off; }
        const int nig = WGM * nN, gid = wgid / nig, rem = wgid - gid * nig, fm = gid * WGM, gsz = (nM - fm) < WGM ? (nM - fm) : WGM;
        static_assert(WGM == 4, "the full-group case below shifts by log2(WGM)");
        if (gsz == WGM) { u.pm = fm + (rem & (WGM - 1)); u.pn = rem >> 2; } else { u.pm = fm + (rem % gsz); u.pn = rem / gsz; }
        return true;
    }
    __device__ __forceinline__ void a_ready(const Unit&) const {}
    __device__ __forceinline__ void done(const Unit&) const {}
};

struct StaticOrderLat : StaticOrder {
    __host__ __device__ bool next(int i, Unit& u) const { if (!StaticOrder::next(i, u)) return false; u.pm = (u.pm >> 4) * 17 + 1 + (u.pm & 15); return true; }
};

typedef int v8i __attribute__((ext_vector_type(8)));
typedef float f32x8 __attribute__((ext_vector_type(8)));
typedef int v4i_ __attribute__((ext_vector_type(4)));
__device__ __forceinline__ v8i cat8(bf16x8 lo, bf16x8 hi) { const v4i_ a = __builtin_bit_cast(v4i_, lo), b = __builtin_bit_cast(v4i_, hi); return __builtin_shufflevector(a, b, 0, 1, 2, 3, 4, 5, 6, 7); }
__device__ __forceinline__ bf16x8 lo8(v8i v) { return __builtin_bit_cast(bf16x8, __builtin_shufflevector(v, v, 0, 1, 2, 3)); }
__device__ __forceinline__ bf16x8 hi8(v8i v) { return __builtin_bit_cast(bf16x8, __builtin_shufflevector(v, v, 4, 5, 6, 7)); }
__device__ __forceinline__ unsigned cvt_pk_bf16(float lo, float hi) { unsigned r; asm volatile("v_cvt_pk_bf16_f32 %0, %1, %2" : "=v"(r) : "v"(lo), "v"(hi)); return r; }

#ifndef EPI_NT
#define EPI_NT 0
#endif
#if EPI_NT
#define EPI_ST(p, v) __builtin_nontemporal_store((v), (p))
#else
#define EPI_ST(p, v) (*(p) = (v))
#endif
__device__ __forceinline__ u32x4 pack8(const f32x4 a, const f32x4 b) { u32x4 w; w.x = cvt_pk_bf16(a[0], a[1]); w.y = cvt_pk_bf16(a[2], a[3]); w.z = cvt_pk_bf16(b[0], b[1]); w.w = cvt_pk_bf16(b[2], b[3]); return w; }

struct EpiPlain {
    static constexpr bool PERM = true, AFTER_DRAIN = false; static constexpr int NSTORE = 16;
    bf16_t* O; int ldc; int pn_mod; int pm_off; int mode;
    __device__ __forceinline__ void operator()(const f32x4 (&acc)[2][2][4][2], const Unit& u, int wr, int wc, int fr, int fq) const {
        if (mode == 1) return;
        const int row0 = (u.pm + pm_off) * BM + wr * 64 + fr, col0 = (u.pn % pn_mod) * BM + wc * 32 + 8 * fq;
#pragma unroll
        for (int ai = 0; ai < 2; ++ai)
#pragma unroll
            for (int m = 0; m < 4; ++m) { bf16_t* rowp = O + (size_t)(row0 + ai * HALF + m * 16) * ldc + col0;
#pragma unroll
                for (int bj = 0; bj < 2; ++bj) { const u32x4 w_ = pack8(acc[ai][bj][m][0], acc[ai][bj][m][1]); if (mode == 0 || w_.x == 0x7fc12345u) EPI_ST((u32x4*)(rowp + bj * HALF), w_); } }
    }
};
struct EpiRope2D {
    static constexpr bool PERM = true, AFTER_DRAIN = false; static constexpr int NSTORE = 16;
    bf16_t* O; int ldc; int rope_tiles; const PG8_LAS float* tabc; const PG8_LAS float* tabs; int mode;
    __device__ __forceinline__ void operator()(const f32x4 (&acc)[2][2][4][2], const Unit& u, int wr, int wc, int fr, int fq) const {
        const int row0 = u.pm * BM + wr * 64 + fr, col0 = u.pn * BM + wc * 32 + 8 * fq;
        const int pt = u.pm % 17; const bool rope = (u.pn < rope_tiles) && (pt != 0);
        const int pos0 = (pt - 1) * 256 + wr * 64 + fr;
#pragma unroll
        for (int ai = 0; ai < 2; ++ai)
#pragma unroll
            for (int m = 0; m < 4; ++m) { bf16_t* rowp = O + (size_t)(row0 + ai * HALF + m * 16) * ldc + col0;
                f32x4 cs = (f32x4){1.f, 1.f, 1.f, 1.f}, sn = (f32x4){0.f, 0.f, 0.f, 0.f};
                if (rope) { const int pos = pos0 + ai * HALF + m * 16; const int pidx = (wc & 1) ? (pos & 63) : (pos >> 6);
                    cs = *(const PG8_LAS f32x4*)(tabc + pidx * 16 + 4 * fq); sn = *(const PG8_LAS f32x4*)(tabs + pidx * 16 + 4 * fq); }
#pragma unroll
                for (int bj = 0; bj < 2; ++bj) { const f32x4 x0 = acc[ai][bj][m][0], x1 = acc[ai][bj][m][1];
                    const f32x4 y0 = x0 * cs - x1 * sn, y1 = x1 * cs + x0 * sn;
                    EPI_ST((u32x4*)(rowp + bj * HALF), pack8(y0, y1)); } }
    }
};
struct EpiRope1D {
    static constexpr bool PERM = true, AFTER_DRAIN = false; static constexpr int NSTORE = 16;
    bf16_t* O; int ldc; int rope_tiles; const float* tabc; const float* tabs; int mode;
    __device__ __forceinline__ void operator()(const f32x4 (&acc)[2][2][4][2], const Unit& u, int wr, int wc, int fr, int fq) const {
        const int row0 = u.pm * BM + wr * 64 + fr, col0 = u.pn * BM + wc * 32 + 8 * fq;
        const int pt = u.pm % 17; const bool rope = (u.pn < rope_tiles) && (pt != 0);
        const int pos0 = (pt - 1) * 256 + wr * 64 + fr;
#pragma unroll
        for (int ai = 0; ai < 2; ++ai)
#pragma unroll
            for (int m = 0; m < 4; ++m) { bf16_t* rowp = O + (size_t)(row0 + ai * HALF + m * 16) * ldc + col0;
                f32x4 y0[2], y1[2];
#pragma unroll
                for (int n = 0; n < 2; ++n) { const f32x4 x0 = acc[ai][0][m][n], x1 = acc[ai][1][m][n];
                    if (rope) { const int pos = pos0 + ai * HALF + m * 16; const int i0 = wc * 32 + 8 * fq + 4 * n;
                        const f32x4 cs = *(const f32x4*)(tabc + (size_t)pos * 128 + i0), sn = *(const f32x4*)(tabs + (size_t)pos * 128 + i0);
                        y0[n] = x0 * cs - x1 * sn; y1[n] = x1 * cs + x0 * sn; }
                    else { y0[n] = x0; y1[n] = x1; } }
                EPI_ST((u32x4*)(rowp), pack8(y0[0], y0[1])); EPI_ST((u32x4*)(rowp + HALF), pack8(y1[0], y1[1])); }
    }
};
__device__ __forceinline__ float silu_f(float t) { return t * __builtin_amdgcn_rcpf(1.f + __builtin_amdgcn_exp2f(-t)); }
struct EpiSwiGLU {
    static constexpr bool PERM = true, AFTER_DRAIN = false; static constexpr int NSTORE = 8;
    bf16_t* O; int ldc; int pn_mod; int pm_off; int mode;
    __device__ __forceinline__ void operator()(const f32x4 (&acc)[2][2][4][2], const Unit& u, int wr, int wc, int fr, int fq) const {
        if (mode == 1) return;
        const int row0 = (u.pm + pm_off) * BM + wr * 64 + fr, col0 = (u.pn % pn_mod) * HALF + wc * 32 + 8 * fq;
        if (mode == 3) { f32x4 s_ = (f32x4){0.f, 0.f, 0.f, 0.f};
#pragma unroll
            for (int ai = 0; ai < 2; ++ai)
#pragma unroll
                for (int bj = 0; bj < 2; ++bj)
#pragma unroll
                    for (int m = 0; m < 4; ++m) { s_ += acc[ai][bj][m][0]; s_ += acc[ai][bj][m][1]; }
            if (s_[0] + s_[1] + s_[2] + s_[3] == 1.2345e-30f) O[(size_t)row0 * ldc + col0] = 1; return; }
#pragma unroll
        for (int ai = 0; ai < 2; ++ai)
#pragma unroll
            for (int m = 0; m < 4; ++m) { bf16_t* rowp = O + (size_t)(row0 + ai * HALF + m * 16) * ldc + col0;
                f32x4 h[2];
#pragma unroll
                for (int n = 0; n < 2; ++n) { const f32x4 g = acc[ai][0][m][n], uu = acc[ai][1][m][n];
                    h[n] = (f32x4){silu_f(g[0]) * uu[0], silu_f(g[1]) * uu[1], silu_f(g[2]) * uu[2], silu_f(g[3]) * uu[3]}; }
                { const u32x4 w_ = pack8(h[0], h[1]); if (mode == 0 || w_.x == 0x7fc12345u) EPI_ST((u32x4*)(rowp), w_); } }
    }
};

__device__ __forceinline__ unsigned pack4_fp8(float a, float b, float c, float d) {
    a = __builtin_fminf(__builtin_fmaxf(a, -448.f), 448.f); b = __builtin_fminf(__builtin_fmaxf(b, -448.f), 448.f); c = __builtin_fminf(__builtin_fmaxf(c, -448.f), 448.f); d = __builtin_fminf(__builtin_fmaxf(d, -448.f), 448.f);
    int w = 0; w = __builtin_amdgcn_cvt_pk_fp8_f32(a, b, w, false); w = __builtin_amdgcn_cvt_pk_fp8_f32(c, d, w, true); return (unsigned)w; }
typedef unsigned u32x2 __attribute__((ext_vector_type(2)));
struct EpiSwiGLU8 {
    static constexpr bool PERM = true, AFTER_DRAIN = false; static constexpr int NSTORE = 8;
    unsigned char* O; int ldc; int pn_mod; int pm_off; float oscale; int mode;
    __device__ __forceinline__ void operator()(const f32x4 (&acc)[2][2][4][2], const Unit& u, int wr, int wc, int fr, int fq) const {
        const int row0 = (u.pm + pm_off) * BM + wr * 64 + fr, col0 = (u.pn % pn_mod) * HALF + wc * 32 + 8 * fq;
#pragma unroll
        for (int ai = 0; ai < 2; ++ai)
#pragma unroll
            for (int m = 0; m < 4; ++m) { unsigned char* rowp = O + (size_t)(row0 + ai * HALF + m * 16) * ldc + col0;
                u32x2 w;
#pragma unroll
                for (int n = 0; n < 2; ++n) { const f32x4 g = acc[ai][0][m][n], uu = acc[ai][1][m][n];
                    const unsigned p = pack4_fp8(silu_f(g[0]) * uu[0], silu_f(g[1]) * uu[1], silu_f(g[2]) * uu[2], silu_f(g[3]) * uu[3]);
                    if (n == 0) w.x = p; else w.y = p; }
                EPI_ST((u32x2*)(rowp), w); }
    }
};
struct MoeOrder {
    int t0, t1, ncol, G, c; const PG8_LAS int* tsl;
    __device__ __forceinline__ bool next(int i, Unit& u) const {
        const unsigned L = (unsigned)i * (unsigned)G + (unsigned)c; const int nt = t1 - t0; if (L >= (unsigned)nt * (unsigned)ncol) return false;
        const unsigned nig = 8u * (unsigned)ncol, gid = L / nig, rem = L - gid * nig; const int fm = (int)gid * 8, gsz = (nt - fm) < 8 ? (nt - fm) : 8;
        const int t = t0 + fm + (gsz == 8 ? (int)(rem & 7u) : (int)(rem % (unsigned)gsz)), j = (gsz == 8) ? (int)(rem >> 3) : (int)(rem / (unsigned)gsz);
        int e = 0;
#pragma unroll
        for (int k = 1; k < 8; ++k) e += (t >= tsl[k]) ? 1 : 0;
        u.pm = t; u.pn = e * ncol + j; return true;
    }
    __device__ __forceinline__ void a_ready(const Unit&) const {}
    __device__ __forceinline__ void done(const Unit&) const {}
};
template <class Epi, class Sched, bool ALIGN_EPI = false, bool SP2 = false, int FP8 = 0  >
__device__ __forceinline__ void gemm_phase(PG8_LAS unsigned char* lds, const Gemm g, const Sched& S, const Epi& E, const int wv) {
    const int tid = opaque_tid(wv), wid = __builtin_amdgcn_readfirstlane(tid >> 6), lane = tid & 63, wr = wid >> 2, wc = wid & 3, fr = lane & 15, fq = lane >> 4;
    const int K = g.K, nt = K / BK;
    constexpr bool RELAX_ST = ALIGN_EPI && SP2 && !Epi::AFTER_DRAIN && (PG8_RELAX != 0);
    unsigned voffA[2], voffB[2];
#pragma unroll
    for (int i = 0; i < 2; ++i) { int R, C; stage_rc(tid * 16 + i * 8192, R, C); const int Rb = Epi::PERM ? ((R & ~31) + perm32(R & 31)) : R;
        voffA[i] = (unsigned)(R * K + C) * 2u; voffB[i] = (unsigned)(Rb * K + C) * 2u; }
    const size_t kstep = (size_t)(BK * 2);
    const size_t hstep = (size_t)HALF * K * 2;
    const size_t tstep = 2 * hstep;
    const unsigned ldsw = (unsigned)wid * 1024u; const unsigned ldsbase = (unsigned)(size_t)lds;
    const int aoff = lds_byte(wr * 64 + fr, fq * 8), boff = lds_byte(wc * 32 + fr, fq * 8);
#define PG8_SA(b, h) (((b) * 2 + (h)) * HTB)
#define PG8_SB(b, h) ((4 + (b) * 2 + (h)) * HTB)
#define PG8_STAGE(bufoff, gbase, voff) do { _Pragma("unroll") for (int _i = 0; _i < 2; ++_i) { \
        if constexpr (FP8 == 0 && !PG8_ASM_DMA) __builtin_amdgcn_global_load_lds((const unsigned*)((const char*)(gbase) + (voff)[_i]), (PG8_LAS unsigned*)(lds + (bufoff) + ldsw + _i * 8192), 16, 0, 0); \
        else { unsigned keep_; asm volatile("s_mov_b32 %0, m0\n\ts_mov_b32 m0, %3\n\ts_nop 0\n\tglobal_load_lds_dwordx4 %1, %2\n\ts_mov_b32 m0, %0" : "=&s"(keep_) : "v"((voff)[_i]), "s"((const char*)(gbase)), "s"((unsigned)__builtin_amdgcn_readfirstlane((int)(ldsbase + (unsigned)(bufoff) + ldsw + _i * 8192))) : "memory"); } } } while (0)
#define PG8_LDA(dst, b, h) do { _Pragma("unroll") for (int m = 0; m < 4; ++m) { const bf16x8 f0_ = *(const PG8_LAS bf16x8*)(lds + PG8_SA(b, h) + aoff + m * 2048), f1_ = *(const PG8_LAS bf16x8*)(lds + PG8_SA(b, h) + aoff + m * 2048 + 1024); dst[m] = cat8(f0_, f1_); } } while (0)
#define PG8_LDB(dst, b, h) do { _Pragma("unroll") for (int n = 0; n < 2; ++n) { const bf16x8 f0_ = *(const PG8_LAS bf16x8*)(lds + PG8_SB(b, h) + boff + n * 2048), f1_ = *(const PG8_LAS bf16x8*)(lds + PG8_SB(b, h) + boff + n * 2048 + 1024); dst[n] = cat8(f0_, f1_); } } while (0)
#define PG8_MMA(ai, bj, At, Bt) do { __builtin_amdgcn_s_setprio(1); \
        if constexpr (FP8 == 0) { _Pragma("unroll") for (int m = 0; m < 4; ++m) _Pragma("unroll") for (int n = 0; n < 2; ++n) { \
            acc[ai][bj][m][n] = __builtin_amdgcn_mfma_f32_16x16x32_bf16(lo8(Bt[n]), lo8(At[m]), acc[ai][bj][m][n], 0, 0, 0); \
            acc[ai][bj][m][n] = __builtin_amdgcn_mfma_f32_16x16x32_bf16(hi8(Bt[n]), hi8(At[m]), acc[ai][bj][m][n], 0, 0, 0); } } \
        else { \
            _Pragma("unroll") for (int m = 0; m < 4; ++m) _Pragma("unroll") for (int n = 0; n < 2; ++n) \
            asm volatile("v_mfma_scale_f32_16x16x128_f8f6f4 %0, %1, %2, %0, %3, %4 op_sel_hi:[0,0,0]" : "+v"(acc[ai][bj][m][n]) : "v"(Bt[n]), "v"(At[m]), "v"(scb_), "v"(sca_)); } \
        __builtin_amdgcn_s_setprio(0); } while (0)
#define PG8_MMA0(ai, bj, At, Bt) do { __builtin_amdgcn_s_setprio(1); \
        if constexpr (FP8 == 0) { _Pragma("unroll") for (int m = 0; m < 4; ++m) _Pragma("unroll") for (int n = 0; n < 2; ++n) { \
            acc[ai][bj][m][n] = __builtin_amdgcn_mfma_f32_16x16x32_bf16(lo8(Bt[n]), lo8(At[m]), (f32x4){0.f, 0.f, 0.f, 0.f}, 0, 0, 0); \
            acc[ai][bj][m][n] = __builtin_amdgcn_mfma_f32_16x16x32_bf16(hi8(Bt[n]), hi8(At[m]), acc[ai][bj][m][n], 0, 0, 0); } } \
        else { \
            _Pragma("unroll") for (int m = 0; m < 4; ++m) _Pragma("unroll") for (int n = 0; n < 2; ++n) \
            asm volatile("v_mfma_scale_f32_16x16x128_f8f6f4 %0, %1, %2, 0, %3, %4 op_sel_hi:[0,0,0]" : "+v"(acc[ai][bj][m][n]) : "v"(Bt[n]), "v"(At[m]), "v"(scb_), "v"(sca_)); }   \
        __builtin_amdgcn_s_setprio(0); } while (0)
#define PG8_MMAX(first, ai, bj, At, Bt) do { if (first) PG8_MMA0(ai, bj, At, Bt); else PG8_MMA(ai, bj, At, Bt); } while (0)
#define PG8_WAIT_V(n) asm volatile("s_waitcnt vmcnt(" #n ")" ::: "memory")
#define PG8_WAIT_L(n) asm volatile("s_waitcnt lgkmcnt(" #n ")" ::: "memory")
#define PG8_WAIT_VX(rx) do { if (rx) asm volatile("s_waitcnt vmcnt(%0)" :: "n"(8 + Epi::NSTORE) : "memory"); else PG8_WAIT_V(8); } while (0)
#define PG8_BAR __builtin_amdgcn_s_barrier()
#define PG8_SCHED __builtin_amdgcn_sched_barrier(0)
    Unit cur, nxt; int ui = 0;
    PG8_LAS unsigned* utab = (PG8_LAS unsigned*)(lds + STAGE_BYTES + 1024);
    if (tid < 64) { Unit u_; utab[tid] = S.next(tid, u_) ? ((unsigned)u_.pm | ((unsigned)u_.pn << 16)) : 0xffffffffu; }
    __syncthreads();
#define PG8_NEXT(i, u, ok) do { const int i_ = (i); if (i_ < 64) { const unsigned v_ = (unsigned)__builtin_amdgcn_readfirstlane((int)utab[i_]); ok = (v_ != 0xffffffffu); u.pm = (int)(v_ & 0xffffu); u.pn = (int)(v_ >> 16); } else ok = S.next(i_, u); } while (0)
    { bool ok0_; PG8_NEXT(0, cur, ok0_); if (!ok0_) return; }
    f32x4 acc[2][2][4][2];
    const int sca_ = (FP8 & 0xff) * 0x01010101, scb_ = ((FP8 >> 8) & 0xff) * 0x01010101;
    {
#pragma unroll
    for (int a = 0; a < 2; ++a)
#pragma unroll
        for (int b = 0; b < 2; ++b)
#pragma unroll
            for (int m = 0; m < 4; ++m)
#pragma unroll
                for (int n = 0; n < 2; ++n) acc[a][b][m][n] = (f32x4){0.f, 0.f, 0.f, 0.f};
    }
    v8i At[4], B0[2], B1[2];
    const char* cA = (const char*)g.A + (size_t)cur.pm * tstep; const char* cB = (const char*)g.Bt + (size_t)cur.pn * tstep;
    S.a_ready(cur);
    if constexpr (SP2) {
        PG8_STAGE(PG8_SB(0, 0), cB, voffB); PG8_STAGE(PG8_SB(0, 1), cB + hstep, voffB); PG8_STAGE(PG8_SA(0, 0), cA, voffA); PG8_STAGE(PG8_SA(0, 1), cA + hstep, voffA);
        if (wr == 1) PG8_BAR;
        PG8_WAIT_V(2); PG8_BAR;
        PG8_STAGE(PG8_SB(1, 0), cB + kstep, voffB); PG8_STAGE(PG8_SA(1, 0), cA + kstep, voffA); PG8_STAGE(PG8_SB(1, 1), cB + hstep + kstep, voffB);
        PG8_WAIT_V(6); PG8_BAR;
    } else {
        PG8_STAGE(PG8_SB(0, 0), cB, voffB); PG8_STAGE(PG8_SA(0, 0), cA, voffA); PG8_STAGE(PG8_SB(0, 1), cB + hstep, voffB); PG8_STAGE(PG8_SA(0, 1), cA + hstep, voffA);
        if (wr == 1) PG8_BAR;
        PG8_WAIT_V(4); PG8_BAR;
        PG8_STAGE(PG8_SB(1, 0), cB + kstep, voffB); PG8_STAGE(PG8_SA(1, 0), cA + kstep, voffA); PG8_STAGE(PG8_SB(1, 1), cB + hstep + kstep, voffB);
        PG8_WAIT_V(6); PG8_BAR;
    }
    for (;;) {
        bool has_next; PG8_NEXT(ui + 1, nxt, has_next);
        const char* nA = has_next ? (const char*)g.A + (size_t)nxt.pm * tstep : cA; const char* nB = has_next ? (const char*)g.Bt + (size_t)nxt.pn * tstep : cB;
        for (int t = 0; t < nt; t += 2) {
            const bool last = (t == nt - 2);
            const char* a1 = cA + (size_t)(t + 1) * kstep;
            const char* a2 = last ? nA : cA + (size_t)(t + 2) * kstep; const char* b2 = last ? nB : cB + (size_t)(t + 2) * kstep;
            const char* a3 = a2 + kstep; const char* b3 = b2 + kstep;
            if (last && has_next) S.a_ready(nxt);
            if constexpr (SP2) {
            const bool relax = RELAX_ST && (t == 0) && (ui > 0);
            const bool first0 = SP2 && (t == 0);
            PG8_LDB(B0, 0, 0); PG8_LDB(B1, 0, 1); PG8_SCHED; PG8_LDA(At, 0, 0); if (!relax) PG8_STAGE(PG8_SA(1, 1), a1 + hstep, voffA);
            PG8_WAIT_VX(relax); PG8_WAIT_L(0); PG8_BAR; PG8_MMAX(first0, 0, 0, At, B0); PG8_MMAX(first0, 0, 1, At, B1); PG8_BAR; PG8_SCHED;
            PG8_LDA(At, 0, 1); PG8_STAGE(PG8_SB(0, 0), b2, voffB); PG8_STAGE(PG8_SB(0, 1), b2 + hstep, voffB); PG8_STAGE(PG8_SA(0, 0), a2, voffA);
            PG8_WAIT_VX(relax); PG8_WAIT_L(0); PG8_BAR; PG8_MMAX(first0, 1, 0, At, B0); PG8_MMAX(first0, 1, 1, At, B1); PG8_BAR; PG8_SCHED;
            PG8_LDB(B0, 1, 0); PG8_LDB(B1, 1, 1); PG8_SCHED; PG8_LDA(At, 1, 0); PG8_STAGE(PG8_SA(0, 1), a2 + hstep, voffA);
            PG8_WAIT_VX(relax); PG8_WAIT_L(0); PG8_BAR; PG8_MMA(0, 0, At, B0); PG8_MMA(0, 1, At, B1); PG8_BAR; PG8_SCHED;
            PG8_LDA(At, 1, 1); PG8_STAGE(PG8_SB(1, 0), b3, voffB); PG8_STAGE(PG8_SB(1, 1), b3 + hstep, voffB); PG8_STAGE(PG8_SA(1, 0), a3, voffA);
            PG8_WAIT_V(8); PG8_WAIT_L(0); PG8_BAR; PG8_MMA(1, 0, At, B0); PG8_MMA(1, 1, At, B1); PG8_BAR; PG8_SCHED;
            } else {
            PG8_LDB(B0, 0, 0); PG8_SCHED; PG8_LDA(At, 0, 0); PG8_STAGE(PG8_SA(1, 1), a1 + hstep, voffA);
            PG8_WAIT_L(8); PG8_BAR; PG8_WAIT_L(0); PG8_MMA(0, 0, At, B0); PG8_BAR; PG8_SCHED;
            PG8_LDB(B1, 0, 1); PG8_STAGE(PG8_SB(0, 0), b2, voffB);
            PG8_BAR; PG8_WAIT_L(0); PG8_MMA(0, 1, At, B1); PG8_BAR;
            PG8_LDA(At, 0, 1); PG8_STAGE(PG8_SA(0, 0), a2, voffA);
            PG8_BAR; PG8_WAIT_L(0); PG8_MMA(1, 0, At, B0); PG8_BAR; PG8_SCHED;
            PG8_STAGE(PG8_SB(0, 1), b2 + hstep, voffB);
            PG8_WAIT_V(6); PG8_BAR; PG8_MMA(1, 1, At, B1); PG8_BAR;
            PG8_LDB(B0, 1, 0); PG8_SCHED; PG8_LDA(At, 1, 0); PG8_STAGE(PG8_SA(0, 1), a2 + hstep, voffA);
            PG8_WAIT_L(8); PG8_BAR; PG8_WAIT_L(0); PG8_MMA(0, 0, At, B0); PG8_BAR; PG8_SCHED;
            PG8_LDB(B1, 1, 1); PG8_STAGE(PG8_SB(1, 0), b3, voffB);
            PG8_BAR; PG8_WAIT_L(0); PG8_MMA(0, 1, At, B1); PG8_BAR;
            PG8_LDA(At, 1, 1); PG8_STAGE(PG8_SA(1, 0), a3, voffA);
            PG8_BAR; PG8_WAIT_L(0); PG8_MMA(1, 0, At, B0); PG8_BAR; PG8_SCHED;
            PG8_STAGE(PG8_SB(1, 1), b3 + hstep, voffB);
            PG8_WAIT_V(6); PG8_BAR; PG8_MMA(1, 1, At, B1); PG8_BAR;
            }
        }
        if constexpr (ALIGN_EPI) { if (wr == 0) PG8_BAR; }
        if constexpr (RELAX_ST) { if (has_next) PG8_STAGE(PG8_SA(1, 1), nA + kstep + hstep, voffA); }
        if constexpr (FP8 != 0) asm volatile("s_nop 15\n\ts_nop 15\n\ts_nop 7" ::: "memory");
        if constexpr (!Epi::AFTER_DRAIN) { int tide_ = tid; asm volatile("" : "+v"(tide_)); const int le_ = tide_ & 63;
            E(acc, cur, wr, wc, le_ & 15, le_ >> 4); S.done(cur); }
        if (!has_next) break;
        if constexpr (!SP2) {
#pragma unroll
        for (int a = 0; a < 2; ++a)
#pragma unroll
            for (int b = 0; b < 2; ++b)
#pragma unroll
                for (int m = 0; m < 4; ++m)
#pragma unroll
                    for (int n = 0; n < 2; ++n) acc[a][b][m][n] = (f32x4){0.f, 0.f, 0.f, 0.f};
        }
        cur = nxt; cA = nA; cB = nB; ++ui;
        if constexpr (ALIGN_EPI) { if (wr == 1) PG8_BAR; }
    }
    PG8_WAIT_V(0);
    if constexpr (!ALIGN_EPI) { if (wr == 0) PG8_BAR; }
    PG8_BAR;
    if constexpr (Epi::AFTER_DRAIN) { E.fused(acc, cur, wr, wc, fr, fq, lds, wid, lane); S.done(cur); }
#undef PG8_SA
#undef PG8_SB
#undef PG8_STAGE
#undef PG8_LDA
#undef PG8_LDB
#undef PG8_MMA
#undef PG8_MMA0
#undef PG8_MMAX
#undef PG8_NEXT
#undef PG8_WAIT_V
#undef PG8_WAIT_L
#undef PG8_WAIT_VX
#undef PG8_BAR
#undef PG8_SCHED
}
}

constexpr int DM = 1024, NBATCH = 16, SEQL = 4096, CTXL = 256, RPB = SEQL + CTXL  , TA = NBATCH * RPB  ;
constexpr int FFN = 2816, NEXP = 8, EDIM = 3584, NWAVES = 8;
constexpr float NORM_EPS = 1e-6f;
constexpr float LOG2E_F = 1.4426950408889634f;
constexpr float QSCALE = 0.125f * 1.4426950408889634f;
constexpr int MOE_TILES_MAX = 552, MOE_PASS_TILES = 276;

constexpr size_t MiB = 1u << 20;
constexpr size_t WS_CTL = 0, CTL_ZERO_BYTES = 1 * MiB;
constexpr size_t WS_MODV = 1 * MiB;
constexpr size_t WS_ROPE2 = 3 * MiB;
constexpr size_t WS_SCAL = 3 * MiB + 64 * 1024;
constexpr size_t WS_ROUTW = 3 * MiB + 128 * 1024;
constexpr size_t WS_SMALL = 3 * MiB + 256 * 1024;
constexpr int SM_NORMG = 0, SM_SUBLN = 16384, SM_SINK = 16384 + 256, SM_DECAY = 16384 + 256 + 16;
constexpr size_t WS_ROPE1 = 4 * MiB;
constexpr size_t WS_TOKINFO = 8 * MiB;
constexpr size_t WS_LISTS = 10 * MiB;
constexpr size_t WS_W = 16 * MiB;
constexpr size_t W_DAIN = WS_W, W_DAOUT = W_DAIN + 12 * MiB, W_WAIN = W_DAOUT + 4 * MiB, W_WAOUT = W_WAIN + 3 * MiB, W_RETIN = W_WAOUT + 2 * MiB, W_RETOUT = W_RETIN + 12 * MiB,
                 W_FFNGU = W_RETOUT + 4 * MiB, W_FFNDN = W_FFNGU + 22 * MiB, W_MOEGU = W_FFNDN + 11 * MiB, W_MOEDN = W_MOEGU + 224 * MiB, W_END = W_MOEDN + 112 * MiB;
constexpr size_t WS_X = 424 * MiB;
constexpr size_t WS_RO8 = 560 * MiB;
constexpr size_t WS_BIG = 696 * MiB;
constexpr size_t WS_END = 1792 * MiB;
static_assert(W_END <= WS_X && WS_X + (size_t)TA * DM * 2 <= WS_RO8 && WS_RO8 + (size_t)TA * 2048 <= WS_BIG, "ws map");
constexpr size_t BIG_QKV = WS_BIG, BIG_O = WS_BIG + 408 * MiB;
constexpr size_t BIG_RQ = WS_BIG, BIG_RO = WS_BIG + 816 * MiB;
constexpr size_t BIG_H = WS_BIG;
constexpr size_t BIG_BUF = WS_BIG, BIG_YE = WS_BIG + 138 * MiB, BIG_MH = WS_BIG + 414 * MiB;
static_assert(BIG_RO + (size_t)TA * 2048 * 2 <= WS_END && BIG_MH + (size_t)MOE_TILES_MAX * 256 * EDIM <= WS_END, "ws map (big)");
#ifndef DENSE_FP8
#define DENSE_FP8 2
#endif
#ifndef DENSE_H8
#define DENSE_H8 1
#endif
#ifndef RETOUT_FP8
#define RETOUT_FP8 1
#endif
#ifndef RESID_NR
#define RESID_NR 3
#endif
#ifndef PROJ_FP8
#define PROJ_FP8 5
#endif
constexpr size_t A8_OFF = 136 * MiB;
constexpr float A8_SCALE = 8.f, H8_SCALE = 4.f, WGU8_SCALE = 32.f, WDN8_SCALE = 64.f;
constexpr int FP8_GU = ((127 - 5) << 8) | (127 - 3), FP8_DN = ((127 - 6) << 8) | (127 - 2), FP8_AO = ((127 - 6) << 8) | (127 - 3);

constexpr size_t WS_OBC = 200 * MiB;
static_assert(WS_OBC >= W_MOEGU + 112 * MiB && WS_OBC + (size_t)NBATCH * CTXL * 2048 * 2 <= W_MOEDN, "OBC placement");
constexpr int CW_TMO = 0, CW_CODE = 1, CW_DBG = 2;
constexpr int CW_MOECNT = 64;
constexpr int CW_WQ = 128;
constexpr int CW_BAR = 4096;

constexpr int RING_OFF = 0, RING_BYTES = 131072;
constexpr int LDSCTL_OFF = RING_BYTES, MISC_OFF = LDSCTL_OFF + 320;
constexpr int ROPE2_LDS_OFF = LDSCTL_OFF + 2048;
constexpr int LDS_BYTES = 147456;

#define GAS __attribute__((address_space(1)))
#define LAS __attribute__((address_space(3)))
typedef unsigned short bf16;
typedef unsigned v4u __attribute__((ext_vector_type(4)));
typedef unsigned v2u __attribute__((ext_vector_type(2)));
typedef float f32x4 __attribute__((ext_vector_type(4)));
typedef float f32x2 __attribute__((ext_vector_type(2)));
typedef short bf16x8 __attribute__((ext_vector_type(8)));
typedef short s16x4 __attribute__((ext_vector_type(4)));
typedef float f32x16 __attribute__((ext_vector_type(16)));
typedef GAS unsigned gu32;
#define RLX_AGENT __ATOMIC_RELAXED, __HIP_MEMORY_SCOPE_AGENT
#define LDS_WAIT() asm volatile("s_waitcnt lgkmcnt(0)" ::: "memory")
#define VM_WAIT() asm volatile("s_waitcnt vmcnt(0)" ::: "memory")
__device__ __forceinline__ unsigned f2bf(float f) { unsigned u = __builtin_bit_cast(unsigned, f); return (u + 0x7fffu + ((u >> 16) & 1u)) >> 16; }
typedef __bf16 bf16x2_t_ __attribute__((ext_vector_type(2)));
__device__ __forceinline__ unsigned pk2(float lo, float hi) { const f32x2 v = {lo, hi}; const bf16x2_t_ b = __builtin_convertvector(v, bf16x2_t_); return __builtin_bit_cast(unsigned, b); }
__device__ __forceinline__ float bf2f(unsigned short h) { return __builtin_bit_cast(float, (unsigned)h << 16); }
__device__ __forceinline__ float bflo(unsigned w) { return __builtin_bit_cast(float, w << 16); }
__device__ __forceinline__ float bfhi(unsigned w) { return __builtin_bit_cast(float, w & 0xffff0000u); }
__device__ __forceinline__ float wave_sum(float v) {
#define WS_DPP(ctrl) v += __builtin_bit_cast(float, __builtin_amdgcn_update_dpp(0, __builtin_bit_cast(int, v), (ctrl), 0xF, 0xF, true))
    WS_DPP(0xB1);
    WS_DPP(0x4E);
    WS_DPP(0x141);
    WS_DPP(0x140);
#undef WS_DPP
    { const unsigned u = __builtin_bit_cast(unsigned, v); auto rr = __builtin_amdgcn_permlane16_swap(u, u, false, false); v = __builtin_bit_cast(float, (unsigned)rr[0]) + __builtin_bit_cast(float, (unsigned)rr[1]); }
    { const unsigned u = __builtin_bit_cast(unsigned, v); auto rr = __builtin_amdgcn_permlane32_swap(u, u, false, false); v = __builtin_bit_cast(float, (unsigned)rr[0]) + __builtin_bit_cast(float, (unsigned)rr[1]); }
    return v;
}
#define XB_TMO      128
#define XB_XCNT(j)  (256  + 64 * (j))
#define XB_XSUB(j)  (1280 + 64 * (j))
#define XB_XGEN(j)  (2304 + 64 * (j))
#define XB_TOP      3328
#define XB_TOPGEN   3392
#define XCD_BAR_WORDS 3456
#define XB_SPIN_CAP (1u << 22)

__device__ __forceinline__ unsigned xb_ld(unsigned* p)              { return __hip_atomic_load(p, __ATOMIC_RELAXED, __HIP_MEMORY_SCOPE_AGENT); }
__device__ __forceinline__ unsigned xb_add(unsigned* p, unsigned v) { return __hip_atomic_fetch_add(p, v, __ATOMIC_RELAXED, __HIP_MEMORY_SCOPE_AGENT); }
__device__ __forceinline__ unsigned xb_xcc_id() { return (unsigned)__builtin_amdgcn_s_getreg((3 << 11) | 20) & 0xFu; }
#define XB_SPIN(cond, bar) do { unsigned _sp = 0; while (cond) { __builtin_amdgcn_s_sleep(1); \
    if ((++_sp & 255u) == 0u) { if (xb_ld(&(bar)[XB_TMO])) break; if (_sp > XB_SPIN_CAP) { atomicAdd(&(bar)[XB_TMO], 1u); break; } } } } while (0)

struct XcdBarrier {
    unsigned* bar; unsigned x;
    unsigned wv;
    volatile LAS unsigned* st;
};

__device__ __forceinline__ XcdBarrier xcd_barrier_post(unsigned* bar, volatile LAS unsigned* st, unsigned wv) {
    XcdBarrier b; b.bar = bar; b.x = xb_xcc_id(); b.st = st; b.wv = wv;
    if (opaque_tid((int)wv) == 0) (void)xb_add(&bar[XB_XCNT(b.x)], 1u);
    return b;
}
__device__ __forceinline__ void xcd_barrier_complete(unsigned* bar, unsigned x, unsigned& nloc, unsigned& nx) {
    const unsigned G = gridDim.x * gridDim.y * gridDim.z;
    unsigned sum, cnt, mine, sp = 0u;
    for (;;) {
        sum = 0u; cnt = 0u; mine = 0u;
#pragma unroll
        for (unsigned j = 0; j < 16; ++j) { const unsigned c = xb_ld(&bar[XB_XCNT(j)]); sum += c; cnt += (c > 0u) ? 1u : 0u; mine = (j == x) ? c : mine; }
        if (sum == G) break;
        __builtin_amdgcn_s_sleep(1);
        if ((++sp & 255u) == 0u) { if (xb_ld(&bar[XB_TMO])) break; if (sp > XB_SPIN_CAP) { atomicAdd(&bar[XB_TMO], 1u); break; } }
    }
    nloc = mine > 0u ? mine : 1u; nx = cnt > 0u ? cnt : 1u;
}

__device__ __forceinline__ void xcd_barrier(const XcdBarrier& b) {
    asm volatile("s_waitcnt vmcnt(0)" ::: "memory");
    __syncthreads();
    if (opaque_tid((int)b.wv) == 0) {
        unsigned* bar = b.bar;
        __builtin_amdgcn_s_waitcnt(0);
        unsigned nloc = b.st[0], nx = b.st[1];
        if (nloc == 0u) { xcd_barrier_complete(bar, b.x, nloc, nx); b.st[0] = nloc; b.st[1] = nx; }
        const unsigned old = xb_add(&bar[XB_XSUB(b.x)], 1u);
        const unsigned gen = old / nloc;
        if (old + 1u == (gen + 1u) * nloc) {
            __builtin_amdgcn_fence(__ATOMIC_RELEASE, "agent");
            asm volatile("s_waitcnt vmcnt(0)" ::: "memory");
            const unsigned og = xb_add(&bar[XB_TOP], 1u);
            const unsigned tg = og / nx;
            if (og + 1u == (tg + 1u) * nx) xb_add(&bar[XB_TOPGEN], 1u);
            else XB_SPIN(xb_ld(&bar[XB_TOPGEN]) == tg, bar);
            __builtin_amdgcn_fence(__ATOMIC_ACQUIRE, "agent");
            xb_add(&bar[XB_XGEN(b.x)], 1u);
            asm volatile("s_waitcnt vmcnt(0)" ::: "memory");
        } else {
            XB_SPIN(xb_ld(&bar[XB_XGEN(b.x)]) == gen, bar);
            __builtin_amdgcn_fence(__ATOMIC_ACQUIRE, "agent");
            asm volatile("s_waitcnt vmcnt(0)" ::: "memory");
        }
    }
    __syncthreads();
}

struct Args { const float* in[22]; float* out; unsigned char* ws; int ph_lo, ph_hi; };

struct WJob { const float* src; bf16* dst; int K, Nsrc, Ndst, mode; float f8scale; float upscale; };
__device__ __forceinline__ void wjob_get(const Args& a, int j, WJob& w) {
    unsigned char* ws = a.ws; w.f8scale = 0.f; w.upscale = 1.f;
    if (j < 2)        { w.src = a.in[7] + (size_t)j * 1024 * 3072;  w.dst = (bf16*)(ws + W_DAIN + (size_t)j * 6 * MiB);   w.K = 1024; w.Nsrc = 3072; w.Ndst = 3072; w.mode = 1; w.f8scale = (j == 1 && (PROJ_FP8 & 4)) ? WGU8_SCALE : 0.f; }
    else if (j < 4)   { const int i = j - 2; w.src = a.in[8] + (size_t)i * 1024 * 1024; w.dst = (bf16*)(ws + W_DAOUT + (size_t)i * 2 * MiB); w.K = 1024; w.Nsrc = 1024; w.Ndst = 1024; w.mode = 0; }
    else if (j == 4)  { w.src = a.in[11]; w.dst = (bf16*)(ws + W_WAIN);  w.K = 1024; w.Nsrc = 1536; w.Ndst = 1536; w.mode = 2; }
    else if (j == 5)  { w.src = a.in[12]; w.dst = (bf16*)(ws + W_WAOUT); w.K = 1024; w.Nsrc = 1024; w.Ndst = 1024; w.mode = 0; }
    else if (j == 6)  { w.src = a.in[14]; w.dst = (bf16*)(ws + W_RETIN); w.K = 1024; w.Nsrc = 6144; w.Ndst = 6144; w.mode = 3; w.f8scale = (PROJ_FP8 & 1) ? WGU8_SCALE : 0.f; }
    else if (j == 7)  { w.src = a.in[15]; w.dst = (bf16*)(ws + W_RETOUT); w.K = 2048; w.Nsrc = 1024; w.Ndst = 1024; w.mode = 0; w.f8scale = RETOUT_FP8 ? WDN8_SCALE : 0.f; }
    else if (j < 10)  { const int i = j - 8;  w.src = a.in[17] + (size_t)i * 1024 * 5632; w.dst = (bf16*)(ws + W_FFNGU + (size_t)i * 11 * MiB); w.K = 1024; w.Nsrc = 5632; w.Ndst = 5632; w.mode = 4; w.f8scale = ((DENSE_FP8 >> i) & 1) ? WGU8_SCALE : 0.f; w.upscale = ((((DENSE_FP8 | DENSE_H8) >> i) & 1) ? H8_SCALE : 1.f) * (1.f / LOG2E_F); }
    else if (j < 12)  { const int i = j - 10; w.src = a.in[18] + (size_t)i * 2816 * 1024; w.dst = (bf16*)(ws + W_FFNDN + (size_t)i * 11 * MiB / 2); w.K = 2816; w.Nsrc = 1024; w.Ndst = 1024; w.mode = 0; w.f8scale = (((DENSE_FP8 | DENSE_H8) >> i) & 1) ? WDN8_SCALE : 0.f; }
    else if (j < 28)  { const int i = j - 12; w.src = a.in[20] + (size_t)i * 1024 * 7168; w.dst = (bf16*)(ws + W_MOEGU + (size_t)i * 7 * MiB); w.K = 1024; w.Nsrc = 7168; w.Ndst = 7168; w.mode = 4; w.f8scale = WGU8_SCALE; w.upscale = H8_SCALE * (1.f / LOG2E_F); }
    else              { const int i = j - 28; w.src = a.in[21] + (size_t)i * 3584 * 1024; w.dst = (bf16*)(ws + W_MOEDN + (size_t)i * 7 * MiB / 2);  w.K = 3584; w.Nsrc = 1024; w.Ndst = 1024; w.mode = 0; w.f8scale = WDN8_SCALE; }
}
constexpr int W_ITEMS = 103936;
__device__ __forceinline__ int wsrc_col(int mode, int n, int Nsrc, float upscale, float& scale) {
    scale = 1.f;
    if (mode == 0) return n;
    if (mode == 1 || mode == 2) {
        const int nrope = (mode == 1) ? 2048 : 1280;
        if (n < 1024) scale = QSCALE;
        if (n >= nrope) return n;
        const int n64 = n & 63, half = n64 >> 5, p = n64 & 31, sg = 4 * (p >> 3) + (p & 3) + 16 * ((p >> 2) & 1);
        return (n & ~63) + 32 * half + sg;
    }
    if (mode == 3) { if (n >= 1024 && n < 2048) scale = 0.0625f; return n; }
    const int F = Nsrc >> 1, pn = n >> 8, w = n & 255;
    scale = (w < 128) ? LOG2E_F : upscale;
    return (w < 128) ? (128 * pn + w) : (F + 128 * pn + (w - 128));
}
__device__ __forceinline__ void p0_transpose_item(const WJob& w, LAS float* scr, int item, int lane) {
    const int nblk = w.Ndst / 32, kb = item / nblk, nb = item % nblk, k0 = 64 * kb, n0 = 32 * nb;
    const int r = lane >> 3, c4 = lane & 7;
    float scale; const int sc = wsrc_col(w.mode, n0 + 4 * c4, w.Nsrc, w.upscale, scale);
    if (w.f8scale != 0.f) scale *= w.f8scale;
    const float* W = w.src + (size_t)(k0 + r) * w.Nsrc + sc;
    f32x4 v[8];
#pragma unroll
    for (int i = 0; i < 8; ++i) v[i] = *(const f32x4*)(W + (size_t)(8 * i) * w.Nsrc);
#pragma unroll
    for (int i = 0; i < 8; ++i) { LAS float* d = scr + (8 * i + r) * 33 + 4 * c4; d[0] = v[i][0] * scale; d[1] = v[i][1] * scale; d[2] = v[i][2] * scale; d[3] = v[i][3] * scale; }
    LDS_WAIT(); asm volatile("" ::: "memory");
    const int c = lane & 7;
#pragma unroll
    for (int j = 0; j < 4; ++j) { const int n = (lane >> 3) + 8 * j; const LAS float* s = scr + (8 * c) * 33 + n;
        if (w.f8scale != 0.f) { v2u o; o.x = pg8::pack4_fp8(s[0 * 33], s[1 * 33], s[2 * 33], s[3 * 33]); o.y = pg8::pack4_fp8(s[4 * 33], s[5 * 33], s[6 * 33], s[7 * 33]);
            *(GAS v2u*)((unsigned char*)w.dst + (size_t)(n0 + n) * w.K + k0 + 8 * c) = o; }
        else { v4u o; o.x = pk2(s[0 * 33], s[1 * 33]); o.y = pk2(s[2 * 33], s[3 * 33]); o.z = pk2(s[4 * 33], s[5 * 33]); o.w = pk2(s[6 * 33], s[7 * 33]);
            *(GAS v4u*)(w.dst + (size_t)(n0 + n) * w.K + k0 + 8 * c) = o; } }
    LDS_WAIT(); asm volatile("" ::: "memory");
}
__device__ __forceinline__ void p0_prologue(const Args& a, LAS unsigned char* lds, int G, int wv) {
    const int tid = opaque_tid(wv), lane = tid & 63, wave = __builtin_amdgcn_readfirstlane(tid >> 6);
    unsigned char* ws = a.ws;
    const int bx = blockIdx.x;
    if (bx < 48) {
        LAS float* s = (LAS float*)lds;
        for (int i = tid; i < 17 * 1024; i += NWAVES * 64) { const float v = (i < 16384) ? a.in[1][i] : a.in[3][i - 16384]; s[(i & 1023) * 20 + (i >> 10)] = v / (1.f + __expf(-v)); }
        __syncthreads();
        const int idx = bx * 512 + tid, l = idx / 6144, n = idx - l * 6144;
        float acc[17];
#pragma unroll
        for (int mi = 0; mi < 17; ++mi) acc[mi] = 0.f;
        const float* wp = a.in[4] + (size_t)l * 1024 * 6144 + n;
#pragma unroll 4
        for (int k = 0; k < 1024; ++k) { const float wv = wp[(size_t)k * 6144];
#pragma unroll
            for (int q = 0; q < 4; ++q) { const f32x4 sv = *(const LAS f32x4*)(s + k * 20 + 4 * q); acc[4 * q] += sv[0] * wv; acc[4 * q + 1] += sv[1] * wv; acc[4 * q + 2] += sv[2] * wv; acc[4 * q + 3] += sv[3] * wv; }
            acc[16] += s[k * 20 + 16] * wv; }
        float* modv = (float*)(ws + WS_MODV); const float bb = a.in[5][l * 6144 + n];
#pragma unroll
        for (int mi = 0; mi < 17; ++mi) modv[(size_t)(l * 17 + mi) * 6144 + n] = acc[mi] + bb;
        __syncthreads();
    }
    { const int gt = bx * (NWAVES * 64) + tid, NT = G * NWAVES * 64;
      float* r1c = (float*)(ws + WS_ROPE1); float* r1s = r1c + 4096 * 128;
      for (int idx = gt; idx < 4096 * 128; idx += NT) { const int pos = idx >> 7, i = idx & 127; const float inv = powf(10000.f, -(float)(2 * i) / 256.f); const float ang = (float)pos * inv;
          double sd, cd; sincos((double)ang, &sd, &cd); r1c[idx] = (float)cd; r1s[idx] = (float)sd; }
      float* r2c = (float*)(ws + WS_ROPE2); float* r2s = r2c + 64 * 16;
      for (int idx = gt; idx < 64 * 16; idx += NT) { const int pos = idx >> 4, i = idx & 15; const float inv = powf(10000.f, -(float)(2 * i) / 32.f); const float ang = (float)pos * inv;
          double sd, cd; sincos((double)ang, &sd, &cd); r2c[idx] = (float)cd; r2s[idx] = (float)sd; }
      float* rw = (float*)(ws + WS_ROUTW);
      for (int idx = gt; idx < 2 * 8 * 1024; idx += NT) { const int l = idx >> 13, e = (idx >> 10) & 7, k = idx & 1023; rw[idx] = a.in[19][((size_t)l * 1024 + k) * 8 + e]; }
      { float* sm = (float*)(ws + WS_SMALL);
        for (int idx = gt; idx < 16384; idx += NT) sm[SM_NORMG + idx] = a.in[6][idx];
        if (gt < 256) sm[SM_SUBLN + gt] = a.in[10][gt];
        if (gt < 16) sm[SM_SINK + gt] = a.in[13][gt];
        if (gt < 8) sm[SM_DECAY + gt] = a.in[16][gt]; }
      if (gt < 2) { const float* lp = a.in[9] + gt * 256; float s01 = 0.f, s23 = 0.f;
          for (int i = 0; i < 64; ++i) { s01 += lp[i] * lp[64 + i]; s23 += lp[128 + i] * lp[192 + i]; }
          const float lam_init = 0.8f - 0.6f * expf(-0.3f * (float)(gt == 0 ? 0 : 3));
          ((float*)(ws + WS_SCAL))[gt] = expf(s01) - expf(s23) + lam_init; }
    }
    { LAS float* scr = (LAS float*)(lds + wave * 16384);
      gu32* wq = (gu32*)(ws + WS_CTL) + CW_WQ;
      constexpr int CH = 8;
      int j = 0, base = 0; WJob w; wjob_get(a, 0, w); int n = (w.K / 64) * (w.Ndst / 32);
      for (;;) {
          unsigned i0 = 0; if (lane == 0) i0 = __hip_atomic_fetch_add(wq, (unsigned)CH, RLX_AGENT); i0 = __builtin_amdgcn_readfirstlane(i0);
          if (i0 >= (unsigned)W_ITEMS) break;
          for (int t = 0; t < CH; ++t) { const int it = (int)i0 + t; if (it >= W_ITEMS) break;
              while (it >= base + n) { base += n; ++j; wjob_get(a, j, w); n = (w.K / 64) * (w.Ndst / 32); }
              p0_transpose_item(w, scr, it - base, lane); } } }
}

#define RC(j) (8 * lane + 512 * ((j) >> 1) + 4 * ((j) & 1))
template <int VAR, bool ROUTE, bool FINAL, bool A8 = false, bool NOCTX = false>
__device__ __forceinline__ void resid_phase(unsigned char* ws, float* outp, const float* in_x, const float* in_ctx, LAS unsigned char* lds, const bf16* Ysrc, int layY, int subY, int layA, int subA, int moe_l, int G, int wv) {
    const int tid = opaque_tid(wv), lane = tid & 63, wave = __builtin_amdgcn_readfirstlane(tid >> 6);
    const int gw = blockIdx.x * NWAVES + wave, NGW = G * NWAVES;
    const float* modv = (const float*)(ws + WS_MODV);
    bf16* X = (bf16*)(ws + WS_X); bf16* AY = (bf16*)outp;
    const float* ngY = (const float*)(ws + WS_SMALL) + SM_NORMG + (size_t)(layY * 4 + (subY ? 3 : 1)) * 1024;
    const float* ngA = (const float*)(ws + WS_SMALL) + SM_NORMG + (size_t)(layA * 4 + (subA ? 2 : 0)) * 1024;
    gu32* ctl = (gu32*)(ws + WS_CTL);
    int ts[9];
    if (VAR == 2) { ts[0] = 0;
#pragma unroll
        for (int e = 0; e < 8; ++e) { const unsigned c = (unsigned)__builtin_amdgcn_readfirstlane((int)__hip_atomic_load(ctl + CW_MOECNT + 16 * moe_l + e, RLX_AGENT)); ts[e + 1] = ts[e] + (int)((c + 255u) >> 8); } }
    const int moe_r = ROUTE ? moe_l : 0;
    LAS float* wr = (LAS float*)lds; LAS int* lcnt = (LAS int*)(lds + 32768); LAS int* lbase = lcnt + 8; LAS unsigned* info = (LAS unsigned*)(lds + 33024) + wave * (40 * 4);
    if (ROUTE) { const float* rw = (const float*)(ws + WS_ROUTW) + (size_t)moe_r * 8192;
        for (int i = tid; i < 8192; i += NWAVES * 64) wr[i] = rw[i];
        if (tid < 8) lcnt[tid] = 0;
        __syncthreads(); }
    constexpr int NR = RESID_NR;
    const int RPW = (TA + NGW - 1) / NGW, rbeg = gw * RPW, rend = (rbeg + RPW < TA) ? rbeg + RPW : TA;
    f32x4 ngY_r[4], ngA_r[4], gate_r[4], sh_r[4], sc_r[4]; int miY = -1, miA = -1;
#pragma unroll
    for (int j = 0; j < 4; ++j) { ngY_r[j] = *(const f32x4*)(ngY + RC(j)); ngA_r[j] = *(const f32x4*)(ngA + RC(j)); }
    for (int r0 = rbeg, nrow = 0; r0 < rend; r0 += NR, nrow += NR) {
        int rr[NR], bb[NR], pp[NR], mi[NR]; bool isctx[NR], act[NR];
#pragma unroll
        for (int u = 0; u < NR; ++u) { rr[u] = r0 + u; const bool valid = rr[u] < rend; const int rq = valid ? rr[u] : r0; bb[u] = rq / RPB; pp[u] = rq - bb[u] * RPB; isctx[u] = pp[u] < CTXL; mi[u] = isctx[u] ? 16 : bb[u];
            act[u] = valid && !((NOCTX || FINAL) && isctx[u]);
            if (ROUTE && valid && !act[u] && lane == 0) info[(nrow + u) * 4] = 0xffu;
            rr[u] = rq; }
        f32x4 xv[NR][4]; v2u xraw[NR][4], yraw[NR][4], y1raw[NR][4]; v4u ti[NR];
#pragma unroll
        for (int u = 0; u < NR; ++u) if (act[u]) {
            if (VAR == 0) { const float* src = isctx[u] ? in_ctx + ((size_t)bb[u] * CTXL + pp[u]) * DM : in_x + ((size_t)bb[u] * SEQL + (pp[u] - CTXL)) * DM;
#pragma unroll
                for (int j = 0; j < 4; ++j) xv[u][j] = *(const f32x4*)(src + RC(j)); }
            else { const bf16* xr = X + (size_t)rr[u] * DM;
#pragma unroll
                for (int jj = 0; jj < 2; ++jj) { const v4u w4_ = *(const v4u*)(xr + RC(2 * jj)); xraw[u][2 * jj] = (v2u){w4_.x, w4_.y}; xraw[u][2 * jj + 1] = (v2u){w4_.z, w4_.w}; }
                if (VAR == 1) { const bf16* yr = Ysrc + (size_t)rr[u] * DM;
#pragma unroll
                    for (int jj = 0; jj < 2; ++jj) { const v4u w4_ = *(const v4u*)(yr + RC(2 * jj)); yraw[u][2 * jj] = (v2u){w4_.x, w4_.y}; yraw[u][2 * jj + 1] = (v2u){w4_.z, w4_.w}; } }
                else ti[u] = *(const v4u*)(ws + WS_TOKINFO + (size_t)rr[u] * 16); } }
        float g0v[NR], g1v[NR];
        if (VAR == 2) {
#pragma unroll
            for (int u = 0; u < NR; ++u) if (act[u]) {
                const int e0 = ti[u].x & 15, e1 = ti[u].y & 15; int s0 = 0, s1 = 0;
#pragma unroll
                for (int e = 0; e < 8; ++e) { s0 = (e == e0) ? ts[e] : s0; s1 = (e == e1) ? ts[e] : s1; }
                s0 = s0 * 256 + (int)(ti[u].x >> 4); s1 = s1 * 256 + (int)(ti[u].y >> 4);
                const unsigned gz_ = ti[u].z, gw_ = ti[u].w;
                g0v[u] = __uint_as_float(gz_); g1v[u] = __uint_as_float(gw_);
                const bf16* y0 = (const bf16*)(ws + BIG_YE) + (size_t)s0 * DM; const bf16* y1 = (const bf16*)(ws + BIG_YE) + (size_t)s1 * DM;
#pragma unroll
                for (int jj = 0; jj < 2; ++jj) { const v4u a4_ = *(const v4u*)(y0 + RC(2 * jj)), b4_ = *(const v4u*)(y1 + RC(2 * jj));
                    yraw[u][2 * jj] = (v2u){a4_.x, a4_.y}; yraw[u][2 * jj + 1] = (v2u){a4_.z, a4_.w}; y1raw[u][2 * jj] = (v2u){b4_.x, b4_.y}; y1raw[u][2 * jj + 1] = (v2u){b4_.z, b4_.w}; } } }
#pragma unroll
        for (int u = 0; u < NR; ++u) if (act[u]) {
        const int r = rr[u], b = bb[u], p = pp[u];
        if (VAR != 0) {
            f32x4 yv[4];
#pragma unroll
            for (int j = 0; j < 4; ++j) { const v2u w = yraw[u][j]; yv[j] = (f32x4){bflo(w.x), bfhi(w.x), bflo(w.y), bfhi(w.y)};
                if (VAR == 2) { const v2u w1 = y1raw[u][j]; yv[j] = yv[j] * g0v[u] + (f32x4){bflo(w1.x), bfhi(w1.x), bflo(w1.y), bfhi(w1.y)} * g1v[u]; } }
            float ss = 0.f;
#pragma unroll
            for (int j = 0; j < 4; ++j) ss += (yv[j].x * yv[j].x + yv[j].y * yv[j].y) + (yv[j].z * yv[j].z + yv[j].w * yv[j].w);
            const float rstd = __builtin_amdgcn_rsqf(wave_sum(ss) * (1.f / DM) + NORM_EPS);
            if (mi[u] != miY) { miY = mi[u]; const float* gate = modv + ((size_t)(layY * 17 + miY) * 6 + (subY ? 5 : 2)) * 1024;
#pragma unroll
                for (int j = 0; j < 4; ++j) gate_r[j] = *(const f32x4*)(gate + RC(j)) * ngY_r[j]; }
#pragma unroll
            for (int j = 0; j < 4; ++j) { const f32x4 g = gate_r[j]; const v2u xw_ = xraw[u][j]; const f32x4 x0 = (f32x4){bflo(xw_.x), bfhi(xw_.x), bflo(xw_.y), bfhi(xw_.y)};
                xv[u][j] = x0 + g * (yv[j] * rstd); }
        }
        if (FINAL) { float* orow = outp + ((size_t)b * SEQL + (p - CTXL)) * DM;
#pragma unroll
                for (int j = 0; j < 4; ++j) *(f32x4*)(orow + RC(j)) = xv[u][j]; }
        else {
            bf16* xw = X + (size_t)r * DM;
#pragma unroll
            for (int jj = 0; jj < 2; ++jj) { v4u w; w.x = pk2(xv[u][2 * jj].x, xv[u][2 * jj].y); w.y = pk2(xv[u][2 * jj].z, xv[u][2 * jj].w); w.z = pk2(xv[u][2 * jj + 1].x, xv[u][2 * jj + 1].y); w.w = pk2(xv[u][2 * jj + 1].z, xv[u][2 * jj + 1].w);
                *(v4u*)(xw + RC(2 * jj)) = w;
                xv[u][2 * jj] = (f32x4){bflo(w.x), bfhi(w.x), bflo(w.y), bfhi(w.y)}; xv[u][2 * jj + 1] = (f32x4){bflo(w.z), bfhi(w.z), bflo(w.w), bfhi(w.w)}; }
            float ss = 0.f;
#pragma unroll
            for (int j = 0; j < 4; ++j) ss += (xv[u][j].x * xv[u][j].x + xv[u][j].y * xv[u][j].y) + (xv[u][j].z * xv[u][j].z + xv[u][j].w * xv[u][j].w);
            const float rstd = __builtin_amdgcn_rsqf(wave_sum(ss) * (1.f / DM) + NORM_EPS);
            if (mi[u] != miA) { miA = mi[u]; const float* sh = modv + ((size_t)(layA * 17 + miA) * 6 + (subA ? 3 : 0)) * 1024; const float* sc = sh + 1024;
#pragma unroll
                for (int j = 0; j < 4; ++j) { sh_r[j] = *(const f32x4*)(sh + RC(j)); sc_r[j] = (*(const f32x4*)(sc + RC(j)) + 1.f) * ngA_r[j]; } }
            bf16* ar = AY + (size_t)r * DM; f32x4 av[4];
#pragma unroll
            for (int j = 0; j < 4; ++j) { const f32x4 s1 = sc_r[j], s0 = sh_r[j]; av[j] = (xv[u][j] * rstd) * s1 + s0; }
#pragma unroll
            for (int jj = 0; jj < 2; ++jj) { const int c = RC(2 * jj); const f32x4 a0 = av[2 * jj], a1 = av[2 * jj + 1];
                if (A8) { v2u w8; w8.x = pg8::pack4_fp8(a0.x * A8_SCALE, a0.y * A8_SCALE, a0.z * A8_SCALE, a0.w * A8_SCALE); w8.y = pg8::pack4_fp8(a1.x * A8_SCALE, a1.y * A8_SCALE, a1.z * A8_SCALE, a1.w * A8_SCALE);
                    *(v2u*)((unsigned char*)outp + A8_OFF + (size_t)r * DM + c) = w8; }
                else { v4u w; w.x = pk2(a0.x, a0.y); w.y = pk2(a0.z, a0.w); w.z = pk2(a1.x, a1.y); w.w = pk2(a1.z, a1.w); *(v4u*)(ar + c) = w; } }
            if (ROUTE) {
                float lg[8];
#pragma unroll
                for (int e = 0; e < 8; ++e) { float s = 0.f;
#pragma unroll
                    for (int j = 0; j < 4; ++j) { const f32x4 w4 = *(const LAS f32x4*)(wr + e * 1024 + RC(j)); s += (av[j].x * w4.x + av[j].y * w4.y) + (av[j].z * w4.z + av[j].w * w4.w); }
                    lg[e] = wave_sum(s); }
                int i0 = 0; float v0 = lg[0];
#pragma unroll
                for (int e = 1; e < 8; ++e) if (lg[e] > v0) { v0 = lg[e]; i0 = e; }
                int i1 = 0; float v1 = -3.0e38f;
#pragma unroll
                for (int e = 0; e < 8; ++e) if (e != i0 && lg[e] > v1) { v1 = lg[e]; i1 = e; }
                const float g0 = 1.f / (1.f + __expf(v1 - v0)), g1 = 1.f - g0;
                if (lane == 0) { const int q0_ = __hip_atomic_fetch_add(lcnt + i0, 1, __ATOMIC_RELAXED, __HIP_MEMORY_SCOPE_WORKGROUP), q1_ = __hip_atomic_fetch_add(lcnt + i1, 1, __ATOMIC_RELAXED, __HIP_MEMORY_SCOPE_WORKGROUP);
                    LAS unsigned* q = info + (nrow + u) * 4; q[0] = (unsigned)i0; q[1] = (unsigned)q0_; q[2] = (unsigned)i1; q[3] = (unsigned)q1_;
                    v2u gg; gg.x = __builtin_bit_cast(unsigned, g0); gg.y = __builtin_bit_cast(unsigned, g1); *(v2u*)(ws + WS_TOKINFO + (size_t)r * 16 + 8) = gg; }
            }
        }
        }
    }
    if (ROUTE) {
        __syncthreads();
        if (tid < 8) lbase[tid] = (int)__hip_atomic_fetch_add(ctl + CW_MOECNT + 16 * moe_r + tid, (unsigned)lcnt[tid], RLX_AGENT);
        __syncthreads();
        if (lane == 0) { int k = 0; int* lists = (int*)(ws + WS_LISTS);
            for (int r = rbeg; r < rend; ++r, ++k) { const LAS unsigned* q = info + k * 4; if (q[0] == 0xffu) continue; const int e0 = (int)q[0], e1 = (int)q[2]; const int r0 = (int)q[1] + lbase[e0], r1 = (int)q[3] + lbase[e1];
                lists[(size_t)e0 * TA + r0] = r; lists[(size_t)e1 * TA + r1] = r;
                v2u ti; ti.x = (unsigned)e0 | ((unsigned)r0 << 4); ti.y = (unsigned)e1 | ((unsigned)r1 << 4);
                *(v2u*)(ws + WS_TOKINFO + (size_t)r * 16) = ti; } }
        __syncthreads();
    }
}

namespace att {
#define SBAR() __builtin_amdgcn_sched_barrier(0)
#define SWZX(v, k) __builtin_bit_cast(float, __builtin_amdgcn_ds_swizzle(__builtin_bit_cast(int, (float)(v)), ((k) << 10) | 0x1f))
constexpr float THRL = 8.f;
__device__ __forceinline__ int crow(int r, int hi) { return (r & 3) + 8 * (r >> 2) + 4 * hi; }
__device__ __forceinline__ unsigned cvtpk(float lo, float hi) { unsigned r; asm volatile("v_cvt_pk_bf16_f32 %0, %1, %2" : "=v"(r) : "v"(lo), "v"(hi)); return r; }
__device__ __forceinline__ void partialSM(f32x16& p0, f32x16& p1, float& m_reg, float& mn, float& alpha) {
    float pmax = p0[0];
#pragma unroll
    for (int r = 1; r < 16; ++r) pmax = fmaxf(pmax, p0[r]);
#pragma unroll
    for (int r = 0; r < 16; ++r) pmax = fmaxf(pmax, p1[r]);
    { auto rr = __builtin_amdgcn_permlane32_swap(__float_as_uint(pmax), __float_as_uint(pmax), false, false);
      pmax = fmaxf(__uint_as_float(rr[0]), __uint_as_float(rr[1])); }
    if (__builtin_expect(__all(pmax - m_reg <= THRL), 1)) { mn = m_reg; alpha = 1.f; }
    else { mn = fmaxf(m_reg, pmax); alpha = __builtin_amdgcn_exp2f(m_reg - mn); m_reg = mn; }
#pragma unroll
    for (int r = 0; r < 16; ++r) p0[r] = p0[r] - mn;
#pragma unroll
    for (int r = 0; r < 16; ++r) p1[r] = p1[r] - mn;
#pragma unroll
    for (int r = 0; r < 16; ++r) p0[r] = __builtin_amdgcn_exp2f(p0[r]);
}

__device__ __forceinline__ float sm_max16(const f32x16& p) { float a = p[0];
#pragma unroll
    for (int r = 1; r < 16; ++r) a = fmaxf(a, p[r]);
    return a; }
__device__ __forceinline__ void sm_decide(float pmax, float& m_reg, float& mn, float& alpha) {
    { auto rr = __builtin_amdgcn_permlane32_swap(__float_as_uint(pmax), __float_as_uint(pmax), false, false);
      pmax = fmaxf(__uint_as_float(rr[0]), __uint_as_float(rr[1])); }
    if (__builtin_expect(__all(pmax - m_reg <= THRL), 1)) { mn = m_reg; alpha = 1.f; }
    else { mn = fmaxf(m_reg, pmax); alpha = __builtin_amdgcn_exp2f(m_reg - mn); m_reg = mn; } }
__device__ __forceinline__ void sm_subexp(f32x16& p, float mn) {
#pragma unroll
    for (int r = 0; r < 16; ++r) p[r] = __builtin_amdgcn_exp2f(p[r] - mn); }
__device__ __forceinline__ void sm_sub(f32x16& p, float mn) {
#pragma unroll
    for (int r = 0; r < 16; ++r) p[r] = p[r] - mn; }
__device__ __forceinline__ void finishSM(f32x16& p0, f32x16& p1, float alpha, float& l_reg, bf16x8& pa0, bf16x8& pa1, bf16x8& pa2, bf16x8& pa3) {
#pragma unroll
    for (int r = 0; r < 16; ++r) p1[r] = __builtin_amdgcn_exp2f(p1[r]);
    float ps = 0;
#pragma unroll
    for (int r = 0; r < 16; ++r) ps += p0[r];
#pragma unroll
    for (int r = 0; r < 16; ++r) ps += p1[r];
    { auto rr = __builtin_amdgcn_permlane32_swap(__float_as_uint(ps), __float_as_uint(ps), false, false);
      ps = __uint_as_float(rr[0]) + __uint_as_float(rr[1]); }
    l_reg = l_reg * alpha + ps;
#define PK4(P, BASE, OUT) do { unsigned a0 = cvtpk(P[BASE + 0], P[BASE + 1]), a1 = cvtpk(P[BASE + 2], P[BASE + 3]);   \
    unsigned b0 = cvtpk(P[BASE + 4], P[BASE + 5]), b1 = cvtpk(P[BASE + 6], P[BASE + 7]);                              \
    v4u w = {a0, a1, b0, b1}; OUT = __builtin_bit_cast(bf16x8, w); } while (0)
    PK4(p0, 0, pa0); PK4(p0, 8, pa1); PK4(p1, 0, pa2); PK4(p1, 8, pa3);
#undef PK4
}
template <int NCB> __device__ __forceinline__ int v_st(int k, int c) { const int kk = k; return ((kk >> 3) * NCB + (c >> 5)) * 512 + ((kk & 7) * 32 + (c & 31)) * 2; }
__device__ __forceinline__ int v_rd_base(int lane) { return ((lane & 3) << 3) | (((lane >> 2) & 3) << 6) | (((lane >> 4) & 1) << 5) | (((lane >> 5) & 1) << 8); }
template <int OFF> __device__ __forceinline__ s16x4 tr_read(int vb) { s16x4 r; asm volatile("ds_read_b64_tr_b16 %0, %1 offset:%2" : "=&v"(r) : "v"(vb), "i"(OFF) : "memory"); return r; }
template <int D0, int NCB> __device__ __forceinline__ void pv_one(f32x16& od, int vb, bf16x8 pa0, bf16x8 pa1, bf16x8 pa2, bf16x8 pa3) {
#define VOFF(ks, half) (((2 * (ks) + (half)) * NCB + D0) * 512)
    const s16x4 l0 = tr_read<VOFF(0, 0)>(vb), h0 = tr_read<VOFF(0, 1)>(vb), l1 = tr_read<VOFF(1, 0)>(vb), h1 = tr_read<VOFF(1, 1)>(vb);
    const s16x4 l2 = tr_read<VOFF(2, 0)>(vb), h2 = tr_read<VOFF(2, 1)>(vb), l3 = tr_read<VOFF(3, 0)>(vb), h3 = tr_read<VOFF(3, 1)>(vb);
#undef VOFF
    asm volatile("s_waitcnt lgkmcnt(0)" ::: "memory"); SBAR();
#define PK(L, H) (bf16x8){L[0], L[1], L[2], L[3], H[0], H[1], H[2], H[3]}
    od = __builtin_amdgcn_mfma_f32_32x32x16_bf16(pa0, PK(l0, h0), od, 0, 0, 0);
    od = __builtin_amdgcn_mfma_f32_32x32x16_bf16(pa1, PK(l1, h1), od, 0, 0, 0);
    od = __builtin_amdgcn_mfma_f32_32x32x16_bf16(pa2, PK(l2, h2), od, 0, 0, 0);
    od = __builtin_amdgcn_mfma_f32_32x32x16_bf16(pa3, PK(l3, h3), od, 0, 0, 0);
#undef PK
}

constexpr int DA_LD = 3072, SHM_T = 64 * 128 * 2;
#define KSWZ(row, colB) ((row) * 256 + ((colB) ^ (((row) & 7) << 4)))
__device__ __forceinline__ void da_unit64(const bf16* __restrict__ QKV_, bf16* __restrict__ O_, int b, int h, int q0, int nkeys, float lam, float oscale, const float* __restrict__ subg, char* lds, int wv) {
    const int tid = opaque_tid(wv), wid = __builtin_amdgcn_readfirstlane(tid >> 6), lane = tid & 63, r32 = lane & 31, hi = lane >> 5, mp = wid >> 2, rgi = wid & 3;
    const bf16* QKV = QKV_; bf16* O = O_; asm volatile("" : "+s"(QKV), "+s"(O));
    char* V_lds = lds; char* K_lds = lds + 2 * SHM_T;
    char* Q1_lds = lds + 4 * SHM_T;
    float* wsf = (float*)(lds + 6 * SHM_T) + wid * 128;
    const size_t rb0 = (size_t)b * RPB;
    float m_reg[2] = {0.f, 0.f}, l_reg[2] = {0.f, 0.f}; f32x16 o[2][4] = {}; bf16x8 qr[4]; asm volatile("" : "+v"(m_reg[0]), "+v"(m_reg[1]));
    { const bf16* Qw = QKV + (rb0 + q0 + rgi * 64 + r32) * DA_LD + h * 128 + mp * 64 + hi * 8;
#pragma unroll
        for (int d0 = 0; d0 < 4; ++d0) qr[d0] = *(const bf16x8*)(Qw + d0 * 16);
#pragma unroll
        for (int i = 0; i < 4; ++i) { const int p = tid + 512 * i, row = p >> 4, ch = p & 15;
            const bf16x8 v = *(const bf16x8*)(QKV + (rb0 + q0 + (row >> 5) * 64 + 32 + (row & 31)) * DA_LD + h * 128 + ch * 8);
            *(bf16x8*)(Q1_lds + row * 256 + ((ch ^ (row & 7)) << 4)) = v; } }
    const int q1off = (rgi * 32 + r32) * 256;
    const bf16* Kh = QKV + rb0 * DA_LD + 1024 + h * 128; const bf16* Vh = Kh + 1024;
    const int vb0 = (int)(uintptr_t)V_lds + v_rd_base(lane);
    const unsigned ldsK = (unsigned)(uintptr_t)K_lds + wid * 2048u, ldsV = (unsigned)(uintptr_t)V_lds + wid * 2048u;
#define DMA1(voffs, gbase, ldsdst) do { unsigned keep_; asm volatile("s_mov_b32 %0, m0\n\ts_mov_b32 m0, %3\n\ts_nop 0\n\tglobal_load_lds_dwordx4 %1, %2\n\ts_mov_b32 m0, %0" : "=&s"(keep_) : "v"(voffs), "s"(gbase), "s"((unsigned)__builtin_amdgcn_readfirstlane((int)(ldsdst))) : "memory"); } while (0)
#define DMA_TILE(k0, bq) do { const char* kb_ = (const char*)(Kh + (size_t)(k0) * DA_LD); const char* vb_ = (const char*)(Vh + (size_t)(k0) * DA_LD); \
    int t_ = tid; asm volatile("" : "+v"(t_)); const int ln = t_ & 63;       \
    _Pragma("unroll") for (int t = 0; t < 2; ++t) { const int i = wid * 2 + t; \
        const int row = 4 * i + (ln >> 4), chp = ln & 15, gch = chp ^ (row & 7); const unsigned koff_ = __umul24((unsigned)row, (unsigned)(DA_LD * 2)) + (unsigned)(gch * 16);   \
        const int p16 = 64 * i + ln, sub = p16 >> 5, within = p16 & 31, kk = (sub >> 2) * 8 + (within >> 2), c = (sub & 3) * 32 + (within & 3) * 8; \
        const int k = kk; const unsigned voff_ = __umul24((unsigned)k, (unsigned)(DA_LD * 2)) + (unsigned)(c * 2); \
        DMA1(koff_, kb_, ldsK + (bq) * SHM_T + 1024u * t); DMA1(voff_, vb_, ldsV + (bq) * SHM_T + 1024u * t); } } while (0)
#define DMA_WAIT_BAR() do { asm volatile("s_waitcnt vmcnt(0)" ::: "memory"); __syncthreads(); } while (0)
    const int NT = nkeys / 64;
    DMA_TILE(0, 0); DMA_WAIT_BAR();
    for (int j = 0; j < NT; ++j) {
        const char* Kb = K_lds + (j & 1) * SHM_T; const int vb = vb0 + (j & 1) * SHM_T;
        if (j + 1 < NT) DMA_TILE((j + 1) * 64, (j + 1) & 1);
        f32x16 p[2][2];
#define QK_ALL() do { _Pragma("unroll") for (int rb = 0; rb < 2; ++rb) { \
            const v4u aw = {hi ? 0u : 0x3F80u, 0u, 0u, 0u}, bw = {__float_as_uint(-m_reg[rb]) >> 16, 0u, 0u, 0u}; \
            p[rb][0] = __builtin_amdgcn_mfma_f32_32x32x16_bf16(__builtin_bit_cast(bf16x8, aw), __builtin_bit_cast(bf16x8, bw), f32x16{}, 0, 0, 0); \
            p[rb][1] = __builtin_amdgcn_mfma_f32_32x32x16_bf16(__builtin_bit_cast(bf16x8, aw), __builtin_bit_cast(bf16x8, bw), f32x16{}, 0, 0, 0); } \
        _Pragma("unroll") for (int d0 = 0; d0 < 4; ++d0) { const int cb = ((mp * 4 + d0) * 16 + hi * 8) * 2; \
            const bf16x8 k0 = *(const bf16x8*)(Kb + KSWZ(r32, cb)), k1 = *(const bf16x8*)(Kb + KSWZ(32 + r32, cb)); \
            const bf16x8 q1 = *(const bf16x8*)(Q1_lds + q1off + (((mp * 8 + d0 * 2 + hi) ^ (r32 & 7)) << 4)); \
            p[0][0] = __builtin_amdgcn_mfma_f32_32x32x16_bf16(k0, qr[d0], p[0][0], 0, 0, 0); p[0][1] = __builtin_amdgcn_mfma_f32_32x32x16_bf16(k1, qr[d0], p[0][1], 0, 0, 0); \
            p[1][0] = __builtin_amdgcn_mfma_f32_32x32x16_bf16(k0, q1, p[1][0], 0, 0, 0); p[1][1] = __builtin_amdgcn_mfma_f32_32x32x16_bf16(k1, q1, p[1][1], 0, 0, 0); \
            SBAR(); } } while (0)
#define EXPSUM(rb) do { _Pragma("unroll") for (int r = 0; r < 16; ++r) { p[rb][0][r] = __builtin_amdgcn_exp2f(p[rb][0][r]); p[rb][1][r] = __builtin_amdgcn_exp2f(p[rb][1][r]); } \
            float ps_ = p[rb][0][0]; _Pragma("unroll") for (int r = 1; r < 16; ++r) ps_ += p[rb][0][r]; _Pragma("unroll") for (int r = 0; r < 16; ++r) ps_ += p[rb][1][r]; \
            { auto rr = __builtin_amdgcn_permlane32_swap(__float_as_uint(ps_), __float_as_uint(ps_), false, false); ps_ = __uint_as_float(rr[0]) + __uint_as_float(rr[1]); } psv[rb] = ps_; } while (0)
#define QK_ONE(rb) do { int tq_ = tid; asm volatile("" : "+v"(tq_)); const int r32q = tq_ & 31, hiq = (tq_ >> 5) & 1; \
        { const v4u aw = {hiq ? 0u : 0x3F80u, 0u, 0u, 0u}, bw = {__float_as_uint(-m_reg[rb]) >> 16, 0u, 0u, 0u}; \
            p[rb][0] = __builtin_amdgcn_mfma_f32_32x32x16_bf16(__builtin_bit_cast(bf16x8, aw), __builtin_bit_cast(bf16x8, bw), f32x16{}, 0, 0, 0); \
            p[rb][1] = __builtin_amdgcn_mfma_f32_32x32x16_bf16(__builtin_bit_cast(bf16x8, aw), __builtin_bit_cast(bf16x8, bw), f32x16{}, 0, 0, 0); } \
        _Pragma("unroll") for (int d0 = 0; d0 < 4; ++d0) { const int cb = ((mp * 4 + d0) * 16 + hiq * 8) * 2; \
            const bf16x8 k0 = *(const bf16x8*)(Kb + KSWZ(r32q, cb)), k1 = *(const bf16x8*)(Kb + KSWZ(32 + r32q, cb)); \
            const bf16x8 qq = (rb) ? *(const bf16x8*)(Q1_lds + (rgi * 32 + r32q) * 256 + (((mp * 8 + d0 * 2 + hiq) ^ (r32q & 7)) << 4)) : qr[d0]; \
            p[rb][0] = __builtin_amdgcn_mfma_f32_32x32x16_bf16(k0, qq, p[rb][0], 0, 0, 0); p[rb][1] = __builtin_amdgcn_mfma_f32_32x32x16_bf16(k1, qq, p[rb][1], 0, 0, 0); \
            SBAR(); } } while (0)
#define ROWMAX(rb, pm) do { pm = fmaxf(sm_max16(p[rb][0]), sm_max16(p[rb][1])); \
        auto rr = __builtin_amdgcn_permlane32_swap(__float_as_uint(pm), __float_as_uint(pm), false, false); pm = fmaxf(__uint_as_float(rr[0]), __uint_as_float(rr[1])); } while (0)
        QK_ALL();
        bf16x8 pa[2][4]; float psv[2];
#pragma unroll
        for (int rb = 0; rb < 2; ++rb) {
            float al = 1.f; bool raw = (j == 0);
            if (!raw) {
                EXPSUM(rb);
                if (__builtin_expect(__any(!(psv[rb] <= 256.f)), 0)) {
                    float pm; ROWMAX(rb, pm);
                    if (__any(!(pm < 3e38f))) raw = true;
                    else { float d = fmaxf(__builtin_amdgcn_logf(pm), 0.f); const float mnew = __uint_as_float(pk2(0.f, m_reg[rb] + d) & 0xffff0000u); d = mnew - m_reg[rb]; m_reg[rb] = mnew;
                        al = __builtin_amdgcn_exp2f(-d); psv[rb] *= al;
#pragma unroll
                        for (int r = 0; r < 16; ++r) { p[rb][0][r] *= al; p[rb][1][r] *= al; } } } }
            if (__builtin_expect(raw, 0)) {
                if (j != 0) QK_ONE(rb);
                float pm; ROWMAX(rb, pm);
                const float mnew = __uint_as_float(pk2(0.f, m_reg[rb] + (j == 0 ? pm : fmaxf(pm, 0.f))) & 0xffff0000u), d = mnew - m_reg[rb];
                m_reg[rb] = mnew; al = __builtin_amdgcn_exp2f(-d); sm_sub(p[rb][0], d); sm_sub(p[rb][1], d);
                EXPSUM(rb); }
            const float ps = psv[rb];
            l_reg[rb] = l_reg[rb] * al + ps;
#define PK4(P, BASE, OUT) do { unsigned a0 = cvtpk(P[BASE + 0], P[BASE + 1]), a1 = cvtpk(P[BASE + 2], P[BASE + 3]);   \
    unsigned b0 = cvtpk(P[BASE + 4], P[BASE + 5]), b1 = cvtpk(P[BASE + 6], P[BASE + 7]);                              \
    v4u w = {a0, a1, b0, b1}; OUT = __builtin_bit_cast(bf16x8, w); } while (0)
            PK4(p[rb][0], 0, pa[rb][0]); PK4(p[rb][0], 8, pa[rb][1]); PK4(p[rb][1], 0, pa[rb][2]); PK4(p[rb][1], 8, pa[rb][3]);
#undef PK4
            if (__any(al < 1.f)) { float* al_l = wsf + 64 + rb * 32; if (hi == 0) al_l[r32] = al; asm volatile("s_waitcnt lgkmcnt(0)" ::: "memory");
#pragma unroll
                for (int d = 0; d < 4; ++d)
#pragma unroll
                    for (int r = 0; r < 16; ++r) o[rb][d][r] *= al_l[crow(r, hi)]; }
        }
#undef QK_ALL
#undef QK_ONE
#undef ROWMAX
#undef EXPSUM
#define PV_READ(D0, v) do { v[0] = tr_read<((0) * 4 + D0) * 512>(vb); v[1] = tr_read<((1) * 4 + D0) * 512>(vb); v[2] = tr_read<((2) * 4 + D0) * 512>(vb); v[3] = tr_read<((3) * 4 + D0) * 512>(vb); \
        v[4] = tr_read<((4) * 4 + D0) * 512>(vb); v[5] = tr_read<((5) * 4 + D0) * 512>(vb); v[6] = tr_read<((6) * 4 + D0) * 512>(vb); v[7] = tr_read<((7) * 4 + D0) * 512>(vb); } while (0)
#define PV_MMA(D0, v) do { \
        const bf16x8 f0 = (bf16x8){v[0][0], v[0][1], v[0][2], v[0][3], v[1][0], v[1][1], v[1][2], v[1][3]}, f1 = (bf16x8){v[2][0], v[2][1], v[2][2], v[2][3], v[3][0], v[3][1], v[3][2], v[3][3]}; \
        const bf16x8 f2 = (bf16x8){v[4][0], v[4][1], v[4][2], v[4][3], v[5][0], v[5][1], v[5][2], v[5][3]}, f3 = (bf16x8){v[6][0], v[6][1], v[6][2], v[6][3], v[7][0], v[7][1], v[7][2], v[7][3]}; \
        _Pragma("unroll") for (int rb = 0; rb < 2; ++rb) { o[rb][D0] = __builtin_amdgcn_mfma_f32_32x32x16_bf16(pa[rb][0], f0, o[rb][D0], 0, 0, 0); o[rb][D0] = __builtin_amdgcn_mfma_f32_32x32x16_bf16(pa[rb][1], f1, o[rb][D0], 0, 0, 0); \
            o[rb][D0] = __builtin_amdgcn_mfma_f32_32x32x16_bf16(pa[rb][2], f2, o[rb][D0], 0, 0, 0); o[rb][D0] = __builtin_amdgcn_mfma_f32_32x32x16_bf16(pa[rb][3], f3, o[rb][D0], 0, 0, 0); } } while (0)
        { s16x4 va[8], vc[8];
          PV_READ(0, va);
          PV_READ(1, vc); asm volatile("s_waitcnt lgkmcnt(8)" ::: "memory"); SBAR(); PV_MMA(0, va); SBAR();
          PV_READ(2, va); asm volatile("s_waitcnt lgkmcnt(8)" ::: "memory"); SBAR(); PV_MMA(1, vc); SBAR();
          PV_READ(3, vc); asm volatile("s_waitcnt lgkmcnt(8)" ::: "memory"); SBAR(); PV_MMA(2, va); SBAR();
          asm volatile("s_waitcnt lgkmcnt(0)" ::: "memory"); SBAR(); PV_MMA(3, vc); }
#undef PV_READ
#undef PV_MMA
        DMA_WAIT_BAR();
    }
    float* xch = (float*)lds;
    int tide_ = tid; asm volatile("" : "+v"(tide_)); const int lanee = tide_ & 63, r32e = lanee & 31, hie = lanee >> 5;
#pragma unroll
    for (int rb = 0; rb < 2; ++rb) {
        float* li_l = wsf + rb * 32;
        if (hie == 0) li_l[r32e] = l_reg[rb]; asm volatile("s_waitcnt lgkmcnt(0)" ::: "memory");
        float rli[16];
#pragma unroll
        for (int r = 0; r < 16; ++r) rli[r] = __builtin_amdgcn_rcpf(li_l[crow(r, hie)]);
        if (rb) __syncthreads();
        if (mp == 1) {
#pragma unroll
            for (int d0 = 0; d0 < 4; ++d0)
#pragma unroll
                for (int r = 0; r < 16; ++r) xch[((rgi * 4 + d0) * 16 + r) * 64 + lanee] = o[rb][d0][r] * rli[r] * lam; }
        __syncthreads();
        if (mp == 0) {
#pragma unroll
            for (int d0 = 0; d0 < 4; ++d0)
#pragma unroll
                for (int r = 0; r < 16; ++r) o[rb][d0][r] = o[rb][d0][r] * rli[r] - xch[((rgi * 4 + d0) * 16 + r) * 64 + lanee];
            float g4[4];
#pragma unroll
            for (int d0 = 0; d0 < 4; ++d0) g4[d0] = subg[d0 * 32 + r32e] * oscale;
#pragma unroll
            for (int r = 0; r < 16; ++r) {
                float s = (o[rb][0][r] * o[rb][0][r] + o[rb][1][r] * o[rb][1][r]) + (o[rb][2][r] * o[rb][2][r] + o[rb][3][r] * o[rb][3][r]);
#define S_DPP(ctrl) s += __builtin_bit_cast(float, __builtin_amdgcn_update_dpp(0, __builtin_bit_cast(int, s), (ctrl), 0xF, 0xF, true))
                S_DPP(0xB1); S_DPP(0x4E); S_DPP(0x141); S_DPP(0x140);
#undef S_DPP
                { const unsigned u_ = __builtin_bit_cast(unsigned, s); auto rr_ = __builtin_amdgcn_permlane16_swap(u_, u_, false, false); s = __builtin_bit_cast(float, (unsigned)rr_[0]) + __builtin_bit_cast(float, (unsigned)rr_[1]); }
                const float rstd = __builtin_amdgcn_rsqf(s * (1.f / 128.f) + NORM_EPS);
                bf16* orow = O + (rb0 + q0 + rgi * 64 + rb * 32 + crow(r, hie)) * DM + h * 128 + r32e;
#pragma unroll
                for (int d0 = 0; d0 < 4; ++d0) orow[d0 * 32] = (bf16)(pk2(o[rb][d0][r] * rstd * g4[d0], 0.f) & 0xffffu);
            }
        }
    }
    __syncthreads();
#undef DMA1
#undef DMA_TILE
#undef DMA_WAIT_BAR
}

constexpr int WA_LD = 1536, SHM_T64 = 64 * 64 * 2;
#define KSWZ64(row, colB) ((row) * 128 + ((colB) ^ (((row) & 7) << 4)))
__device__ __forceinline__ void wa_unit(const bf16* __restrict__ QKV, bf16* __restrict__ O, int b, int g, int blk, const float* __restrict__ sink, char* lds, int wv) {
    const int tid = opaque_tid(wv), wid = tid >> 6, lane = tid & 63, r32 = lane & 31, hi = lane >> 5, hd = wid >> 1, hf = wid & 1;
    char* V_lds = lds; char* K_lds = lds + 2 * SHM_T;
    float* wsf = (float*)(lds + 4 * SHM_T) + wid * 64; float* li_l = wsf; float* al_l = wsf + 32;
    const size_t rb = (size_t)b * RPB;
    const bool isctx = blk < 4; const int q0 = (blk - 4) * 64;
    const int NT = isctx ? 4 : 10;
    float m_reg = -1e30f, l_reg = 0.f; f32x16 o[2] = {}; bf16x8 qr[4];
    const bf16* Qw = QKV + (rb + blk * 64 + hf * 32 + r32) * WA_LD + (g * 4 + hd) * 64 + hi * 8;
#pragma unroll
    for (int d0 = 0; d0 < 4; ++d0) qr[d0] = *(const bf16x8*)(Qw + d0 * 16);
    const bf16* Kh = QKV + rb * WA_LD + 1024 + g * 64; const bf16* Vh = Kh + 256;
    const int sr = tid >> 3, sc = (tid & 7) * 8, vst = v_st<2>(sr, sc);
    const int vb0 = (int)(uintptr_t)V_lds + v_rd_base(lane);
    const int qp = q0 + hf * 32 + r32;
#define TKP(t) (q0 - 128 + 64 * ((t) - 4))
#define TROW(t) (((t) < 4) ? 64 * (t) : (((t) < 9 && TKP(t) >= 0 && TKP(t) < SEQL) ? CTXL + TKP(t) : 0))
    bf16x8 vsA, ksA, vsB, ksB;
#define SLOADA(t) do { const int k0_ = TROW(t); vsA = *(const bf16x8*)(Vh + (size_t)(k0_ + sr) * WA_LD + sc); ksA = *(const bf16x8*)(Kh + (size_t)(k0_ + sr) * WA_LD + sc); } while (0)
#define SLOADB(t) do { const int k0_ = TROW(t); vsB = *(const bf16x8*)(Vh + (size_t)(k0_ + sr) * WA_LD + sc); ksB = *(const bf16x8*)(Kh + (size_t)(k0_ + sr) * WA_LD + sc); } while (0)
#define SWRITE(bq, V0, K0) do { *(bf16x8*)(V_lds + (bq) * SHM_T + vst) = V0; *(bf16x8*)(K_lds + (bq) * SHM_T + KSWZ64(sr, sc * 2)) = K0; } while (0)
#define SWAIT() asm volatile("s_waitcnt vmcnt(2)" ::: "memory")
#define RESC(al) do { if (__any((al) < 1.f)) { if (hi == 0) al_l[r32] = (al); asm volatile("s_waitcnt lgkmcnt(0)" ::: "memory"); \
    _Pragma("unroll") for (int d = 0; d < 2; ++d) _Pragma("unroll") for (int r = 0; r < 16; ++r) o[d][r] *= al_l[crow(r, hi)]; } } while (0)
#define MASKT(P0, P1, t) do { if ((t) >= 4) { const int kp0_ = TKP(t); const bool tv_ = ((t) < 9) && kp0_ >= 0 && kp0_ < SEQL; \
    if (!tv_) { _Pragma("unroll") for (int r = 0; r < 16; ++r) { P0[r] = -1e30f; P1[r] = -1e30f; } }                  \
    else if ((t) == 4 || (t) == 8) {                                                                                  \
    _Pragma("unroll") for (int r = 0; r < 16; ++r) { const int d0_ = qp - (kp0_ + crow(r, hi)); const int d1_ = d0_ - 32; \
        if (d0_ > 128 || d0_ < -128) P0[r] = -1e30f; if (d1_ > 128 || d1_ < -128) P1[r] = -1e30f; } } } } while (0)
#define QKT(P0, P1, KB, t) do { P0 = f32x16{}; P1 = f32x16{}; _Pragma("unroll") for (int d0 = 0; d0 < 4; ++d0) { const int cb = (d0 * 16 + hi * 8) * 2; \
    const bf16x8 b0 = *(const bf16x8*)((KB) + KSWZ64(r32, cb)); const bf16x8 b1 = *(const bf16x8*)((KB) + KSWZ64(32 + r32, cb)); \
    P0 = __builtin_amdgcn_mfma_f32_32x32x16_bf16(b0, qr[d0], P0, 0, 0, 0); P1 = __builtin_amdgcn_mfma_f32_32x32x16_bf16(b1, qr[d0], P1, 0, 0, 0); } MASKT(P0, P1, t); } while (0)
#define PV2(VB) do { pv_one<0, 2>(o[0], VB, pa0, pa1, pa2, pa3); pv_one<1, 2>(o[1], VB, pa0, pa1, pa2, pa3); } while (0)
    f32x16 pA0, pA1, pB0, pB1; float mnA, mnB, alA, alB; bf16x8 pa0, pa1, pa2, pa3;
    SLOADA(0); asm volatile("s_waitcnt vmcnt(0)" ::: "memory"); SWRITE(0, vsA, ksA); __syncthreads();
    QKT(pA0, pA1, K_lds, 0); partialSM(pA0, pA1, m_reg, mnA, alA);
    SLOADB(1); if (2 < NT) SLOADA(2);
    SWAIT(); SWRITE(1, vsB, ksB); __syncthreads();
    for (int j = 1; j + 1 < NT; j += 2) {
        SBAR(); QKT(pB0, pB1, K_lds + SHM_T, j);
        finishSM(pA0, pA1, alA, l_reg, pa0, pa1, pa2, pa3); SBAR();
        SLOADB(j + 2); SBAR();
        PV2(vb0); partialSM(pB0, pB1, m_reg, mnB, alB);
        __syncthreads(); SWAIT(); SWRITE(0, vsA, ksA);
        RESC(alB); __syncthreads();
        SBAR(); QKT(pA0, pA1, K_lds, j + 1);
        finishSM(pB0, pB1, alB, l_reg, pa0, pa1, pa2, pa3); SBAR();
        if (j + 3 < NT) SLOADA(j + 3); SBAR();
        PV2(vb0 + SHM_T); partialSM(pA0, pA1, m_reg, mnA, alA);
        __syncthreads(); SWAIT(); SWRITE(1, vsB, ksB);
        RESC(alA); __syncthreads();
    }
    SBAR(); QKT(pB0, pB1, K_lds + SHM_T, NT - 1);
    finishSM(pA0, pA1, alA, l_reg, pa0, pa1, pa2, pa3); SBAR();
    PV2(vb0); partialSM(pB0, pB1, m_reg, mnB, alB);
    __syncthreads(); RESC(alB);
    finishSM(pB0, pB1, alB, l_reg, pa0, pa1, pa2, pa3); SBAR();
    PV2(vb0 + SHM_T);
    l_reg += __builtin_amdgcn_exp2f(sink[g * 4 + hd] * 1.4426950408889634f - m_reg);
    if (hi == 0) li_l[r32] = l_reg; asm volatile("s_waitcnt lgkmcnt(0)" ::: "memory");
#pragma unroll
    for (int r = 0; r < 16; ++r) { const float rl = __builtin_amdgcn_rcpf(li_l[crow(r, hi)]);
        bf16* orow = O + (rb + blk * 64 + hf * 32 + crow(r, hi)) * DM + (g * 4 + hd) * 64 + r32;
        orow[0] = (bf16)(pk2(o[0][r] * rl, 0.f) & 0xffffu); orow[32] = (bf16)(pk2(o[1][r] * rl, 0.f) & 0xffffu); }
    __syncthreads();
#undef TKP
#undef TROW
#undef SLOADA
#undef SLOADB
#undef SWRITE
#undef SWAIT
#undef RESC
#undef MASKT
#undef QKT
#undef PV2
}
#undef KSWZ
#undef KSWZ64
#undef SBAR
}

namespace ret {
constexpr int LD = 6144, QS = 528, VS = 272, PS = 144, C = 64;
constexpr int L_Q = 0, L_K = 64 * QS, L_V = 2 * 64 * QS, L_P = L_V + 64 * VS, L_T = L_P + 64 * PS  , L_END = L_T + 80 * 4;
static_assert(L_END <= 131072, "retention LDS");
template <int O0, int O1, int O2, int O3> __device__ __forceinline__ void tr4(unsigned base, s16x4& a, s16x4& b, s16x4& c, s16x4& d) {
    asm volatile("ds_read_b64_tr_b16 %0, %4 offset:%5\n\tds_read_b64_tr_b16 %1, %4 offset:%6\n\tds_read_b64_tr_b16 %2, %4 offset:%7\n\tds_read_b64_tr_b16 %3, %4 offset:%8\n\ts_waitcnt lgkmcnt(0)"
                 : "=&v"(a), "=&v"(b), "=&v"(c), "=&v"(d) : "v"(base), "i"(O0), "i"(O1), "i"(O2), "i"(O3) : "memory");
}
template <int O0, int O1, int O2, int O3> __device__ __forceinline__ void tr4n(unsigned base, s16x4& a, s16x4& b, s16x4& c, s16x4& d) {
    asm volatile("ds_read_b64_tr_b16 %0, %4 offset:%5\n\tds_read_b64_tr_b16 %1, %4 offset:%6\n\tds_read_b64_tr_b16 %2, %4 offset:%7\n\tds_read_b64_tr_b16 %3, %4 offset:%8"
                 : "=&v"(a), "=&v"(b), "=&v"(c), "=&v"(d) : "v"(base), "i"(O0), "i"(O1), "i"(O2), "i"(O3) : "memory");
}
template <int O0, int O1, int O2, int O3> __device__ __forceinline__ void tr8(unsigned base0, unsigned base1, s16x4& a, s16x4& b, s16x4& c, s16x4& d, s16x4& e, s16x4& f, s16x4& g, s16x4& h) {
    asm volatile("ds_read_b64_tr_b16 %0, %8 offset:%10\n\tds_read_b64_tr_b16 %1, %8 offset:%11\n\tds_read_b64_tr_b16 %2, %8 offset:%12\n\tds_read_b64_tr_b16 %3, %8 offset:%13\n\t"
                 "ds_read_b64_tr_b16 %4, %9 offset:%10\n\tds_read_b64_tr_b16 %5, %9 offset:%11\n\tds_read_b64_tr_b16 %6, %9 offset:%12\n\tds_read_b64_tr_b16 %7, %9 offset:%13\n\ts_waitcnt lgkmcnt(0)"
                 : "=&v"(a), "=&v"(b), "=&v"(c), "=&v"(d), "=&v"(e), "=&v"(f), "=&v"(g), "=&v"(h) : "v"(base0), "v"(base1), "i"(O0), "i"(O1), "i"(O2), "i"(O3) : "memory");
}
__device__ __forceinline__ bf16x8 cat4(s16x4 l, s16x4 h) { return (bf16x8){l[0], l[1], l[2], l[3], h[0], h[1], h[2], h[3]}; }
__device__ __forceinline__ bf16x8 scale8(bf16x8 v, const float* sc) {
    v4u w = __builtin_bit_cast(v4u, v); v4u o;
    o.x = pk2(bflo(w.x) * sc[0], bfhi(w.x) * sc[1]); o.y = pk2(bflo(w.y) * sc[2], bfhi(w.y) * sc[3]);
    o.z = pk2(bflo(w.z) * sc[4], bfhi(w.z) * sc[5]); o.w = pk2(bflo(w.w) * sc[6], bfhi(w.w) * sc[7]);
    return __builtin_bit_cast(bf16x8, o);
}
constexpr int VS2 = 528, L2_Q = 0, L2_K = 64 * QS, L2_V = 2 * 64 * QS, L2_P = 3 * 64 * QS, L2_T = L2_P + 64 * PS, L2_END = L2_T + 80 * 4;
static_assert(L2_END <= 131072, "retention LDS (v2)");
__device__ __forceinline__ void ret_unit2(const bf16* __restrict__ QKVG, bf16* __restrict__ OB, bf16* __restrict__ OBL, bf16* __restrict__ OBC, const float* __restrict__ dlogit, int b, int h, int dir, int hv, char* lds, int wv) {
    const int tid0 = opaque_tid(wv), wid = __builtin_amdgcn_readfirstlane(tid0 >> 6);
    const size_t rb = (size_t)b * RPB;
    const unsigned ldsb = (unsigned)(uintptr_t)lds;
    const bf16* Qg = QKVG + rb * LD + h * 256; const bf16* Kg = Qg + 1024; const bf16* Vg = QKVG + rb * LD + 2048 + h * 512 + hv * 256;
    const int ocol = h * 512 + hv * 256 + wid * 32;
    bf16x8 sq[4], sk[4], sv[4];
#define R2LOADQK(row0) do { _Pragma("unroll") for (int i = 0; i < 4; ++i) { const int p = tid + 512 * i; sq[i] = *(const bf16x8*)(Qg + (size_t)((row0) + (p >> 5)) * LD + (p & 31) * 8); sk[i] = *(const bf16x8*)(Kg + (size_t)((row0) + (p >> 5)) * LD + (p & 31) * 8); } } while (0)
#define R2LOADV(row0) do { _Pragma("unroll") for (int i = 0; i < 4; ++i) { const int p = tid + 512 * i; sv[i] = *(const bf16x8*)(Vg + (size_t)((row0) + (p >> 5)) * LD + (p & 31) * 8); } } while (0)
#define R2WRITEQK() do { _Pragma("unroll") for (int i = 0; i < 4; ++i) { const int p = tid + 512 * i; *(bf16x8*)(lds + L2_Q + (p >> 5) * QS + (p & 31) * 16) = sq[i]; *(bf16x8*)(lds + L2_K + (p >> 5) * QS + (p & 31) * 16) = sk[i]; } } while (0)
#define R2WRITEV() do { _Pragma("unroll") for (int i = 0; i < 4; ++i) { const int p = tid + 512 * i; *(bf16x8*)(lds + L2_V + (p >> 5) * VS2 + (p & 31) * 16) = sv[i]; } } while (0)
    const float x = dlogit[dir * 4 + h];
    const float lg2d = -log1pf(expf(-x)) * 1.4426950408889634f;
    f32x4 S[16][2];
#pragma unroll
    for (int mb = 0; mb < 16; ++mb) { S[mb][0] = (f32x4){0.f, 0.f, 0.f, 0.f}; S[mb][1] = (f32x4){0.f, 0.f, 0.f, 0.f}; }
    const float gC = __builtin_amdgcn_exp2f(lg2d * (float)C);
    __syncthreads(); if (tid0 < 65) ((float*)(lds + L2_T))[tid0] = __builtin_amdgcn_exp2f(lg2d * (float)tid0); __syncthreads();
    const float* DT = (const float*)(lds + L2_T);
#define CROW(step) ((dir == 0) ? 64 * (step) : (((step) < 4) ? 64 * (3 - (step)) : CTXL + 64 * (67 - (step))))
    { int tid = tid0; asm volatile("" : "+v"(tid)); R2LOADQK(CROW(0)); }
    for (int step = 0; step < 68; ++step) {
        const int row0 = CROW(step);
        int tid = tid0; asm volatile("" : "+v"(tid));
        R2WRITEQK(); R2LOADV(row0); __syncthreads();
        if (step + 1 < 68) { const int rown = CROW(step + 1); R2LOADQK(rown); }
        asm volatile("" : "+v"(tid)); const int lane = tid & 63, l15 = lane & 15, g = lane >> 4;
        { const int qb = wid >> 1, tb0 = 2 * (wid & 1); f32x4 sc2[2] = {(f32x4){0.f, 0.f, 0.f, 0.f}, (f32x4){0.f, 0.f, 0.f, 0.f}};
#pragma unroll
          for (int s = 0; s < 8; ++s) { const bf16x8 af = *(const bf16x8*)(lds + L2_Q + (16 * qb + l15) * QS + (32 * s + 8 * g) * 2);
              const bf16x8 bf0 = *(const bf16x8*)(lds + L2_K + (16 * tb0 + l15) * QS + (32 * s + 8 * g) * 2), bf1 = *(const bf16x8*)(lds + L2_K + (16 * tb0 + 16 + l15) * QS + (32 * s + 8 * g) * 2);
              sc2[0] = __builtin_amdgcn_mfma_f32_16x16x32_bf16(af, bf0, sc2[0], 0, 0, 0); sc2[1] = __builtin_amdgcn_mfma_f32_16x16x32_bf16(af, bf1, sc2[1], 0, 0, 0); }
#pragma unroll
          for (int tt = 0; tt < 2; ++tt) { const int tb = tb0 + tt; const f32x4 sc = sc2[tt];
#pragma unroll
              for (int r = 0; r < 4; ++r) { const int i = 16 * qb + 4 * g + r, j = 16 * tb + l15; const int d = (dir == 0) ? (i - j) : (j - i);
                  const bool keep = (dir == 0) ? (d >= 0) : (d > 0);
                  const float pv = keep ? sc[r] * DT[d & 63] : 0.f;
                  *(bf16*)(lds + L2_P + i * PS + j * 2) = (bf16)(pk2(pv, 0.f) & 0xffffu); } } }
        f32x4 oi[4][2];
#pragma unroll
          for (int qb = 0; qb < 4; ++qb) { oi[qb][0] = (f32x4){0.f, 0.f, 0.f, 0.f}; oi[qb][1] = (f32x4){0.f, 0.f, 0.f, 0.f}; }
#pragma unroll
          for (int s = 0; s < 8; ++s) { v4u bw[2];
#pragma unroll
              for (int nb = 0; nb < 2; ++nb) { bw[nb].x = pk2(S[2 * s][nb][0], S[2 * s][nb][1]); bw[nb].y = pk2(S[2 * s][nb][2], S[2 * s][nb][3]); bw[nb].z = pk2(S[2 * s + 1][nb][0], S[2 * s + 1][nb][1]); bw[nb].w = pk2(S[2 * s + 1][nb][2], S[2 * s + 1][nb][3]); }
#pragma unroll
              for (int qb = 0; qb < 4; ++qb) { const char* qp = lds + L2_Q + (16 * qb + l15) * QS + (32 * s + 4 * g) * 2;
                  const v2u a0 = *(const v2u*)qp, a1 = *(const v2u*)(qp + 32);
                  v4u aw = {a0.x, a0.y, a1.x, a1.y};
                  oi[qb][0] = __builtin_amdgcn_mfma_f32_16x16x32_bf16(__builtin_bit_cast(bf16x8, aw), __builtin_bit_cast(bf16x8, bw[0]), oi[qb][0], 0, 0, 0);
                  oi[qb][1] = __builtin_amdgcn_mfma_f32_16x16x32_bf16(__builtin_bit_cast(bf16x8, aw), __builtin_bit_cast(bf16x8, bw[1]), oi[qb][1], 0, 0, 0); } }
        R2WRITEV();
        __syncthreads();
        int tid2 = tid0; asm volatile("" : "+v"(tid2)); const int lane2 = tid2 & 63, trq = (lane2 & 15) >> 2, trp = lane2 & 3, g2 = lane2 >> 4;
        const unsigned vtr = ldsb + L2_V + (8 * g2 + trq) * VS2 + (wid * 32 + 4 * trp) * 2;
        const unsigned ktr = ldsb + L2_K + (8 * g2 + trq) * QS + (4 * trp) * 2;
        bf16x8 vf[2][2];
#pragma unroll
        for (int nb = 0; nb < 2; ++nb) { s16x4 v00, v01, v10, v11; tr4<0, 4 * VS2, 32 * VS2, 36 * VS2>(vtr + nb * 32, v00, v01, v10, v11); vf[0][nb] = cat4(v00, v01); vf[1][nb] = cat4(v10, v11); }
        {
          bf16* Obase = (dir == 0) ? OB + (rb + row0) * 2048 : ((row0 < CTXL) ? OBC + ((size_t)b * CTXL + row0) * 2048 : OBL + ((size_t)b * SEQL + (row0 - CTXL)) * 2048);
#pragma unroll
          for (int qb = 0; qb < 4; ++qb) {
            const bf16x8 p0 = *(const bf16x8*)(lds + L2_P + (16 * qb + l15) * PS + (8 * g) * 2), p1 = *(const bf16x8*)(lds + L2_P + (16 * qb + l15) * PS + (32 + 8 * g) * 2);
#pragma unroll
            for (int nb = 0; nb < 2; ++nb) { f32x4 oo;
#pragma unroll
                for (int r = 0; r < 4; ++r) { const int i = 16 * qb + 4 * g + r; oo[r] = oi[qb][nb][r] * DT[dir == 0 ? (i + 1) : (C - i)]; }
                oo = __builtin_amdgcn_mfma_f32_16x16x32_bf16(p0, vf[0][nb], oo, 0, 0, 0);
                oo = __builtin_amdgcn_mfma_f32_16x16x32_bf16(p1, vf[1][nb], oo, 0, 0, 0);
#pragma unroll
                for (int r = 0; r < 4; ++r) *(Obase + (size_t)(16 * qb + 4 * g + r) * 2048 + ocol + nb * 16 + l15) = (bf16)(pk2(oo[r], 0.f) & 0xffffu); } } }
        { float vsc0[8], vsc1[8];
#pragma unroll
          for (int j = 0; j < 8; ++j) { const int t = 8 * g2 + j; vsc0[j] = DT[dir == 0 ? (C - 1 - t) : t]; vsc1[j] = DT[dir == 0 ? (C - 33 - t) : (t + 32)]; }
          bf16x8 vs[2][2];
#pragma unroll
          for (int nb = 0; nb < 2; ++nb) { vs[0][nb] = scale8(vf[0][nb], vsc0); vs[1][nb] = scale8(vf[1][nb], vsc1); }
#pragma unroll
          for (int mg = 0; mg < 8; ++mg) { s16x4 kk[2][4];
              tr8<0, 4 * QS, 32 * QS, 36 * QS>(ktr + (mg * 2) * 32, ktr + (mg * 2 + 1) * 32, kk[0][0], kk[0][1], kk[0][2], kk[0][3], kk[1][0], kk[1][1], kk[1][2], kk[1][3]);
#pragma unroll
              for (int q = 0; q < 2; ++q) { const int mb = mg * 2 + q; const bf16x8 k0f = cat4(kk[q][0], kk[q][1]), k1f = cat4(kk[q][2], kk[q][3]);
#pragma unroll
                  for (int nb = 0; nb < 2; ++nb) { f32x4 sn = S[mb][nb] * gC;
                      sn = __builtin_amdgcn_mfma_f32_16x16x32_bf16(k0f, vs[0][nb], sn, 0, 0, 0);
                      sn = __builtin_amdgcn_mfma_f32_16x16x32_bf16(k1f, vs[1][nb], sn, 0, 0, 0);
                      S[mb][nb] = sn; } } } }
        __syncthreads();
    }
#undef CROW
#undef R2LOADQK
#undef R2LOADV
#undef R2WRITEQK
#undef R2WRITEV
}
__device__ __forceinline__ void ret_finish2(const bf16* __restrict__ QKVG, bf16* __restrict__ OB, const bf16* __restrict__ OBL, const bf16* __restrict__ OBC, unsigned char* __restrict__ O8, int G, int wv) {
    const int tid = opaque_tid(wv), lane = tid & 63, gw = (int)blockIdx.x * NWAVES + __builtin_amdgcn_readfirstlane(tid >> 6), NGW = G * NWAVES;
    for (int it0 = gw; it0 < TA * 4; it0 += 2 * NGW) {
        v4u ow[2], gwv[2], bw[2]; bf16* opv[2]; bool ok[2];
#pragma unroll
        for (int u = 0; u < 2; ++u) { const int it = it0 + u * NGW; ok[u] = it < TA * 4; const int itq = ok[u] ? it : it0; const int r = itq >> 2, h = itq & 3; const int b = r / RPB, p = r - b * RPB;
            opv[u] = OB + (size_t)r * 2048 + h * 512 + lane * 8; const bf16* gp = QKVG + (size_t)r * LD + 4096 + h * 512 + lane * 8;
            const bf16* bp = ((p < CTXL) ? OBC + ((size_t)b * CTXL + p) * 2048 : OBL + ((size_t)b * SEQL + (p - CTXL)) * 2048) + h * 512 + lane * 8;
            ow[u] = *(const v4u*)opv[u]; gwv[u] = *(const v4u*)gp; bw[u] = *(const v4u*)bp; }
#pragma unroll
        for (int u = 0; u < 2; ++u) if (ok[u]) {
            float o[8] = {bflo(ow[u].x) + bflo(bw[u].x), bfhi(ow[u].x) + bfhi(bw[u].x), bflo(ow[u].y) + bflo(bw[u].y), bfhi(ow[u].y) + bfhi(bw[u].y), bflo(ow[u].z) + bflo(bw[u].z), bfhi(ow[u].z) + bfhi(bw[u].z), bflo(ow[u].w) + bflo(bw[u].w), bfhi(ow[u].w) + bfhi(bw[u].w)};
            float gg[8] = {bflo(gwv[u].x), bfhi(gwv[u].x), bflo(gwv[u].y), bfhi(gwv[u].y), bflo(gwv[u].z), bfhi(gwv[u].z), bflo(gwv[u].w), bfhi(gwv[u].w)};
            float ss = 0.f;
#pragma unroll
            for (int j = 0; j < 8; ++j) ss += o[j] * o[j];
            const float rstd = __builtin_amdgcn_rsqf(wave_sum(ss) * (1.f / 512.f) + NORM_EPS);
#pragma unroll
            for (int j = 0; j < 8; ++j) o[j] = o[j] * rstd * (gg[j] * __builtin_amdgcn_rcpf(1.f + __builtin_amdgcn_exp2f(-LOG2E_F * gg[j])));
            v4u w; w.x = pk2(o[0], o[1]); w.y = pk2(o[2], o[3]); w.z = pk2(o[4], o[5]); w.w = pk2(o[6], o[7]);
            if (O8) { const int it = it0 + u * NGW; const int r = it >> 2, h = it & 3; v2u w8; w8.x = pg8::pack4_fp8(o[0] * A8_SCALE, o[1] * A8_SCALE, o[2] * A8_SCALE, o[3] * A8_SCALE); w8.y = pg8::pack4_fp8(o[4] * A8_SCALE, o[5] * A8_SCALE, o[6] * A8_SCALE, o[7] * A8_SCALE);
                *(v2u*)(O8 + (size_t)r * 2048 + h * 512 + lane * 8) = w8; }
            else *(v4u*)opv[u] = w; } }
}
}

__device__ __forceinline__ void moe_gather(unsigned char* ws, const float* outp, int ml, int G, int wv) {
    const int tid = opaque_tid(wv), lane = tid & 63, gw = (int)blockIdx.x * NWAVES + __builtin_amdgcn_readfirstlane(tid >> 6), NGW = G * NWAVES;
    gu32* ctl = (gu32*)(ws + WS_CTL);
    int cum[9], ts[9]; cum[0] = 0; ts[0] = 0;
#pragma unroll
    for (int e = 0; e < 8; ++e) { const unsigned c = (unsigned)__builtin_amdgcn_readfirstlane((int)__hip_atomic_load(ctl + CW_MOECNT + 16 * ml + e, RLX_AGENT)); cum[e + 1] = cum[e] + (int)c; ts[e + 1] = ts[e] + (int)((c + 255u) >> 8); }
    const int* lists = (const int*)(ws + WS_LISTS); unsigned char* BUF = ws + BIG_BUF;
    for (int i = gw; i < cum[8]; i += 4 * NGW) {
        int tok[4]; size_t slot[4]; bool ok[4];
#pragma unroll
        for (int u = 0; u < 4; ++u) { const int iu = i + u * NGW; ok[u] = iu < cum[8];
            int e = 0;
#pragma unroll
            for (int k = 1; k < 8; ++k) e += (iu >= cum[k]) ? 1 : 0;
            int ce = 0, te = 0;
#pragma unroll
            for (int k = 0; k < 8; ++k) { ce = (k == e) ? cum[k] : ce; te = (k == e) ? ts[k] : te; }
            const int rank = iu - ce; tok[u] = ok[u] ? lists[(size_t)e * TA + rank] : 0; slot[u] = (size_t)te * 256 + rank; }
        v4u o[4];
#pragma unroll
        for (int u = 0; u < 4; ++u) o[u] = *((const v4u*)((const unsigned char*)outp + A8_OFF + (size_t)tok[u] * DM) + lane);
#pragma unroll
        for (int u = 0; u < 4; ++u) if (ok[u]) *((v4u*)(BUF + slot[u] * DM) + lane) = o[u];
    }
}

__global__ void __launch_bounds__(NWAVES * 64, 2) hybrid_fwd(Args args) {
    extern __shared__ __attribute__((aligned(16))) unsigned char lds[];
    LAS unsigned char* ldsl = (LAS unsigned char*)lds;
    volatile LAS unsigned* MISC = (volatile LAS unsigned*)(ldsl + MISC_OFF);
    const int tid = threadIdx.x;
    const int WV = __builtin_amdgcn_readfirstlane(tid >> 6);
    const int G = gridDim.x;
    unsigned char* ws = args.ws;
    gu32* ctl = (gu32*)(ws + WS_CTL);
    for (int u = tid; u < (LDS_BYTES - LDSCTL_OFF) / 4; u += NWAVES * 64) ((LAS unsigned*)(ldsl + LDSCTL_OFF))[u] = 0u;
    __syncthreads();
#if MK_MULTI
    XcdBarrier bar; bar.bar = (unsigned*)(ctl + CW_BAR); bar.x = 0; bar.st = nullptr; bar.wv = (unsigned)WV;
#define GRID_BAR() do { } while (0)
#else
    XcdBarrier bar = xcd_barrier_post((unsigned*)(ctl + CW_BAR), MISC + 8, (unsigned)WV);
#define GRID_BAR() xcd_barrier(bar)
#endif
#ifdef PH_ONLY
    const int lo = PH_ONLY, hi = PH_ONLY + 1; int ph = 0;
#else
    const int lo = args.ph_lo, hi = args.ph_hi; int ph = 0;
#endif
#ifndef REPEAT_PH
#define REPEAT_PH -1
#endif
    enum { PH_BASE = __COUNTER__ + 1 };
#define PHASE_BEGIN if (lo <= ph && ph < hi) { constexpr int pid_ = __COUNTER__ - PH_BASE; constexpr int nrep_ = (pid_ == REPEAT_PH) ? 2 : 1; asm volatile("; PHASE_MARK %0" :: "i"(pid_)); \
    _Pragma("unroll") for (int rep_ = 0; rep_ < nrep_; ++rep_) { if (rep_) GRID_BAR();
#define PHASE_END   } if (ph + 1 < hi) GRID_BAR(); } ++ph;

#define AY ((bf16*)args.out)
#define r2c ((const float*)(ws + WS_ROPE2))
#define r2s ((const float*)(ws + WS_ROPE2) + 64 * 16)
#define r1c ((const float*)(ws + WS_ROPE1))
#define r1s ((const float*)(ws + WS_ROPE1) + 4096 * 128)

    PHASE_BEGIN p0_prologue(args, ldsl, G, WV); PHASE_END
    PHASE_BEGIN resid_phase<0, false, false>(ws, args.out, args.in[0], args.in[2], ldsl, AY, 0, 0, 0, 0, 0, G, WV); PHASE_END

#define GEMM_PHASE8(F8, EPI, ORDER, AP, BP, NN, KK, SINIT, ...) { int kk_ = (KK); asm volatile("" : "+s"(kk_)); pg8::Gemm g{(const bf16*)(AP), (const bf16*)(BP), TA, NN, kk_}; ORDER S; SINIT; EPI E{__VA_ARGS__}; EPI_SETMODE \
        pg8::gemm_phase<EPI, ORDER, true, true, F8>(ldsl + RING_OFF, g, S, E, WV); }
#define GEMM_PHASE(...) GEMM_PHASE8(0, __VA_ARGS__)
#ifdef EPI_MODE
#define EPI_SETMODE E.mode = rep_ ? EPI_MODE : 0;
#else
#define EPI_SETMODE
#endif
#define SO_INIT(NN) S.init(TA, NN, G, (int)blockIdx.x)
#define ROPE2_LDS { LAS float* rl_ = (LAS float*)(ldsl + ROPE2_LDS_OFF); const float* rg_ = (const float*)(ws + WS_ROPE2); for (int i_ = opaque_tid(WV); i_ < 2048; i_ += NWAVES * 64) rl_[i_] = rg_[i_]; __syncthreads(); }
#define r2cl ((const LAS float*)(ldsl + ROPE2_LDS_OFF))
#define r2sl ((const LAS float*)(ldsl + ROPE2_LDS_OFF) + 64 * 16)
#define DA_INPROJ(j) PHASE_BEGIN ROPE2_LDS GEMM_PHASE(pg8::EpiRope2D, pg8::StaticOrder, AY, ws + W_DAIN + (size_t)(j) * 6 * MiB, 3072, 1024, SO_INIT(3072), (bf16*)(ws + BIG_QKV), 3072, 8, r2cl, r2sl) PHASE_END
#define DA_INPROJ8(j) PHASE_BEGIN ROPE2_LDS GEMM_PHASE8(FP8_GU, pg8::EpiRope2D, pg8::StaticOrder, (unsigned char*)args.out + A8_OFF, ws + W_DAIN + (size_t)(j) * 6 * MiB, 3072, 512, SO_INIT(3072), (bf16*)(ws + BIG_QKV), 3072, 8, r2cl, r2sl) PHASE_END
#define DA_LAYER(j, lam_init) \
    PHASE_BEGIN { const float lam = ((const float*)(ws + WS_SCAL))[j]; \
        for (int L = blockIdx.x; L < ((j) == 1 ? 2048 : 2176); L += G) { int bh, q0r, nk;     if (L < 2048) { const int c_ = L & 255; bh = 16 * (L >> 8) + (c_ & 7) + 8 * (c_ >> 7); q0r = CTXL + 256 * ((c_ >> 3) & 15); nk = RPB; } else { bh = L - 2048; q0r = 0; nk = CTXL; } \
            att::da_unit64((const bf16*)(ws + BIG_QKV), (bf16*)(ws + BIG_O), bh >> 3, bh & 7, q0r, nk, lam, 1.f - (lam_init), (const float*)(ws + WS_SMALL) + SM_SUBLN + (j) * 128, (char*)lds + RING_OFF, WV); } } PHASE_END \
    PHASE_BEGIN if ((j) == 1) GEMM_PHASE(pg8::EpiPlain, pg8::StaticOrderLat, ws + BIG_O, ws + W_DAOUT + (size_t)(j) * 2 * MiB, 1024, 1024, S.init(NBATCH * SEQL, 1024, G, (int)blockIdx.x), AY, 1024, 4, 0) \
                else GEMM_PHASE(pg8::EpiPlain, pg8::StaticOrder, ws + BIG_O, ws + W_DAOUT + (size_t)(j) * 2 * MiB, 1024, 1024, SO_INIT(1024), AY, 1024, 4, 0) PHASE_END
#define DENSE_FFN8(i) \
    PHASE_BEGIN GEMM_PHASE8(FP8_GU, pg8::EpiSwiGLU8, pg8::StaticOrder, (unsigned char*)args.out + A8_OFF, ws + W_FFNGU + (size_t)(i) * 11 * MiB, 5632, 512, SO_INIT(5632), ws + BIG_H, FFN, 22, 0, H8_SCALE) PHASE_END \
    PHASE_BEGIN GEMM_PHASE8(FP8_DN, pg8::EpiPlain, pg8::StaticOrder, ws + BIG_H, ws + W_FFNDN + (size_t)(i) * 11 * MiB / 2, 1024, FFN / 2, SO_INIT(1024), AY, 1024, 4, 0) PHASE_END
#define DENSE_FFN_H8(i) \
    PHASE_BEGIN GEMM_PHASE(pg8::EpiSwiGLU8, pg8::StaticOrder, AY, ws + W_FFNGU + (size_t)(i) * 11 * MiB, 5632, 1024, SO_INIT(5632), ws + BIG_H, FFN, 22, 0, H8_SCALE) PHASE_END \
    PHASE_BEGIN GEMM_PHASE8(FP8_DN, pg8::EpiPlain, pg8::StaticOrder, ws + BIG_H, ws + W_FFNDN + (size_t)(i) * 11 * MiB / 2, 1024, FFN / 2, SO_INIT(1024), AY, 1024, 4, 0) PHASE_END
#define DENSE_FFN(i) \
    PHASE_BEGIN GEMM_PHASE(pg8::EpiSwiGLU, pg8::StaticOrder, AY, ws + W_FFNGU + (size_t)(i) * 11 * MiB, 5632, 1024, SO_INIT(5632), (bf16*)(ws + BIG_H), FFN, 22, 0) PHASE_END \
    PHASE_BEGIN GEMM_PHASE(pg8::EpiPlain, pg8::StaticOrder, ws + BIG_H, ws + W_FFNDN + (size_t)(i) * 11 * MiB / 2, 1024, FFN, SO_INIT(1024), AY, 1024, 4, 0) PHASE_END
#define MOE_INIT(NCOL, T0, T1) { LAS int* tsl_ = (LAS int*)(ldsl + MISC_OFF + 64); int tsum_ = 0; \
        if (opaque_tid(WV) == 0) { tsl_[0] = 0; for (int e = 0; e < 8; ++e) { const unsigned c_ = __hip_atomic_load(ctl + CW_MOECNT + 16 * ml_ + e, RLX_AGENT); tsum_ += (int)((c_ + 255u) >> 8); tsl_[e + 1] = tsum_; } } \
        __syncthreads(); \
        S.ncol = NCOL; S.G = G; S.c = (int)blockIdx.x; S.tsl = tsl_; S.t0 = (T0); { const int t8_ = __builtin_amdgcn_readfirstlane(tsl_[8]); S.t1 = t8_ < (T1) ? t8_ : (T1); } }
#define MOE_FFN(ml) \
    PHASE_BEGIN moe_gather(ws, args.out, ml, G, WV); PHASE_END \
    { const int ml_ = (ml); \
        PHASE_BEGIN GEMM_PHASE8(FP8_GU, pg8::EpiSwiGLU8, pg8::MoeOrder, ws + BIG_BUF, ws + W_MOEGU + (size_t)(ml) * 56 * MiB, 7168, 512, MOE_INIT(28, 0, MOE_TILES_MAX), ws + BIG_MH, EDIM, 28, 0, H8_SCALE) PHASE_END \
        PHASE_BEGIN GEMM_PHASE8(FP8_DN, pg8::EpiPlain, pg8::MoeOrder, ws + BIG_MH, ws + W_MOEDN + (size_t)(ml) * 28 * MiB, 1024, EDIM / 2, MOE_INIT(4, 0, MOE_TILES_MAX), (bf16*)(ws + BIG_YE), 1024, 4, 0) PHASE_END }

    DA_INPROJ(0)
    DA_LAYER(0, 0.2f)
    PHASE_BEGIN resid_phase<1, false, false, (DENSE_FP8 & 1) != 0>(ws, args.out, nullptr, nullptr, ldsl, AY, 0, 0, 0, 1, 0, G, WV); PHASE_END
#if DENSE_FP8 & 1
    DENSE_FFN8(0)
#elif DENSE_H8 & 1
    DENSE_FFN_H8(0)
#else
    DENSE_FFN(0)
#endif
    PHASE_BEGIN resid_phase<1, false, false>(ws, args.out, nullptr, nullptr, ldsl, AY, 0, 1, 1, 0, 0, G, WV); PHASE_END

    PHASE_BEGIN ROPE2_LDS GEMM_PHASE(pg8::EpiRope2D, pg8::StaticOrder, AY, ws + W_WAIN, 1536, 1024, SO_INIT(1536), (bf16*)(ws + BIG_QKV), 1536, 5, r2cl, r2sl) PHASE_END
    PHASE_BEGIN { for (int L = blockIdx.x; L < 16 * 4 * 68; L += G) { const int bg = L / 68, blk = L - bg * 68;
            att::wa_unit((const bf16*)(ws + BIG_QKV), (bf16*)(ws + BIG_O), bg >> 2, bg & 3, blk, (const float*)(ws + WS_SMALL) + SM_SINK, (char*)lds + RING_OFF, WV); } } PHASE_END
    PHASE_BEGIN GEMM_PHASE(pg8::EpiPlain, pg8::StaticOrder, ws + BIG_O, ws + W_WAOUT, 1024, 1024, SO_INIT(1024), AY, 1024, 4, 0) PHASE_END
    PHASE_BEGIN resid_phase<1, true, false, true>(ws, args.out, nullptr, nullptr, ldsl, AY, 1, 0, 1, 1, 0, G, WV); PHASE_END
    MOE_FFN(0)
    PHASE_BEGIN resid_phase<2, false, false, (PROJ_FP8 & 1) != 0>(ws, args.out, nullptr, nullptr, ldsl, AY, 1, 1, 2, 0, 0, G, WV); PHASE_END

#if PROJ_FP8 & 1
    PHASE_BEGIN GEMM_PHASE8(FP8_GU, pg8::EpiRope1D, pg8::StaticOrder, (unsigned char*)args.out + A8_OFF, ws + W_RETIN, 6144, 512, SO_INIT(6144), (bf16*)(ws + BIG_RQ), 6144, 8, r1c, r1s) PHASE_END
#else
    PHASE_BEGIN GEMM_PHASE(pg8::EpiRope1D, pg8::StaticOrder, AY, ws + W_RETIN, 6144, 1024, SO_INIT(6144), (bf16*)(ws + BIG_RQ), 6144, 8, r1c, r1s) PHASE_END
#endif
    PHASE_BEGIN { for (int L = blockIdx.x; L < 256; L += G) ret::ret_unit2((const bf16*)(ws + BIG_RQ), (bf16*)(ws + BIG_RO), (bf16*)args.out, (bf16*)(ws + WS_OBC), (const float*)(ws + WS_SMALL) + SM_DECAY, L >> 4, (L >> 2) & 3, (L >> 1) & 1, L & 1, (char*)lds + RING_OFF, WV); } PHASE_END
    PHASE_BEGIN ret::ret_finish2((const bf16*)(ws + BIG_RQ), (bf16*)(ws + BIG_RO), (const bf16*)args.out, (const bf16*)(ws + WS_OBC), RETOUT_FP8 ? ws + WS_RO8 : nullptr, G, WV); PHASE_END
#if RETOUT_FP8
    PHASE_BEGIN GEMM_PHASE8(FP8_AO, pg8::EpiPlain, pg8::StaticOrder, ws + WS_RO8, ws + W_RETOUT, 1024, 1024, SO_INIT(1024), AY, 1024, 4, 0) PHASE_END
#else
    PHASE_BEGIN GEMM_PHASE(pg8::EpiPlain, pg8::StaticOrder, ws + BIG_RO, ws + W_RETOUT, 1024, 2048, SO_INIT(1024), AY, 1024, 4, 0) PHASE_END
#endif
    PHASE_BEGIN resid_phase<1, false, false, (DENSE_FP8 & 2) != 0>(ws, args.out, nullptr, nullptr, ldsl, AY, 2, 0, 2, 1, 0, G, WV); PHASE_END
#if DENSE_FP8 & 2
    DENSE_FFN8(1)
#else
    DENSE_FFN(1)
#endif
    PHASE_BEGIN resid_phase<1, false, false, (PROJ_FP8 & 4) != 0>(ws, args.out, nullptr, nullptr, ldsl, AY, 2, 1, 3, 0, 0, G, WV); PHASE_END

#if PROJ_FP8 & 4
    DA_INPROJ8(1)
#else
    DA_INPROJ(1)
#endif
    DA_LAYER(1, 0.55605820f)
    PHASE_BEGIN resid_phase<1, true, false, true, true>(ws, args.out, nullptr, nullptr, ldsl, AY, 3, 0, 3, 1, 1, G, WV); PHASE_END
    MOE_FFN(1)
    PHASE_BEGIN resid_phase<2, false, true>(ws, args.out, nullptr, nullptr, ldsl, AY, 3, 1, 3, 0, 1, G, WV); PHASE_END
#undef PHASE_BEGIN
#undef PHASE_END
}
constexpr int N_PHASES = 33;

extern "C" void kernel_launch(void* const* d_in, const int* in_sizes, int n_in, void* d_out, int out_size, void* d_ws, size_t ws_size, hipStream_t stream) {
    static int grid = 0;
    if (grid == 0) {
        if (n_in != 22 || in_sizes[0] != NBATCH * SEQL * DM || out_size != NBATCH * SEQL * DM || ws_size < WS_END) {
            fprintf(stderr, "kernel_launch: shape mismatch (n_in %d, in0 %d, out %d, ws %zu; need ws >= %zu); nothing launched\n", n_in, n_in > 0 ? in_sizes[0] : -1, out_size, ws_size, (size_t)WS_END); grid = -1; return; }
        int dev = 0, cus = 0, per_cu = 0;
        if (hipGetDevice(&dev) != hipSuccess || hipDeviceGetAttribute(&cus, hipDeviceAttributeMultiprocessorCount, dev) != hipSuccess) { fprintf(stderr, "kernel_launch: device query failed\n"); grid = -1; return; }
        if (hipFuncSetAttribute((const void*)hybrid_fwd, hipFuncAttributeMaxDynamicSharedMemorySize, LDS_BYTES) != hipSuccess) { fprintf(stderr, "kernel_launch: hipFuncSetAttribute failed\n"); grid = -1; return; }
        if (hipOccupancyMaxActiveBlocksPerMultiprocessor(&per_cu, (const void*)hybrid_fwd, NWAVES * 64, LDS_BYTES) != hipSuccess || per_cu < 1) {
            fprintf(stderr, "kernel_launch: occupancy query reports %d workgroups per CU\n", per_cu); }
        (void)hipGetLastError();
        if ((long)cus * NWAVES * 40 < (long)TA) { fprintf(stderr, "kernel_launch: %d CUs are too few for the routing phase's per-wave row table; nothing launched\n", cus); grid = -1; return; }
        grid = cus;
        if (grid != 256) fprintf(stderr, "kernel_launch: note: %d CUs (built and tuned for 256)\n", grid);
    }
    if (grid < 0) return;
    if (hipMemsetAsync((char*)d_ws + WS_CTL, 0, CTL_ZERO_BYTES, stream) != hipSuccess) { fprintf(stderr, "kernel_launch: memset failed\n"); return; }
    Args a{};
    for (int i = 0; i < 22; ++i) a.in[i] = (const float*)d_in[i];
    a.out = (float*)d_out; a.ws = (unsigned char*)d_ws;
#if MK_MULTI
    for (int p = 0; p < N_PHASES; ++p) { a.ph_lo = p; a.ph_hi = p + 1; hipLaunchKernelGGL(hybrid_fwd, dim3(grid), dim3(NWAVES * 64), LDS_BYTES, stream, a); }
#else
    a.ph_lo = 0; a.ph_hi = N_PHASES;
    hipLaunchKernelGGL(hybrid_fwd, dim3(grid), dim3(NWAVES * 64), LDS_BYTES, stream, a);
#endif
    const hipError_t le = hipPeekAtLastError();
    if (le != hipSuccess) fprintf(stderr, "kernel_launch: launch failed: %s\n", hipGetErrorName(le));
}
```

```cpp
#include <hip/hip_runtime.h>
#include <cstdio>
#include <cstdint>

#ifndef DBG
#define DBG 0
#endif
#ifndef PG8_RELAX
#define PG8_RELAX 1
#endif
#ifndef PG8_ASM_DMA
#define PG8_ASM_DMA 1
#endif
#ifndef MK_MULTI
#define MK_MULTI 0
#endif

__device__ __forceinline__ int opaque_tid(int wv) { int l; asm volatile("v_mbcnt_lo_u32_b32 %0, -1, 0\n\tv_mbcnt_hi_u32_b32 %0, -1, %0" : "=v"(l)); return (wv << 6) | l; }
namespace pg8 {
#define PG8_LAS __attribute__((address_space(3)))
typedef unsigned short bf16_t;
typedef short bf16x8 __attribute__((ext_vector_type(8)));
typedef float f32x4 __attribute__((ext_vector_type(4)));
typedef unsigned u32x4 __attribute__((ext_vector_type(4)));
constexpr int BM = 256, BK = 64, HALF = 128, HTB = HALF * BK * 2  , STAGE_BYTES = 8 * HTB, NXCD = 8, WGM = 4;

__host__ __device__ __forceinline__ int lds_byte(int r, int c) { const int st = (r >> 4) * 2 + (c >> 5), rr = r & 15, cc = c & 31, ob = rr * 64 + cc * 2; return st * 1024 + (ob ^ (((ob >> 9) & 1) << 5)); }
__host__ __device__ __forceinline__ void stage_rc(int b, int& R, int& C) { const int st = b / 1024, sb = b % 1024, swz = sb ^ (((sb >> 9) & 1) << 5); R = (st >> 1) * 16 + swz / 64; C = (st & 1) * 32 + (swz % 64) / 2; }
__host__ __device__ __forceinline__ int perm32(int rho) { const int n = rho >> 4, i = rho & 15; return 8 * (i >> 2) + 4 * n + (i & 3); }

struct Unit { int pm, pn; };
struct Gemm { const bf16_t* A; const bf16_t* Bt; int M, N, K; };

struct StaticOrder {
    int nM, nN, nwg, G, c;
    __host__ __device__ void init(int M, int N, int G_, int c_) { nM = M / BM; nN = N / BM; nwg = nM * nN; G = G_; c = c_; }
    __host__ __device__ bool next(int i, Unit& u) const {
        const long L = (long)i * G + c; if (L >= nwg) return false;
        int wgid = (int)L; { const int q = nwg / NXCD, r = nwg % NXCD, xcd = wgid % NXCD, off = wgid / NXCD; wgid = (xcd < r ? xcd * (q + 1) : r * (q + 1) + (xcd - r) * q) + off; }
        const int nig = WGM * nN, gid = wgid / nig, rem = wgid - gid * nig, fm = gid * WGM, gsz = (nM - fm) < WGM ? (nM - fm) : WGM;
        static_assert(WGM == 4, "the full-group case below shifts by log2(WGM)");
        if (gsz == WGM) { u.pm = fm + (rem & (WGM - 1)); u.pn = rem >> 2; } else { u.pm = fm + (rem % gsz); u.pn = rem / gsz; }
        return true;
    }
    __device__ __forceinline__ void a_ready(const Unit&) const {}
    __device__ __forceinline__ void done(const Unit&) const {}
};

struct StaticOrderLat : StaticOrder {
    __host__ __device__ bool next(int i, Unit& u) const { if (!StaticOrder::next(i, u)) return false; u.pm = (u.pm >> 4) * 17 + 1 + (u.pm & 15); return true; }
};

typedef int v8i __attribute__((ext_vector_type(8)));
typedef float f32x8 __attribute__((ext_vector_type(8)));
typedef int v4i_ __attribute__((ext_vector_type(4)));
__device__ __forceinline__ v8i cat8(bf16x8 lo, bf16x8 hi) { const v4i_ a = __builtin_bit_cast(v4i_, lo), b = __builtin_bit_cast(v4i_, hi); return __builtin_shufflevector(a, b, 0, 1, 2, 3, 4, 5, 6, 7); }
__device__ __forceinline__ bf16x8 lo8(v8i v) { return __builtin_bit_cast(bf16x8, __builtin_shufflevector(v, v, 0, 1, 2, 3)); }
__device__ __forceinline__ bf16x8 hi8(v8i v) { return __builtin_bit_cast(bf16x8, __builtin_shufflevector(v, v, 4, 5, 6, 7)); }
__device__ __forceinline__ unsigned cvt_pk_bf16(float lo, float hi) { unsigned r; asm volatile("v_cvt_pk_bf16_f32 %0, %1, %2" : "=v"(r) : "v"(lo), "v"(hi)); return r; }

#ifndef EPI_NT
#define EPI_NT 0
#endif
#if EPI_NT
#define EPI_ST(p, v) __builtin_nontemporal_store((v), (p))
#else
#define EPI_ST(p, v) (*(p) = (v))
#endif
__device__ __forceinline__ u32x4 pack8(const f32x4 a, const f32x4 b) { u32x4 w; w.x = cvt_pk_bf16(a[0], a[1]); w.y = cvt_pk_bf16(a[2], a[3]); w.z = cvt_pk_bf16(b[0], b[1]); w.w = cvt_pk_bf16(b[2], b[3]); return w; }

struct EpiPlain {
    static constexpr bool PERM = true, AFTER_DRAIN = false; static constexpr int NSTORE = 16;
    bf16_t* O; int ldc; int pn_mod; int pm_off; int mode;
    __device__ __forceinline__ void operator()(const f32x4 (&acc)[2][2][4][2], const Unit& u, int wr, int wc, int fr, int fq) const {
        if (mode == 1) return;
        const int row0 = (u.pm + pm_off) * BM + wr * 64 + fr, col0 = (u.pn % pn_mod) * BM + wc * 32 + 8 * fq;
#pragma unroll
        for (int ai = 0; ai < 2; ++ai)
#pragma unroll
            for (int m = 0; m < 4; ++m) { bf16_t* rowp = O + (size_t)(row0 + ai * HALF + m * 16) * ldc + col0;
#pragma unroll
                for (int bj = 0; bj < 2; ++bj) { const u32x4 w_ = pack8(acc[ai][bj][m][0], acc[ai][bj][m][1]); if (mode == 0 || w_.x == 0x7fc12345u) EPI_ST((u32x4*)(rowp + bj * HALF), w_); } }
    }
};
struct EpiRope2D {
    static constexpr bool PERM = true, AFTER_DRAIN = false; static constexpr int NSTORE = 16;
    bf16_t* O; int ldc; int rope_tiles; const PG8_LAS float* tabc; const PG8_LAS float* tabs; int mode;
    __device__ __forceinline__ void operator()(const f32x4 (&acc)[2][2][4][2], const Unit& u, int wr, int wc, int fr, int fq) const {
        const int row0 = u.pm * BM + wr * 64 + fr, col0 = u.pn * BM + wc * 32 + 8 * fq;
        const int pt = u.pm % 17; const bool rope = (u.pn < rope_tiles) && (pt != 0);
        const int pos0 = (pt - 1) * 256 + wr * 64 + fr;
#pragma unroll
        for (int ai = 0; ai < 2; ++ai)
#pragma unroll
            for (int m = 0; m < 4; ++m) { bf16_t* rowp = O + (size_t)(row0 + ai * HALF + m * 16) * ldc + col0;
                f32x4 cs = (f32x4){1.f, 1.f, 1.f, 1.f}, sn = (f32x4){0.f, 0.f, 0.f, 0.f};
                if (rope) { const int pos = pos0 + ai * HALF + m * 16; const int pidx = (wc & 1) ? (pos & 63) : (pos >> 6);
                    cs = *(const PG8_LAS f32x4*)(tabc + pidx * 16 + 4 * fq); sn = *(const PG8_LAS f32x4*)(tabs + pidx * 16 + 4 * fq); }
#pragma unroll
                for (int bj = 0; bj < 2; ++bj) { const f32x4 x0 = acc[ai][bj][m][0], x1 = acc[ai][bj][m][1];
                    const f32x4 y0 = x0 * cs - x1 * sn, y1 = x1 * cs + x0 * sn;
                    EPI_ST((u32x4*)(rowp + bj * HALF), pack8(y0, y1)); } }
    }
};
struct EpiRope1D {
    static constexpr bool PERM = true, AFTER_DRAIN = false; static constexpr int NSTORE = 16;
    bf16_t* O; int ldc; int rope_tiles; const float* tabc; const float* tabs; int mode;
    __device__ __forceinline__ void operator()(const f32x4 (&acc)[2][2][4][2], const Unit& u, int wr, int wc, int fr, int fq) const {
        const int row0 = u.pm * BM + wr * 64 + fr, col0 = u.pn * BM + wc * 32 + 8 * fq;
        const int pt = u.pm % 17; const bool rope = (u.pn < rope_tiles) && (pt != 0);
        const int pos0 = (pt - 1) * 256 + wr * 64 + fr;
#pragma unroll
        for (int ai = 0; ai < 2; ++ai)
#pragma unroll
            for (int m = 0; m < 4; ++m) { bf16_t* rowp = O + (size_t)(row0 + ai * HALF + m * 16) * ldc + col0;
                f32x4 y0[2], y1[2];
#pragma unroll
                for (int n = 0; n < 2; ++n) { const f32x4 x0 = acc[ai][0][m][n], x1 = acc[ai][1][m][n];
                    if (rope) { const int pos = pos0 + ai * HALF + m * 16; const int i0 = wc * 32 + 8 * fq + 4 * n;
                        const f32x4 cs = *(const f32x4*)(tabc + (size_t)pos * 128 + i0), sn = *(const f32x4*)(tabs + (size_t)pos * 128 + i0);
                        y0[n] = x0 * cs - x1 * sn; y1[n] = x1 * cs + x0 * sn; }
                    else { y0[n] = x0; y1[n] = x1; } }
                EPI_ST((u32x4*)(rowp), pack8(y0[0], y0[1])); EPI_ST((u32x4*)(rowp + HALF), pack8(y1[0], y1[1])); }
    }
};
__device__ __forceinline__ float silu_f(float t) { return t * __builtin_amdgcn_rcpf(1.f + __builtin_amdgcn_exp2f(-t)); }
struct EpiSwiGLU {
    static constexpr bool PERM = true, AFTER_DRAIN = false; static constexpr int NSTORE = 8;
    bf16_t* O; int ldc; int pn_mod; int pm_off; int mode;
    __device__ __forceinline__ void operator()(const f32x4 (&acc)[2][2][4][2], const Unit& u, int wr, int wc, int fr, int fq) const {
        if (mode == 1) return;
        const int row0 = (u.pm + pm_off) * BM + wr * 64 + fr, col0 = (u.pn % pn_mod) * HALF + wc * 32 + 8 * fq;
        if (mode == 3) { f32x4 s_ = (f32x4){0.f, 0.f, 0.f, 0.f};
#pragma unroll
            for (int ai = 0; ai < 2; ++ai)
#pragma unroll
                for (int bj = 0; bj < 2; ++bj)
#pragma unroll
                    for (int m = 0; m < 4; ++m) { s_ += acc[ai][bj][m][0]; s_ += acc[ai][bj][m][1]; }
            if (s_[0] + s_[1] + s_[2] + s_[3] == 1.2345e-30f) O[(size_t)row0 * ldc + col0] = 1; return; }
#pragma unroll
        for (int ai = 0; ai < 2; ++ai)
#pragma unroll
            for (int m = 0; m < 4; ++m) { bf16_t* rowp = O + (size_t)(row0 + ai * HALF + m * 16) * ldc + col0;
                f32x4 h[2];
#pragma unroll
                for (int n = 0; n < 2; ++n) { const f32x4 g = acc[ai][0][m][n], uu = acc[ai][1][m][n];
                    h[n] = (f32x4){silu_f(g[0]) * uu[0], silu_f(g[1]) * uu[1], silu_f(g[2]) * uu[2], silu_f(g[3]) * uu[3]}; }
                { const u32x4 w_ = pack8(h[0], h[1]); if (mode == 0 || w_.x == 0x7fc12345u) EPI_ST((u32x4*)(rowp), w_); } }
    }
};

__device__ __forceinline__ unsigned pack4_fp8(float a, float b, float c, float d) {
    a = __builtin_fminf(__builtin_fmaxf(a, -448.f), 448.f); b = __builtin_fminf(__builtin_fmaxf(b, -448.f), 448.f); c = __builtin_fminf(__builtin_fmaxf(c, -448.f), 448.f); d = __builtin_fminf(__builtin_fmaxf(d, -448.f), 448.f);
    int w = 0; w = __builtin_amdgcn_cvt_pk_fp8_f32(a, b, w, false); w = __builtin_amdgcn_cvt_pk_fp8_f32(c, d, w, true); return (unsigned)w; }
typedef unsigned u32x2 __attribute__((ext_vector_type(2)));
struct EpiSwiGLU8 {
    static constexpr bool PERM = true, AFTER_DRAIN = false; static constexpr int NSTORE = 8;
    unsigned char* O; int ldc; int pn_mod; int pm_off; float oscale; int mode;
    __device__ __forceinline__ void operator()(const f32x4 (&acc)[2][2][4][2], const Unit& u, int wr, int wc, int fr, int fq) const {
        const int row0 = (u.pm + pm_off) * BM + wr * 64 + fr, col0 = (u.pn % pn_mod) * HALF + wc * 32 + 8 * fq;
#pragma unroll
        for (int ai = 0; ai < 2; ++ai)
#pragma unroll
            for (int m = 0; m < 4; ++m) { unsigned char* rowp = O + (size_t)(row0 + ai * HALF + m * 16) * ldc + col0;
                u32x2 w;
#pragma unroll
                for (int n = 0; n < 2; ++n) { const f32x4 g = acc[ai][0][m][n], uu = acc[ai][1][m][n];
                    const unsigned p = pack4_fp8(silu_f(g[0]) * uu[0], silu_f(g[1]) * uu[1], silu_f(g[2]) * uu[2], silu_f(g[3]) * uu[3]);
                    if (n == 0) w.x = p; else w.y = p; }
                EPI_ST((u32x2*)(rowp), w); }
    }
};
struct MoeOrder {
    int t0, t1, ncol, G, c; const PG8_LAS int* tsl;
    __device__ __forceinline__ bool next(int i, Unit& u) const {
        const unsigned L = (unsigned)i * (unsigned)G + (unsigned)c; const int nt = t1 - t0; if (L >= (unsigned)nt * (unsigned)ncol) return false;
        const unsigned nig = 8u * (unsigned)ncol, gid = L / nig, rem = L - gid * nig; const int fm = (int)gid * 8, gsz = (nt - fm) < 8 ? (nt - fm) : 8;
        const int t = t0 + fm + (gsz == 8 ? (int)(rem & 7u) : (int)(rem % (unsigned)gsz)), j = (gsz == 8) ? (int)(rem >> 3) : (int)(rem / (unsigned)gsz);
        int e = 0;
#pragma unroll
        for (int k = 1; k < 8; ++k) e += (t >= tsl[k]) ? 1 : 0;
        u.pm = t; u.pn = e * ncol + j; return true;
    }
    __device__ __forceinline__ void a_ready(const Unit&) const {}
    __device__ __forceinline__ void done(const Unit&) const {}
};
template <class Epi, class Sched, bool ALIGN_EPI = false, bool SP2 = false, int FP8 = 0  >
__device__ __forceinline__ void gemm_phase(PG8_LAS unsigned char* lds, const Gemm g, const Sched& S, const Epi& E, const int wv) {
    const int tid = opaque_tid(wv), wid = __builtin_amdgcn_readfirstlane(tid >> 6), lane = tid & 63, wr = wid >> 2, wc = wid & 3, fr = lane & 15, fq = lane >> 4;
    const int K = g.K, nt = K / BK;
    constexpr bool RELAX_ST = ALIGN_EPI && SP2 && !Epi::AFTER_DRAIN && (PG8_RELAX != 0);
    unsigned voffA[2], voffB[2];
#pragma unroll
    for (int i = 0; i < 2; ++i) { int R, C; stage_rc(tid * 16 + i * 8192, R, C); const int Rb = Epi::PERM ? ((R & ~31) + perm32(R & 31)) : R;
        voffA[i] = (unsigned)(R * K + C) * 2u; voffB[i] = (unsigned)(Rb * K + C) * 2u; }
    const size_t kstep = (size_t)(BK * 2);
    const size_t hstep = (size_t)HALF * K * 2;
    const size_t tstep = 2 * hstep;
    const unsigned ldsw = (unsigned)wid * 1024u; const unsigned ldsbase = (unsigned)(size_t)lds;
    const int aoff = lds_byte(wr * 64 + fr, fq * 8), boff = lds_byte(wc * 32 + fr, fq * 8);
#define PG8_SA(b, h) (((b) * 2 + (h)) * HTB)
#define PG8_SB(b, h) ((4 + (b) * 2 + (h)) * HTB)
#define PG8_STAGE(bufoff, gbase, voff) do { _Pragma("unroll") for (int _i = 0; _i < 2; ++_i) { \
        if constexpr (FP8 == 0 && !PG8_ASM_DMA) __builtin_amdgcn_global_load_lds((const unsigned*)((const char*)(gbase) + (voff)[_i]), (PG8_LAS unsigned*)(lds + (bufoff) + ldsw + _i * 8192), 16, 0, 0); \
        else { unsigned keep_; asm volatile("s_mov_b32 %0, m0\n\ts_mov_b32 m0, %3\n\ts_nop 0\n\tglobal_load_lds_dwordx4 %1, %2\n\ts_mov_b32 m0, %0" : "=&s"(keep_) : "v"((voff)[_i]), "s"((const char*)(gbase)), "s"((unsigned)__builtin_amdgcn_readfirstlane((int)(ldsbase + (unsigned)(bufoff) + ldsw + _i * 8192))) : "memory"); } } } while (0)
#define PG8_LDA(dst, b, h) do { _Pragma("unroll") for (int m = 0; m < 4; ++m) { const bf16x8 f0_ = *(const PG8_LAS bf16x8*)(lds + PG8_SA(b, h) + aoff + m * 2048), f1_ = *(const PG8_LAS bf16x8*)(lds + PG8_SA(b, h) + aoff + m * 2048 + 1024); dst[m] = cat8(f0_, f1_); } } while (0)
#define PG8_LDB(dst, b, h) do { _Pragma("unroll") for (int n = 0; n < 2; ++n) { const bf16x8 f0_ = *(const PG8_LAS bf16x8*)(lds + PG8_SB(b, h) + boff + n * 2048), f1_ = *(const PG8_LAS bf16x8*)(lds + PG8_SB(b, h) + boff + n * 2048 + 1024); dst[n] = cat8(f0_, f1_); } } while (0)
#define PG8_MMA(ai, bj, At, Bt) do { __builtin_amdgcn_s_setprio(1); \
        if constexpr (FP8 == 0) { _Pragma("unroll") for (int m = 0; m < 4; ++m) _Pragma("unroll") for (int n = 0; n < 2; ++n) { \
            acc[ai][bj][m][n] = __builtin_amdgcn_mfma_f32_16x16x32_bf16(lo8(Bt[n]), lo8(At[m]), acc[ai][bj][m][n], 0, 0, 0); \
            acc[ai][bj][m][n] = __builtin_amdgcn_mfma_f32_16x16x32_bf16(hi8(Bt[n]), hi8(At[m]), acc[ai][bj][m][n], 0, 0, 0); } } \
        else { \
            _Pragma("unroll") for (int m = 0; m < 4; ++m) _Pragma("unroll") for (int n = 0; n < 2; ++n) \
            asm volatile("v_mfma_scale_f32_16x16x128_f8f6f4 %0, %1, %2, %0, %3, %4 op_sel_hi:[0,0,0]" : "+v"(acc[ai][bj][m][n]) : "v"(Bt[n]), "v"(At[m]), "v"(scb_), "v"(sca_)); } \
        __builtin_amdgcn_s_setprio(0); } while (0)
#define PG8_MMA0(ai, bj, At, Bt) do { __builtin_amdgcn_s_setprio(1); \
        if constexpr (FP8 == 0) { _Pragma("unroll") for (int m = 0; m < 4; ++m) _Pragma("unroll") for (int n = 0; n < 2; ++n) { \
            acc[ai][bj][m][n] = __builtin_amdgcn_mfma_f32_16x16x32_bf16(lo8(Bt[n]), lo8(At[m]), (f32x4){0.f, 0.f, 0.f, 0.f}, 0, 0, 0); \
            acc[ai][bj][m][n] = __builtin_amdgcn_mfma_f32_16x16x32_bf16(hi8(Bt[n]), hi8(At[m]), acc[ai][bj][m][n], 0, 0, 0); } } \
        else { \
            _Pragma("unroll") for (int m = 0; m < 4; ++m) _Pragma("unroll") for (int n = 0; n < 2; ++n) \
            asm volatile("v_mfma_scale_f32_16x16x128_f8f6f4 %0, %1, %2, 0, %3, %4 op_sel_hi:[0,0,0]" : "+v"(acc[ai][bj][m][n]) : "v"(Bt[n]), "v"(At[m]), "v"(scb_), "v"(sca_)); }   \
        __builtin_amdgcn_s_setprio(0); } while (0)
#define PG8_MMAX(first, ai, bj, At, Bt) do { if (first) PG8_MMA0(ai, bj, At, Bt); else PG8_MMA(ai, bj, At, Bt); } while (0)
#define PG8_WAIT_V(n) asm volatile("s_waitcnt vmcnt(" #n ")" ::: "memory")
#define PG8_WAIT_L(n) asm volatile("s_waitcnt lgkmcnt(" #n ")" ::: "memory")
#define PG8_WAIT_VX(rx) do { if (rx) asm volatile("s_waitcnt vmcnt(%0)" :: "n"(8 + Epi::NSTORE) : "memory"); else PG8_WAIT_V(8); } while (0)
#define PG8_BAR __builtin_amdgcn_s_barrier()
#define PG8_SCHED __builtin_amdgcn_sched_barrier(0)
    Unit cur, nxt; int ui = 0;
    PG8_LAS unsigned* utab = (PG8_LAS unsigned*)(lds + STAGE_BYTES + 1024);
    if (tid < 64) { Unit u_; utab[tid] = S.next(tid, u_) ? ((unsigned)u_.pm | ((unsigned)u_.pn << 16)) : 0xffffffffu; }
    __syncthreads();
#define PG8_NEXT(i, u, ok) do { const int i_ = (i); if (i_ < 64) { const unsigned v_ = (unsigned)__builtin_amdgcn_readfirstlane((int)utab[i_]); ok = (v_ != 0xffffffffu); u.pm = (int)(v_ & 0xffffu); u.pn = (int)(v_ >> 16); } else ok = S.next(i_, u); } while (0)
    { bool ok0_; PG8_NEXT(0, cur, ok0_); if (!ok0_) return; }
    f32x4 acc[2][2][4][2];
    const int sca_ = (FP8 & 0xff) * 0x01010101, scb_ = ((FP8 >> 8) & 0xff) * 0x01010101;
    {
#pragma unroll
    for (int a = 0; a < 2; ++a)
#pragma unroll
        for (int b = 0; b < 2; ++b)
#pragma unroll
            for (int m = 0; m < 4; ++m)
#pragma unroll
                for (int n = 0; n < 2; ++n) acc[a][b][m][n] = (f32x4){0.f, 0.f, 0.f, 0.f};
    }
    v8i At[4], B0[2], B1[2];
    const char* cA = (const char*)g.A + (size_t)cur.pm * tstep; const char* cB = (const char*)g.Bt + (size_t)cur.pn * tstep;
    S.a_ready(cur);
    if constexpr (SP2) {
        PG8_STAGE(PG8_SB(0, 0), cB, voffB); PG8_STAGE(PG8_SB(0, 1), cB + hstep, voffB); PG8_STAGE(PG8_SA(0, 0), cA, voffA); PG8_STAGE(PG8_SA(0, 1), cA + hstep, voffA);
        if (wr == 1) PG8_BAR;
        PG8_WAIT_V(2); PG8_BAR;
        PG8_STAGE(PG8_SB(1, 0), cB + kstep, voffB); PG8_STAGE(PG8_SA(1, 0), cA + kstep, voffA); PG8_STAGE(PG8_SB(1, 1), cB + hstep + kstep, voffB);
        PG8_WAIT_V(6); PG8_BAR;
    } else {
        PG8_STAGE(PG8_SB(0, 0), cB, voffB); PG8_STAGE(PG8_SA(0, 0), cA, voffA); PG8_STAGE(PG8_SB(0, 1), cB + hstep, voffB); PG8_STAGE(PG8_SA(0, 1), cA + hstep, voffA);
        if (wr == 1) PG8_BAR;
        PG8_WAIT_V(4); PG8_BAR;
        PG8_STAGE(PG8_SB(1, 0), cB + kstep, voffB); PG8_STAGE(PG8_SA(1, 0), cA + kstep, voffA); PG8_STAGE(PG8_SB(1, 1), cB + hstep + kstep, voffB);
        PG8_WAIT_V(6); PG8_BAR;
    }
    for (;;) {
        bool has_next; PG8_NEXT(ui + 1, nxt, has_next);
        const char* nA = has_next ? (const char*)g.A + (size_t)nxt.pm * tstep : cA; const char* nB = has_next ? (const char*)g.Bt + (size_t)nxt.pn * tstep : cB;
        for (int t = 0; t < nt; t += 2) {
            const bool last = (t == nt - 2);
            const char* a1 = cA + (size_t)(t + 1) * kstep;
            const char* a2 = last ? nA : cA + (size_t)(t + 2) * kstep; const char* b2 = last ? nB : cB + (size_t)(t + 2) * kstep;
            const char* a3 = a2 + kstep; const char* b3 = b2 + kstep;
            if (last && has_next) S.a_ready(nxt);
            if constexpr (SP2) {
            const bool relax = RELAX_ST && (t == 0) && (ui > 0);
            const bool first0 = SP2 && (t == 0);
            PG8_LDB(B0, 0, 0); PG8_LDB(B1, 0, 1); PG8_SCHED; PG8_LDA(At, 0, 0); if (!relax) PG8_STAGE(PG8_SA(1, 1), a1 + hstep, voffA);
            PG8_WAIT_VX(relax); PG8_WAIT_L(0); PG8_BAR; PG8_MMAX(first0, 0, 0, At, B0); PG8_MMAX(first0, 0, 1, At, B1); PG8_BAR; PG8_SCHED;
            PG8_LDA(At, 0, 1); PG8_STAGE(PG8_SB(0, 0), b2, voffB); PG8_STAGE(PG8_SB(0, 1), b2 + hstep, voffB); PG8_STAGE(PG8_SA(0, 0), a2, voffA);
            PG8_WAIT_VX(relax); PG8_WAIT_L(0); PG8_BAR; PG8_MMAX(first0, 1, 0, At, B0); PG8_MMAX(first0, 1, 1, At, B1); PG8_BAR; PG8_SCHED;
            PG8_LDB(B0, 1, 0); PG8_LDB(B1, 1, 1); PG8_SCHED; PG8_LDA(At, 1, 0); PG8_STAGE(PG8_SA(0, 1), a2 + hstep, voffA);
            PG8_WAIT_VX(relax); PG8_WAIT_L(0); PG8_BAR; PG8_MMA(0, 0, At, B0); PG8_MMA(0, 1, At, B1); PG8_BAR; PG8_SCHED;
            PG8_LDA(At, 1, 1); PG8_STAGE(PG8_SB(1, 0), b3, voffB); PG8_STAGE(PG8_SB(1, 1), b3 + hstep, voffB); PG8_STAGE(PG8_SA(1, 0), a3, voffA);
            PG8_WAIT_V(8); PG8_WAIT_L(0); PG8_BAR; PG8_MMA(1, 0, At, B0); PG8_MMA(1, 1, At, B1); PG8_BAR; PG8_SCHED;
            } else {
            PG8_LDB(B0, 0, 0); PG8_SCHED; PG8_LDA(At, 0, 0); PG8_STAGE(PG8_SA(1, 1), a1 + hstep, voffA);
            PG8_WAIT_L(8); PG8_BAR; PG8_WAIT_L(0); PG8_MMA(0, 0, At, B0); PG8_BAR; PG8_SCHED;
            PG8_LDB(B1, 0, 1); PG8_STAGE(PG8_SB(0, 0), b2, voffB);
            PG8_BAR; PG8_WAIT_L(0); PG8_MMA(0, 1, At, B1); PG8_BAR;
            PG8_LDA(At, 0, 1); PG8_STAGE(PG8_SA(0, 0), a2, voffA);
            PG8_BAR; PG8_WAIT_L(0); PG8_MMA(1, 0, At, B0); PG8_BAR; PG8_SCHED;
            PG8_STAGE(PG8_SB(0, 1), b2 + hstep, voffB);
            PG8_WAIT_V(6); PG8_BAR; PG8_MMA(1, 1, At, B1); PG8_BAR;
            PG8_LDB(B0, 1, 0); PG8_SCHED; PG8_LDA(At, 1, 0); PG8_STAGE(PG8_SA(0, 1), a2 + hstep, voffA);
            PG8_WAIT_L(8); PG8_BAR; PG8_WAIT_L(0); PG8_MMA(0, 0, At, B0); PG8_BAR; PG8_SCHED;
            PG8_LDB(B1, 1, 1); PG8_STAGE(PG8_SB(1, 0), b3, voffB);
            PG8_BAR; PG8_WAIT_L(0); PG8_MMA(0, 1, At, B1); PG8_BAR;
            PG8_LDA(At, 1, 1); PG8_STAGE(PG8_SA(1, 0), a3, voffA);
            PG8_BAR; PG8_WAIT_L(0); PG8_MMA(1, 0, At, B0); PG8_BAR; PG8_SCHED;
            PG8_STAGE(PG8_SB(1, 1), b3 + hstep, voffB);
            PG8_WAIT_V(6); PG8_BAR; PG8_MMA(1, 1, At, B1); PG8_BAR;
            }
        }
        if constexpr (ALIGN_EPI) { if (wr == 0) PG8_BAR; }
        if constexpr (RELAX_ST) { if (has_next) PG8_STAGE(PG8_SA(1, 1), nA + kstep + hstep, voffA); }
        if constexpr (FP8 != 0) asm volatile("s_nop 15\n\ts_nop 15\n\ts_nop 7" ::: "memory");
        if constexpr (!Epi::AFTER_DRAIN) { int tide_ = tid; asm volatile("" : "+v"(tide_)); const int le_ = tide_ & 63;
            E(acc, cur, wr, wc, le_ & 15, le_ >> 4); S.done(cur); }
        if (!has_next) break;
        if constexpr (!SP2) {
#pragma unroll
        for (int a = 0; a < 2; ++a)
#pragma unroll
            for (int b = 0; b < 2; ++b)
#pragma unroll
                for (int m = 0; m < 4; ++m)
#pragma unroll
                    for (int n = 0; n < 2; ++n) acc[a][b][m][n] = (f32x4){0.f, 0.f, 0.f, 0.f};
        }
        cur = nxt; cA = nA; cB = nB; ++ui;
        if constexpr (ALIGN_EPI) { if (wr == 1) PG8_BAR; }
    }
    PG8_WAIT_V(0);
    if constexpr (!ALIGN_EPI) { if (wr == 0) PG8_BAR; }
    PG8_BAR;
    if constexpr (Epi::AFTER_DRAIN) { E.fused(acc, cur, wr, wc, fr, fq, lds, wid, lane); S.done(cur); }
#undef PG8_SA
#undef PG8_SB
#undef PG8_STAGE
#undef PG8_LDA
#undef PG8_LDB
#undef PG8_MMA
#undef PG8_MMA0
#undef PG8_MMAX
#undef PG8_NEXT
#undef PG8_WAIT_V
#undef PG8_WAIT_L
#undef PG8_WAIT_VX
#undef PG8_BAR
#undef PG8_SCHED
}
}

constexpr int DM = 1024, NBATCH = 16, SEQL = 4096, CTXL = 256, RPB = SEQL + CTXL  , TA = NBATCH * RPB  ;
constexpr int FFN = 2816, NEXP = 8, EDIM = 3584, NWAVES = 8;
constexpr float NORM_EPS = 1e-6f;
constexpr float LOG2E_F = 1.4426950408889634f;
constexpr float QSCALE = 0.125f * 1.4426950408889634f;
constexpr int MOE_TILES_MAX = 552, MOE_PASS_TILES = 276;

constexpr size_t MiB = 1u << 20;
constexpr size_t WS_CTL = 0, CTL_ZERO_BYTES = 1 * MiB;
constexpr size_t WS_MODV = 1 * MiB;
constexpr size_t WS_ROPE2 = 3 * MiB;
constexpr size_t WS_SCAL = 3 * MiB + 64 * 1024;
constexpr size_t WS_ROUTW = 3 * MiB + 128 * 1024;
constexpr size_t WS_SMALL = 3 * MiB + 256 * 1024;
constexpr int SM_NORMG = 0, SM_SUBLN = 16384, SM_SINK = 16384 + 256, SM_DECAY = 16384 + 256 + 16;
constexpr size_t WS_ROPE1 = 4 * MiB;
constexpr size_t WS_TOKINFO = 8 * MiB;
constexpr size_t WS_LISTS = 10 * MiB;
constexpr size_t WS_W = 16 * MiB;
constexpr size_t W_DAIN = WS_W, W_DAOUT = W_DAIN + 12 * MiB, W_WAIN = W_DAOUT + 4 * MiB, W_WAOUT = W_WAIN + 3 * MiB, W_RETIN = W_WAOUT + 2 * MiB, W_RETOUT = W_RETIN + 12 * MiB,
                 W_FFNGU = W_RETOUT + 4 * MiB, W_FFNDN = W_FFNGU + 22 * MiB, W_MOEGU = W_FFNDN + 11 * MiB, W_MOEDN = W_MOEGU + 224 * MiB, W_END = W_MOEDN + 112 * MiB;
constexpr size_t WS_X = 424 * MiB;
constexpr size_t WS_RO8 = 560 * MiB;
constexpr size_t WS_BIG = 696 * MiB;
constexpr size_t WS_END = 1792 * MiB;
static_assert(W_END <= WS_X && WS_X + (size_t)TA * DM * 2 <= WS_RO8 && WS_RO8 + (size_t)TA * 2048 <= WS_BIG, "ws map");
constexpr size_t BIG_QKV = WS_BIG, BIG_O = WS_BIG + 408 * MiB;
constexpr size_t BIG_RQ = WS_BIG, BIG_RO = WS_BIG + 816 * MiB;
constexpr size_t BIG_H = WS_BIG;
constexpr size_t BIG_BUF = WS_BIG, BIG_YE = WS_BIG + 138 * MiB, BIG_MH = WS_BIG + 414 * MiB;
static_assert(BIG_RO + (size_t)TA * 2048 * 2 <= WS_END && BIG_MH + (size_t)MOE_TILES_MAX * 256 * EDIM <= WS_END, "ws map (big)");
#ifndef DENSE_FP8
#define DENSE_FP8 2
#endif
#ifndef DENSE_H8
#define DENSE_H8 1
#endif
#ifndef RETOUT_FP8
#define RETOUT_FP8 1
#endif
#ifndef RESID_NR
#define RESID_NR 3
#endif
#ifndef PROJ_FP8
#define PROJ_FP8 5
#endif
constexpr size_t A8_OFF = 136 * MiB;
constexpr float A8_SCALE = 8.f, H8_SCALE = 4.f, WGU8_SCALE = 32.f, WDN8_SCALE = 64.f;
constexpr int FP8_GU = ((127 - 5) << 8) | (127 - 3), FP8_DN = ((127 - 6) << 8) | (127 - 2), FP8_AO = ((127 - 6) << 8) | (127 - 3);

constexpr size_t WS_OBC = 200 * MiB;
static_assert(WS_OBC >= W_MOEGU + 112 * MiB && WS_OBC + (size_t)NBATCH * CTXL * 2048 * 2 <= W_MOEDN, "OBC placement");
constexpr int CW_TMO = 0, CW_CODE = 1, CW_DBG = 2;
constexpr int CW_MOECNT = 64;
constexpr int CW_WQ = 128;
constexpr int CW_BAR = 4096;

constexpr int RING_OFF = 0, RING_BYTES = 131072;
constexpr int LDSCTL_OFF = RING_BYTES, MISC_OFF = LDSCTL_OFF + 320;
constexpr int ROPE2_LDS_OFF = LDSCTL_OFF + 2048;
constexpr int LDS_BYTES = 147456;

#define GAS __attribute__((address_space(1)))
#define LAS __attribute__((address_space(3)))
typedef unsigned short bf16;
typedef unsigned v4u __attribute__((ext_vector_type(4)));
typedef unsigned v2u __attribute__((ext_vector_type(2)));
typedef float f32x4 __attribute__((ext_vector_type(4)));
typedef float f32x2 __attribute__((ext_vector_type(2)));
typedef short bf16x8 __attribute__((ext_vector_type(8)));
typedef short s16x4 __attribute__((ext_vector_type(4)));
typedef float f32x16 __attribute__((ext_vector_type(16)));
typedef GAS unsigned gu32;
#define RLX_AGENT __ATOMIC_RELAXED, __HIP_MEMORY_SCOPE_AGENT
#define LDS_WAIT() asm volatile("s_waitcnt lgkmcnt(0)" ::: "memory")
#define VM_WAIT() asm volatile("s_waitcnt vmcnt(0)" ::: "memory")
__device__ __forceinline__ unsigned f2bf(float f) { unsigned u = __builtin_bit_cast(unsigned, f); return (u + 0x7fffu + ((u >> 16) & 1u)) >> 16; }
typedef __bf16 bf16x2_t_ __attribute__((ext_vector_type(2)));
__device__ __forceinline__ unsigned pk2(float lo, float hi) { const f32x2 v = {lo, hi}; const bf16x2_t_ b = __builtin_convertvector(v, bf16x2_t_); return __builtin_bit_cast(unsigned, b); }
__device__ __forceinline__ float bf2f(unsigned short h) { return __builtin_bit_cast(float, (unsigned)h << 16); }
__device__ __forceinline__ float bflo(unsigned w) { return __builtin_bit_cast(float, w << 16); }
__device__ __forceinline__ float bfhi(unsigned w) { return __builtin_bit_cast(float, w & 0xffff0000u); }
__device__ __forceinline__ float wave_sum(float v) {
#define WS_DPP(ctrl) v += __builtin_bit_cast(float, __builtin_amdgcn_update_dpp(0, __builtin_bit_cast(int, v), (ctrl), 0xF, 0xF, true))
    WS_DPP(0xB1);
    WS_DPP(0x4E);
    WS_DPP(0x141);
    WS_DPP(0x140);
#undef WS_DPP
    { const unsigned u = __builtin_bit_cast(unsigned, v); auto rr = __builtin_amdgcn_permlane16_swap(u, u, false, false); v = __builtin_bit_cast(float, (unsigned)rr[0]) + __builtin_bit_cast(float, (unsigned)rr[1]); }
    { const unsigned u = __builtin_bit_cast(unsigned, v); auto rr = __builtin_amdgcn_permlane32_swap(u, u, false, false); v = __builtin_bit_cast(float, (unsigned)rr[0]) + __builtin_bit_cast(float, (unsigned)rr[1]); }
    return v;
}
#define XB_TMO      128
#define XB_XCNT(j)  (256  + 64 * (j))
#define XB_XSUB(j)  (1280 + 64 * (j))
#define XB_XGEN(j)  (2304 + 64 * (j))
#define XB_TOP      3328
#define XB_TOPGEN   3392
#define XCD_BAR_WORDS 3456
#define XB_SPIN_CAP (1u << 22)

__device__ __forceinline__ unsigned xb_ld(unsigned* p)              { return __hip_atomic_load(p, __ATOMIC_RELAXED, __HIP_MEMORY_SCOPE_AGENT); }
__device__ __forceinline__ unsigned xb_add(unsigned* p, unsigned v) { return __hip_atomic_fetch_add(p, v, __ATOMIC_RELAXED, __HIP_MEMORY_SCOPE_AGENT); }
__device__ __forceinline__ unsigned xb_xcc_id() { return (unsigned)__builtin_amdgcn_s_getreg((3 << 11) | 20) & 0xFu; }
#define XB_SPIN(cond, bar) do { unsigned _sp = 0; while (cond) { __builtin_amdgcn_s_sleep(1); \
    if ((++_sp & 255u) == 0u) { if (xb_ld(&(bar)[XB_TMO])) break; if (_sp > XB_SPIN_CAP) { atomicAdd(&(bar)[XB_TMO], 1u); break; } } } } while (0)

struct XcdBarrier {
    unsigned* bar; unsigned x;
    unsigned wv;
    volatile LAS unsigned* st;
};

__device__ __forceinline__ XcdBarrier xcd_barrier_post(unsigned* bar, volatile LAS unsigned* st, unsigned wv) {
    XcdBarrier b; b.bar = bar; b.x = xb_xcc_id(); b.st = st; b.wv = wv;
    if (opaque_tid((int)wv) == 0) (void)xb_add(&bar[XB_XCNT(b.x)], 1u);
    return b;
}
__device__ __forceinline__ void xcd_barrier_complete(unsigned* bar, unsigned x, unsigned& nloc, unsigned& nx) {
    const unsigned G = gridDim.x * gridDim.y * gridDim.z;
    unsigned sum, cnt, mine, sp = 0u;
    for (;;) {
        sum = 0u; cnt = 0u; mine = 0u;
#pragma unroll
        for (unsigned j = 0; j < 16; ++j) { const unsigned c = xb_ld(&bar[XB_XCNT(j)]); sum += c; cnt += (c > 0u) ? 1u : 0u; mine = (j == x) ? c : mine; }
        if (sum == G) break;
        __builtin_amdgcn_s_sleep(1);
        if ((++sp & 255u) == 0u) { if (xb_ld(&bar[XB_TMO])) break; if (sp > XB_SPIN_CAP) { atomicAdd(&bar[XB_TMO], 1u); break; } }
    }
    nloc = mine > 0u ? mine : 1u; nx = cnt > 0u ? cnt : 1u;
}

__device__ __forceinline__ void xcd_barrier(const XcdBarrier& b) {
    asm volatile("s_waitcnt vmcnt(0)" ::: "memory");
    __syncthreads();
    if (opaque_tid((int)b.wv) == 0) {
        unsigned* bar = b.bar;
        __builtin_amdgcn_s_waitcnt(0);
        unsigned nloc = b.st[0], nx = b.st[1];
        if (nloc == 0u) { xcd_barrier_complete(bar, b.x, nloc, nx); b.st[0] = nloc; b.st[1] = nx; }
        const unsigned old = xb_add(&bar[XB_XSUB(b.x)], 1u);
        const unsigned gen = old / nloc;
        if (old + 1u == (gen + 1u) * nloc) {
            __builtin_amdgcn_fence(__ATOMIC_RELEASE, "agent");
            asm volatile("s_waitcnt vmcnt(0)" ::: "memory");
            const unsigned og = xb_add(&bar[XB_TOP], 1u);
            const unsigned tg = og / nx;
            if (og + 1u == (tg + 1u) * nx) xb_add(&bar[XB_TOPGEN], 1u);
            else XB_SPIN(xb_ld(&bar[XB_TOPGEN]) == tg, bar);
            __builtin_amdgcn_fence(__ATOMIC_ACQUIRE, "agent");
            xb_add(&bar[XB_XGEN(b.x)], 1u);
            asm volatile("s_waitcnt vmcnt(0)" ::: "memory");
        } else {
            XB_SPIN(xb_ld(&bar[XB_XGEN(b.x)]) == gen, bar);
            __builtin_amdgcn_fence(__ATOMIC_ACQUIRE, "agent");
            asm volatile("s_waitcnt vmcnt(0)" ::: "memory");
        }
    }
    __syncthreads();
}

struct Args { const float* in[22]; float* out; unsigned char* ws; int ph_lo, ph_hi; };

struct WJob { const float* src; bf16* dst; int K, Nsrc, Ndst, mode; float f8scale; float upscale; };
__device__ __forceinline__ void wjob_get(const Args& a, int j, WJob& w) {
    unsigned char* ws = a.ws; w.f8scale = 0.f; w.upscale = 1.f;
    if (j < 2)        { w.src = a.in[7] + (size_t)j * 1024 * 3072;  w.dst = (bf16*)(ws + W_DAIN + (size_t)j * 6 * MiB);   w.K = 1024; w.Nsrc = 3072; w.Ndst = 3072; w.mode = 1; w.f8scale = (j == 1 && (PROJ_FP8 & 4)) ? WGU8_SCALE : 0.f; }
    else if (j < 4)   { const int i = j - 2; w.src = a.in[8] + (size_t)i * 1024 * 1024; w.dst = (bf16*)(ws + W_DAOUT + (size_t)i * 2 * MiB); w.K = 1024; w.Nsrc = 1024; w.Ndst = 1024; w.mode = 0; }
    else if (j == 4)  { w.src = a.in[11]; w.dst = (bf16*)(ws + W_WAIN);  w.K = 1024; w.Nsrc = 1536; w.Ndst = 1536; w.mode = 2; }
    else if (j == 5)  { w.src = a.in[12]; w.dst = (bf16*)(ws + W_WAOUT); w.K = 1024; w.Nsrc = 1024; w.Ndst = 1024; w.mode = 0; }
    else if (j == 6)  { w.src = a.in[14]; w.dst = (bf16*)(ws + W_RETIN); w.K = 1024; w.Nsrc = 6144; w.Ndst = 6144; w.mode = 3; w.f8scale = (PROJ_FP8 & 1) ? WGU8_SCALE : 0.f; }
    else if (j == 7)  { w.src = a.in[15]; w.dst = (bf16*)(ws + W_RETOUT); w.K = 2048; w.Nsrc = 1024; w.Ndst = 1024; w.mode = 0; w.f8scale = RETOUT_FP8 ? WDN8_SCALE : 0.f; }
    else if (j < 10)  { const int i = j - 8;  w.src = a.in[17] + (size_t)i * 1024 * 5632; w.dst = (bf16*)(ws + W_FFNGU + (size_t)i * 11 * MiB); w.K = 1024; w.Nsrc = 5632; w.Ndst = 5632; w.mode = 4; w.f8scale = ((DENSE_FP8 >> i) & 1) ? WGU8_SCALE : 0.f; w.upscale = ((((DENSE_FP8 | DENSE_H8) >> i) & 1) ? H8_SCALE : 1.f) * (1.f / LOG2E_F); }
    else if (j < 12)  { const int i = j - 10; w.src = a.in[18] + (size_t)i * 2816 * 1024; w.dst = (bf16*)(ws + W_FFNDN + (size_t)i * 11 * MiB / 2); w.K = 2816; w.Nsrc = 1024; w.Ndst = 1024; w.mode = 0; w.f8scale = (((DENSE_FP8 | DENSE_H8) >> i) & 1) ? WDN8_SCALE : 0.f; }
    else if (j < 28)  { const int i = j - 12; w.src = a.in[20] + (size_t)i * 1024 * 7168; w.dst = (bf16*)(ws + W_MOEGU + (size_t)i * 7 * MiB); w.K = 1024; w.Nsrc = 7168; w.Ndst = 7168; w.mode = 4; w.f8scale = WGU8_SCALE; w.upscale = H8_SCALE * (1.f / LOG2E_F); }
    else              { const int i = j - 28; w.src = a.in[21] + (size_t)i * 3584 * 1024; w.dst = (bf16*)(ws + W_MOEDN + (size_t)i * 7 * MiB / 2);  w.K = 3584; w.Nsrc = 1024; w.Ndst = 1024; w.mode = 0; w.f8scale = WDN8_SCALE; }
}
constexpr int W_ITEMS = 103936;
__device__ __forceinline__ int wsrc_col(int mode, int n, int Nsrc, float upscale, float& scale) {
    scale = 1.f;
    if (mode == 0) return n;
    if (mode == 1 || mode == 2) {
        const int nrope = (mode == 1) ? 2048 : 1280;
        if (n < 1024) scale = QSCALE;
        if (n >= nrope) return n;
        const int n64 = n & 63, half = n64 >> 5, p = n64 & 31, sg = 4 * (p >> 3) + (p & 3) + 16 * ((p >> 2) & 1);
        return (n & ~63) + 32 * half + sg;
    }
    if (mode == 3) { if (n >= 1024 && n < 2048) scale = 0.0625f; return n; }
    const int F = Nsrc >> 1, pn = n >> 8, w = n & 255;
    scale = (w < 128) ? LOG2E_F : upscale;
    return (w < 128) ? (128 * pn + w) : (F + 128 * pn + (w - 128));
}
__device__ __forceinline__ void p0_transpose_item(const WJob& w, LAS float* scr, int item, int lane) {
    const int nblk = w.Ndst / 32, kb = item / nblk, nb = item % nblk, k0 = 64 * kb, n0 = 32 * nb;
    const int r = lane >> 3, c4 = lane & 7;
    float scale; const int sc = wsrc_col(w.mode, n0 + 4 * c4, w.Nsrc, w.upscale, scale);
    if (w.f8scale != 0.f) scale *= w.f8scale;
    const float* W = w.src + (size_t)(k0 + r) * w.Nsrc + sc;
    f32x4 v[8];
#pragma unroll
    for (int i = 0; i < 8; ++i) v[i] = *(const f32x4*)(W + (size_t)(8 * i) * w.Nsrc);
#pragma unroll
    for (int i = 0; i < 8; ++i) { LAS float* d = scr + (8 * i + r) * 33 + 4 * c4; d[0] = v[i][0] * scale; d[1] = v[i][1] * scale; d[2] = v[i][2] * scale; d[3] = v[i][3] * scale; }
    LDS_WAIT(); asm volatile("" ::: "memory");
    const int c = lane & 7;
#pragma unroll
    for (int j = 0; j < 4; ++j) { const int n = (lane >> 3) + 8 * j; const LAS float* s = scr + (8 * c) * 33 + n;
        if (w.f8scale != 0.f) { v2u o; o.x = pg8::pack4_fp8(s[0 * 33], s[1 * 33], s[2 * 33], s[3 * 33]); o.y = pg8::pack4_fp8(s[4 * 33], s[5 * 33], s[6 * 33], s[7 * 33]);
            *(GAS v2u*)((unsigned char*)w.dst + (size_t)(n0 + n) * w.K + k0 + 8 * c) = o; }
        else { v4u o; o.x = pk2(s[0 * 33], s[1 * 33]); o.y = pk2(s[2 * 33], s[3 * 33]); o.z = pk2(s[4 * 33], s[5 * 33]); o.w = pk2(s[6 * 33], s[7 * 33]);
            *(GAS v4u*)(w.dst + (size_t)(n0 + n) * w.K + k0 + 8 * c) = o; } }
    LDS_WAIT(); asm volatile("" ::: "memory");
}
__device__ __forceinline__ void p0_prologue(const Args& a, LAS unsigned char* lds, int G, int wv) {
    const int tid = opaque_tid(wv), lane = tid & 63, wave = __builtin_amdgcn_readfirstlane(tid >> 6);
    unsigned char* ws = a.ws;
    const int bx = blockIdx.x;
    if (bx < 48) {
        LAS float* s = (LAS float*)lds;
        for (int i = tid; i < 17 * 1024; i += NWAVES * 64) { const float v = (i < 16384) ? a.in[1][i] : a.in[3][i - 16384]; s[(i & 1023) * 20 + (i >> 10)] = v / (1.f + __expf(-v)); }
        __syncthreads();
        const int idx = bx * 512 + tid, l = idx / 6144, n = idx - l * 6144;
        float acc[17];
#pragma unroll
        for (int mi = 0; mi < 17; ++mi) acc[mi] = 0.f;
        const float* wp = a.in[4] + (size_t)l * 1024 * 6144 + n;
#pragma unroll 4
        for (int k = 0; k < 1024; ++k) { const float wv = wp[(size_t)k * 6144];
#pragma unroll
            for (int q = 0; q < 4; ++q) { const f32x4 sv = *(const LAS f32x4*)(s + k * 20 + 4 * q); acc[4 * q] += sv[0] * wv; acc[4 * q + 1] += sv[1] * wv; acc[4 * q + 2] += sv[2] * wv; acc[4 * q + 3] += sv[3] * wv; }
            acc[16] += s[k * 20 + 16] * wv; }
        float* modv = (float*)(ws + WS_MODV); const float bb = a.in[5][l * 6144 + n];
#pragma unroll
        for (int mi = 0; mi < 17; ++mi) modv[(size_t)(l * 17 + mi) * 6144 + n] = acc[mi] + bb;
        __syncthreads();
    }
    { const int gt = bx * (NWAVES * 64) + tid, NT = G * NWAVES * 64;
      float* r1c = (float*)(ws + WS_ROPE1); float* r1s = r1c + 4096 * 128;
      for (int idx = gt; idx < 4096 * 128; idx += NT) { const int pos = idx >> 7, i = idx & 127; const float inv = powf(10000.f, -(float)(2 * i) / 256.f); const float ang = (float)pos * inv;
          double sd, cd; sincos((double)ang, &sd, &cd); r1c[idx] = (float)cd; r1s[idx] = (float)sd; }
      float* r2c = (float*)(ws + WS_ROPE2); float* r2s = r2c + 64 * 16;
      for (int idx = gt; idx < 64 * 16; idx += NT) { const int pos = idx >> 4, i = idx & 15; const float inv = powf(10000.f, -(float)(2 * i) / 32.f); const float ang = (float)pos * inv;
          double sd, cd; sincos((double)ang, &sd, &cd); r2c[idx] = (float)cd; r2s[idx] = (float)sd; }
      float* rw = (float*)(ws + WS_ROUTW);
      for (int idx = gt; idx < 2 * 8 * 1024; idx += NT) { const int l = idx >> 13, e = (idx >> 10) & 7, k = idx & 1023; rw[idx] = a.in[19][((size_t)l * 1024 + k) * 8 + e]; }
      { float* sm = (float*)(ws + WS_SMALL);
        for (int idx = gt; idx < 16384; idx += NT) sm[SM_NORMG + idx] = a.in[6][idx];
        if (gt < 256) sm[SM_SUBLN + gt] = a.in[10][gt];
        if (gt < 16) sm[SM_SINK + gt] = a.in[13][gt];
        if (gt < 8) sm[SM_DECAY + gt] = a.in[16][gt]; }
      if (gt < 2) { const float* lp = a.in[9] + gt * 256; float s01 = 0.f, s23 = 0.f;
          for (int i = 0; i < 64; ++i) { s01 += lp[i] * lp[64 + i]; s23 += lp[128 + i] * lp[192 + i]; }
          const float lam_init = 0.8f - 0.6f * expf(-0.3f * (float)(gt == 0 ? 0 : 3));
          ((float*)(ws + WS_SCAL))[gt] = expf(s01) - expf(s23) + lam_init; }
    }
    { LAS float* scr = (LAS float*)(lds + wave * 16384);
      gu32* wq = (gu32*)(ws + WS_CTL) + CW_WQ;
      constexpr int CH = 8;
      int j = 0, base = 0; WJob w; wjob_get(a, 0, w); int n = (w.K / 64) * (w.Ndst / 32);
      for (;;) {
          unsigned i0 = 0; if (lane == 0) i0 = __hip_atomic_fetch_add(wq, (unsigned)CH, RLX_AGENT); i0 = __builtin_amdgcn_readfirstlane(i0);
          if (i0 >= (unsigned)W_ITEMS) break;
          for (int t = 0; t < CH; ++t) { const int it = (int)i0 + t; if (it >= W_ITEMS) break;
              while (it >= base + n) { base += n; ++j; wjob_get(a, j, w); n = (w.K / 64) * (w.Ndst / 32); }
              p0_transpose_item(w, scr, it - base, lane); } } }
}

#define RC(j) (8 * lane + 512 * ((j) >> 1) + 4 * ((j) & 1))
template <int VAR, bool ROUTE, bool FINAL, bool A8 = false, bool NOCTX = false>
__device__ __forceinline__ void resid_phase(unsigned char* ws, float* outp, const float* in_x, const float* in_ctx, LAS unsigned char* lds, const bf16* Ysrc, int layY, int subY, int layA, int subA, int moe_l, int G, int wv) {
    const int tid = opaque_tid(wv), lane = tid & 63, wave = __builtin_amdgcn_readfirstlane(tid >> 6);
    const int gw = blockIdx.x * NWAVES + wave, NGW = G * NWAVES;
    const float* modv = (const float*)(ws + WS_MODV);
    bf16* X = (bf16*)(ws + WS_X); bf16* AY = (bf16*)outp;
    const float* ngY = (const float*)(ws + WS_SMALL) + SM_NORMG + (size_t)(layY * 4 + (subY ? 3 : 1)) * 1024;
    const float* ngA = (const float*)(ws + WS_SMALL) + SM_NORMG + (size_t)(layA * 4 + (subA ? 2 : 0)) * 1024;
    gu32* ctl = (gu32*)(ws + WS_CTL);
    int ts[9];
    if (VAR == 2) { ts[0] = 0;
#pragma unroll
        for (int e = 0; e < 8; ++e) { const unsigned c = (unsigned)__builtin_amdgcn_readfirstlane((int)__hip_atomic_load(ctl + CW_MOECNT + 16 * moe_l + e, RLX_AGENT)); ts[e + 1] = ts[e] + (int)((c + 255u) >> 8); } }
    const int moe_r = ROUTE ? moe_l : 0;
    LAS float* wr = (LAS float*)lds; LAS int* lcnt = (LAS int*)(lds + 32768); LAS int* lbase = lcnt + 8; LAS unsigned* info = (LAS unsigned*)(lds + 33024) + wave * (40 * 4);
    if (ROUTE) { const float* rw = (const float*)(ws + WS_ROUTW) + (size_t)moe_r * 8192;
        for (int i = tid; i < 8192; i += NWAVES * 64) wr[i] = rw[i];
        if (tid < 8) lcnt[tid] = 0;
        __syncthreads(); }
    constexpr int NR = RESID_NR;
    const int RPW = (TA + NGW - 1) / NGW, rbeg = gw * RPW, rend = (rbeg + RPW < TA) ? rbeg + RPW : TA;
    f32x4 ngY_r[4], ngA_r[4], gate_r[4], sh_r[4], sc_r[4]; int miY = -1, miA = -1;
#pragma unroll
    for (int j = 0; j < 4; ++j) { ngY_r[j] = *(const f32x4*)(ngY + RC(j)); ngA_r[j] = *(const f32x4*)(ngA + RC(j)); }
    for (int r0 = rbeg, nrow = 0; r0 < rend; r0 += NR, nrow += NR) {
        int rr[NR], bb[NR], pp[NR], mi[NR]; bool isctx[NR], act[NR];
#pragma unroll
        for (int u = 0; u < NR; ++u) { rr[u] = r0 + u; const bool valid = rr[u] < rend; const int rq = valid ? rr[u] : r0; bb[u] = rq / RPB; pp[u] = rq - bb[u] * RPB; isctx[u] = pp[u] < CTXL; mi[u] = isctx[u] ? 16 : bb[u];
            act[u] = valid && !((NOCTX || FINAL) && isctx[u]);
            if (ROUTE && valid && !act[u] && lane == 0) info[(nrow + u) * 4] = 0xffu;
            rr[u] = rq; }
        f32x4 xv[NR][4]; v2u xraw[NR][4], yraw[NR][4], y1raw[NR][4]; v4u ti[NR];
#pragma unroll
        for (int u = 0; u < NR; ++u) if (act[u]) {
            if (VAR == 0) { const float* src = isctx[u] ? in_ctx + ((size_t)bb[u] * CTXL + pp[u]) * DM : in_x + ((size_t)bb[u] * SEQL + (pp[u] - CTXL)) * DM;
#pragma unroll
                for (int j = 0; j < 4; ++j) xv[u][j] = *(const f32x4*)(src + RC(j)); }
            else { const bf16* xr = X + (size_t)rr[u] * DM;
#pragma unroll
                for (int jj = 0; jj < 2; ++jj) { const v4u w4_ = *(const v4u*)(xr + RC(2 * jj)); xraw[u][2 * jj] = (v2u){w4_.x, w4_.y}; xraw[u][2 * jj + 1] = (v2u){w4_.z, w4_.w}; }
                if (VAR == 1) { const bf16* yr = Ysrc + (size_t)rr[u] * DM;
#pragma unroll
                    for (int jj = 0; jj < 2; ++jj) { const v4u w4_ = *(const v4u*)(yr + RC(2 * jj)); yraw[u][2 * jj] = (v2u){w4_.x, w4_.y}; yraw[u][2 * jj + 1] = (v2u){w4_.z, w4_.w}; } }
                else ti[u] = *(const v4u*)(ws + WS_TOKINFO + (size_t)rr[u] * 16); } }
        float g0v[NR], g1v[NR];
        if (VAR == 2) {
#pragma unroll
            for (int u = 0; u < NR; ++u) if (act[u]) {
                const int e0 = ti[u].x & 15, e1 = ti[u].y & 15; int s0 = 0, s1 = 0;
#pragma unroll
                for (int e = 0; e < 8; ++e) { s0 = (e == e0) ? ts[e] : s0; s1 = (e == e1) ? ts[e] : s1; }
                s0 = s0 * 256 + (int)(ti[u].x >> 4); s1 = s1 * 256 + (int)(ti[u].y >> 4);
                const unsigned gz_ = ti[u].z, gw_ = ti[u].w;
                g0v[u] = __uint_as_float(gz_); g1v[u] = __uint_as_float(gw_);
                const bf16* y0 = (const bf16*)(ws + BIG_YE) + (size_t)s0 * DM; const bf16* y1 = (const bf16*)(ws + BIG_YE) + (size_t)s1 * DM;
#pragma unroll
                for (int jj = 0; jj < 2; ++jj) { const v4u a4_ = *(const v4u*)(y0 + RC(2 * jj)), b4_ = *(const v4u*)(y1 + RC(2 * jj));
                    yraw[u][2 * jj] = (v2u){a4_.x, a4_.y}; yraw[u][2 * jj + 1] = (v2u){a4_.z, a4_.w}; y1raw[u][2 * jj] = (v2u){b4_.x, b4_.y}; y1raw[u][2 * jj + 1] = (v2u){b4_.z, b4_.w}; } } }
#pragma unroll
        for (int u = 0; u < NR; ++u) if (act[u]) {
        const int r = rr[u], b = bb[u], p = pp[u];
        if (VAR != 0) {
            f32x4 yv[4];
#pragma unroll
            for (int j = 0; j < 4; ++j) { const v2u w = yraw[u][j]; yv[j] = (f32x4){bflo(w.x), bfhi(w.x), bflo(w.y), bfhi(w.y)};
                if (VAR == 2) { const v2u w1 = y1raw[u][j]; yv[j] = yv[j] * g0v[u] + (f32x4){bflo(w1.x), bfhi(w1.x), bflo(w1.y), bfhi(w1.y)} * g1v[u]; } }
            float ss = 0.f;
#pragma unroll
            for (int j = 0; j < 4; ++j) ss += (yv[j].x * yv[j].x + yv[j].y * yv[j].y) + (yv[j].z * yv[j].z + yv[j].w * yv[j].w);
            const float rstd = __builtin_amdgcn_rsqf(wave_sum(ss) * (1.f / DM) + NORM_EPS);
            if (mi[u] != miY) { miY = mi[u]; const float* gate = modv + ((size_t)(layY * 17 + miY) * 6 + (subY ? 5 : 2)) * 1024;
#pragma unroll
                for (int j = 0; j < 4; ++j) gate_r[j] = *(const f32x4*)(gate + RC(j)) * ngY_r[j]; }
#pragma unroll
            for (int j = 0; j < 4; ++j) { const f32x4 g = gate_r[j]; const v2u xw_ = xraw[u][j]; const f32x4 x0 = (f32x4){bflo(xw_.x), bfhi(xw_.x), bflo(xw_.y), bfhi(xw_.y)};
                xv[u][j] = x0 + g * (yv[j] * rstd); }
        }
        if (FINAL) { float* orow = outp + ((size_t)b * SEQL + (p - CTXL)) * DM;
#pragma unroll
                for (int j = 0; j < 4; ++j) *(f32x4*)(orow + RC(j)) = xv[u][j]; }
        else {
            bf16* xw = X + (size_t)r * DM;
#pragma unroll
            for (int jj = 0; jj < 2; ++jj) { v4u w; w.x = pk2(xv[u][2 * jj].x, xv[u][2 * jj].y); w.y = pk2(xv[u][2 * jj].z, xv[u][2 * jj].w); w.z = pk2(xv[u][2 * jj + 1].x, xv[u][2 * jj + 1].y); w.w = pk2(xv[u][2 * jj + 1].z, xv[u][2 * jj + 1].w);
                *(v4u*)(xw + RC(2 * jj)) = w;
                xv[u][2 * jj] = (f32x4){bflo(w.x), bfhi(w.x), bflo(w.y), bfhi(w.y)}; xv[u][2 * jj + 1] = (f32x4){bflo(w.z), bfhi(w.z), bflo(w.w), bfhi(w.w)}; }
            float ss = 0.f;
#pragma unroll
            for (int j = 0; j < 4; ++j) ss += (xv[u][j].x * xv[u][j].x + xv[u][j].y * xv[u][j].y) + (xv[u][j].z * xv[u][j].z + xv[u][j].w * xv[u][j].w);
            const float rstd = __builtin_amdgcn_rsqf(wave_sum(ss) * (1.f / DM) + NORM_EPS);
            if (mi[u] != miA) { miA = mi[u]; const float* sh = modv + ((size_t)(layA * 17 + miA) * 6 + (subA ? 3 : 0)) * 1024; const float* sc = sh + 1024;
#pragma unroll
                for (int j = 0; j < 4; ++j) { sh_r[j] = *(const f32x4*)(sh + RC(j)); sc_r[j] = (*(const f32x4*)(sc + RC(j)) + 1.f) * ngA_r[j]; } }
            bf16* ar = AY + (size_t)r * DM; f32x4 av[4];
#pragma unroll
            for (int j = 0; j < 4; ++j) { const f32x4 s1 = sc_r[j], s0 = sh_r[j]; av[j] = (xv[u][j] * rstd) * s1 + s0; }
#pragma unroll
            for (int jj = 0; jj < 2; ++jj) { const int c = RC(2 * jj); const f32x4 a0 = av[2 * jj], a1 = av[2 * jj + 1];
                if (A8) { v2u w8; w8.x = pg8::pack4_fp8(a0.x * A8_SCALE, a0.y * A8_SCALE, a0.z * A8_SCALE, a0.w * A8_SCALE); w8.y = pg8::pack4_fp8(a1.x * A8_SCALE, a1.y * A8_SCALE, a1.z * A8_SCALE, a1.w * A8_SCALE);
                    *(v2u*)((unsigned char*)outp + A8_OFF + (size_t)r * DM + c) = w8; }
                else { v4u w; w.x = pk2(a0.x, a0.y); w.y = pk2(a0.z, a0.w); w.z = pk2(a1.x, a1.y); w.w = pk2(a1.z, a1.w); *(v4u*)(ar + c) = w; } }
            if (ROUTE) {
                float lg[8];
#pragma unroll
                for (int e = 0; e < 8; ++e) { float s = 0.f;
#pragma unroll
                    for (int j = 0; j < 4; ++j) { const f32x4 w4 = *(const LAS f32x4*)(wr + e * 1024 + RC(j)); s += (av[j].x * w4.x + av[j].y * w4.y) + (av[j].z * w4.z + av[j].w * w4.w); }
                    lg[e] = wave_sum(s); }
                int i0 = 0; float v0 = lg[0];
#pragma unroll
                for (int e = 1; e < 8; ++e) if (lg[e] > v0) { v0 = lg[e]; i0 = e; }
                int i1 = 0; float v1 = -3.0e38f;
#pragma unroll
                for (int e = 0; e < 8; ++e) if (e != i0 && lg[e] > v1) { v1 = lg[e]; i1 = e; }
                const float g0 = 1.f / (1.f + __expf(v1 - v0)), g1 = 1.f - g0;
                if (lane == 0) { const int q0_ = __hip_atomic_fetch_add(lcnt + i0, 1, __ATOMIC_RELAXED, __HIP_MEMORY_SCOPE_WORKGROUP), q1_ = __hip_atomic_fetch_add(lcnt + i1, 1, __ATOMIC_RELAXED, __HIP_MEMORY_SCOPE_WORKGROUP);
                    LAS unsigned* q = info + (nrow + u) * 4; q[0] = (unsigned)i0; q[1] = (unsigned)q0_; q[2] = (unsigned)i1; q[3] = (unsigned)q1_;
                    v2u gg; gg.x = __builtin_bit_cast(unsigned, g0); gg.y = __builtin_bit_cast(unsigned, g1); *(v2u*)(ws + WS_TOKINFO + (size_t)r * 16 + 8) = gg; }
            }
        }
        }
    }
    if (ROUTE) {
        __syncthreads();
        if (tid < 8) lbase[tid] = (int)__hip_atomic_fetch_add(ctl + CW_MOECNT + 16 * moe_r + tid, (unsigned)lcnt[tid], RLX_AGENT);
        __syncthreads();
        if (lane == 0) { int k = 0; int* lists = (int*)(ws + WS_LISTS);
            for (int r = rbeg; r < rend; ++r, ++k) { const LAS unsigned* q = info + k * 4; if (q[0] == 0xffu) continue; const int e0 = (int)q[0], e1 = (int)q[2]; const int r0 = (int)q[1] + lbase[e0], r1 = (int)q[3] + lbase[e1];
                lists[(size_t)e0 * TA + r0] = r; lists[(size_t)e1 * TA + r1] = r;
                v2u ti; ti.x = (unsigned)e0 | ((unsigned)r0 << 4); ti.y = (unsigned)e1 | ((unsigned)r1 << 4);
                *(v2u*)(ws + WS_TOKINFO + (size_t)r * 16) = ti; } }
        __syncthreads();
    }
}

namespace att {
#define SBAR() __builtin_amdgcn_sched_barrier(0)
#define SWZX(v, k) __builtin_bit_cast(float, __builtin_amdgcn_ds_swizzle(__builtin_bit_cast(int, (float)(v)), ((k) << 10) | 0x1f))
constexpr float THRL = 8.f;
__device__ __forceinline__ int crow(int r, int hi) { return (r & 3) + 8 * (r >> 2) + 4 * hi; }
__device__ __forceinline__ unsigned cvtpk(float lo, float hi) { unsigned r; asm volatile("v_cvt_pk_bf16_f32 %0, %1, %2" : "=v"(r) : "v"(lo), "v"(hi)); return r; }
__device__ __forceinline__ void partialSM(f32x16& p0, f32x16& p1, float& m_reg, float& mn, float& alpha) {
    float pmax = p0[0];
#pragma unroll
    for (int r = 1; r < 16; ++r) pmax = fmaxf(pmax, p0[r]);
#pragma unroll
    for (int r = 0; r < 16; ++r) pmax = fmaxf(pmax, p1[r]);
    { auto rr = __builtin_amdgcn_permlane32_swap(__float_as_uint(pmax), __float_as_uint(pmax), false, false);
      pmax = fmaxf(__uint_as_float(rr[0]), __uint_as_float(rr[1])); }
    if (__builtin_expect(__all(pmax - m_reg <= THRL), 1)) { mn = m_reg; alpha = 1.f; }
    else { mn = fmaxf(m_reg, pmax); alpha = __builtin_amdgcn_exp2f(m_reg - mn); m_reg = mn; }
#pragma unroll
    for (int r = 0; r < 16; ++r) p0[r] = p0[r] - mn;
#pragma unroll
    for (int r = 0; r < 16; ++r) p1[r] = p1[r] - mn;
#pragma unroll
    for (int r = 0; r < 16; ++r) p0[r] = __builtin_amdgcn_exp2f(p0[r]);
}

__device__ __forceinline__ float sm_max16(const f32x16& p) { float a = p[0];
#pragma unroll
    for (int r = 1; r < 16; ++r) a = fmaxf(a, p[r]);
    return a; }
__device__ __forceinline__ void sm_decide(float pmax, float& m_reg, float& mn, float& alpha) {
    { auto rr = __builtin_amdgcn_permlane32_swap(__float_as_uint(pmax), __float_as_uint(pmax), false, false);
      pmax = fmaxf(__uint_as_float(rr[0]), __uint_as_float(rr[1])); }
    if (__builtin_expect(__all(pmax - m_reg <= THRL), 1)) { mn = m_reg; alpha = 1.f; }
    else { mn = fmaxf(m_reg, pmax); alpha = __builtin_amdgcn_exp2f(m_reg - mn); m_reg = mn; } }
__device__ __forceinline__ void sm_subexp(f32x16& p, float mn) {
#pragma unroll
    for (int r = 0; r < 16; ++r) p[r] = __builtin_amdgcn_exp2f(p[r] - mn); }
__device__ __forceinline__ void sm_sub(f32x16& p, float mn) {
#pragma unroll
    for (int r = 0; r < 16; ++r) p[r] = p[r] - mn; }
__device__ __forceinline__ void finishSM(f32x16& p0, f32x16& p1, float alpha, float& l_reg, bf16x8& pa0, bf16x8& pa1, bf16x8& pa2, bf16x8& pa3) {
#pragma unroll
    for (int r = 0; r < 16; ++r) p1[r] = __builtin_amdgcn_exp2f(p1[r]);
    float ps = 0;
#pragma unroll
    for (int r = 0; r < 16; ++r) ps += p0[r];
#pragma unroll
    for (int r = 0; r < 16; ++r) ps += p1[r];
    { auto rr = __builtin_amdgcn_permlane32_swap(__float_as_uint(ps), __float_as_uint(ps), false, false);
      ps = __uint_as_float(rr[0]) + __uint_as_float(rr[1]); }
    l_reg = l_reg * alpha + ps;
#define PK4(P, BASE, OUT) do { unsigned a0 = cvtpk(P[BASE + 0], P[BASE + 1]), a1 = cvtpk(P[BASE + 2], P[BASE + 3]);   \
    unsigned b0 = cvtpk(P[BASE + 4], P[BASE + 5]), b1 = cvtpk(P[BASE + 6], P[BASE + 7]);                              \
    v4u w = {a0, a1, b0, b1}; OUT = __builtin_bit_cast(bf16x8, w); } while (0)
    PK4(p0, 0, pa0); PK4(p0, 8, pa1); PK4(p1, 0, pa2); PK4(p1, 8, pa3);
#undef PK4
}
template <int NCB> __device__ __forceinline__ int v_st(int k, int c) { const int kk = k; return ((kk >> 3) * NCB + (c >> 5)) * 512 + ((kk & 7) * 32 + (c & 31)) * 2; }
__device__ __forceinline__ int v_rd_base(int lane) { return ((lane & 3) << 3) | (((lane >> 2) & 3) << 6) | (((lane >> 4) & 1) << 5) | (((lane >> 5) & 1) << 8); }
template <int OFF> __device__ __forceinline__ s16x4 tr_read(int vb) { s16x4 r; asm volatile("ds_read_b64_tr_b16 %0, %1 offset:%2" : "=&v"(r) : "v"(vb), "i"(OFF) : "memory"); return r; }
template <int D0, int NCB> __device__ __forceinline__ void pv_one(f32x16& od, int vb, bf16x8 pa0, bf16x8 pa1, bf16x8 pa2, bf16x8 pa3) {
#define VOFF(ks, half) (((2 * (ks) + (half)) * NCB + D0) * 512)
    const s16x4 l0 = tr_read<VOFF(0, 0)>(vb), h0 = tr_read<VOFF(0, 1)>(vb), l1 = tr_read<VOFF(1, 0)>(vb), h1 = tr_read<VOFF(1, 1)>(vb);
    const s16x4 l2 = tr_read<VOFF(2, 0)>(vb), h2 = tr_read<VOFF(2, 1)>(vb), l3 = tr_read<VOFF(3, 0)>(vb), h3 = tr_read<VOFF(3, 1)>(vb);
#undef VOFF
    asm volatile("s_waitcnt lgkmcnt(0)" ::: "memory"); SBAR();
#define PK(L, H) (bf16x8){L[0], L[1], L[2], L[3], H[0], H[1], H[2], H[3]}
    od = __builtin_amdgcn_mfma_f32_32x32x16_bf16(pa0, PK(l0, h0), od, 0, 0, 0);
    od = __builtin_amdgcn_mfma_f32_32x32x16_bf16(pa1, PK(l1, h1), od, 0, 0, 0);
    od = __builtin_amdgcn_mfma_f32_32x32x16_bf16(pa2, PK(l2, h2), od, 0, 0, 0);
    od = __builtin_amdgcn_mfma_f32_32x32x16_bf16(pa3, PK(l3, h3), od, 0, 0, 0);
#undef PK
}

constexpr int DA_LD = 3072, SHM_T = 64 * 128 * 2;
#define KSWZ(row, colB) ((row) * 256 + ((colB) ^ (((row) & 7) << 4)))
__device__ __forceinline__ void da_unit64(const bf16* __restrict__ QKV_, bf16* __restrict__ O_, int b, int h, int q0, int nkeys, float lam, float oscale, const float* __restrict__ subg, char* lds, int wv) {
    const int tid = opaque_tid(wv), wid = __builtin_amdgcn_readfirstlane(tid >> 6), lane = tid & 63, r32 = lane & 31, hi = lane >> 5, mp = wid >> 2, rgi = wid & 3;
    const bf16* QKV = QKV_; bf16* O = O_; asm volatile("" : "+s"(QKV), "+s"(O));
    char* V_lds = lds; char* K_lds = lds + 2 * SHM_T;
    char* Q1_lds = lds + 4 * SHM_T;
    float* wsf = (float*)(lds + 6 * SHM_T) + wid * 128;
    const size_t rb0 = (size_t)b * RPB;
    float m_reg[2] = {0.f, 0.f}, l_reg[2] = {0.f, 0.f}; f32x16 o[2][4] = {}; bf16x8 qr[4]; asm volatile("" : "+v"(m_reg[0]), "+v"(m_reg[1]));
    { const bf16* Qw = QKV + (rb0 + q0 + rgi * 64 + r32) * DA_LD + h * 128 + mp * 64 + hi * 8;
#pragma unroll
        for (int d0 = 0; d0 < 4; ++d0) qr[d0] = *(const bf16x8*)(Qw + d0 * 16);
#pragma unroll
        for (int i = 0; i < 4; ++i) { const int p = tid + 512 * i, row = p >> 4, ch = p & 15;
            const bf16x8 v = *(const bf16x8*)(QKV + (rb0 + q0 + (row >> 5) * 64 + 32 + (row & 31)) * DA_LD + h * 128 + ch * 8);
            *(bf16x8*)(Q1_lds + row * 256 + ((ch ^ (row & 7)) << 4)) = v; } }
    const int q1off = (rgi * 32 + r32) * 256;
    const bf16* Kh = QKV + rb0 * DA_LD + 1024 + h * 128; const bf16* Vh = Kh + 1024;
    const int vb0 = (int)(uintptr_t)V_lds + v_rd_base(lane);
    const unsigned ldsK = (unsigned)(uintptr_t)K_lds + wid * 2048u, ldsV = (unsigned)(uintptr_t)V_lds + wid * 2048u;
#define DMA1(voffs, gbase, ldsdst) do { unsigned keep_; asm volatile("s_mov_b32 %0, m0\n\ts_mov_b32 m0, %3\n\ts_nop 0\n\tglobal_load_lds_dwordx4 %1, %2\n\ts_mov_b32 m0, %0" : "=&s"(keep_) : "v"(voffs), "s"(gbase), "s"((unsigned)__builtin_amdgcn_readfirstlane((int)(ldsdst))) : "memory"); } while (0)
#define DMA_TILE(k0, bq) do { const char* kb_ = (const char*)(Kh + (size_t)(k0) * DA_LD); const char* vb_ = (const char*)(Vh + (size_t)(k0) * DA_LD); \
    int t_ = tid; asm volatile("" : "+v"(t_)); const int ln = t_ & 63;       \
    _Pragma("unroll") for (int t = 0; t < 2; ++t) { const int i = wid * 2 + t; \
        const int row = 4 * i + (ln >> 4), chp = ln & 15, gch = chp ^ (row & 7); const unsigned koff_ = __umul24((unsigned)row, (unsigned)(DA_LD * 2)) + (unsigned)(gch * 16);   \
        const int p16 = 64 * i + ln, sub = p16 >> 5, within = p16 & 31, kk = (sub >> 2) * 8 + (within >> 2), c = (sub & 3) * 32 + (within & 3) * 8; \
        const int k = kk; const unsigned voff_ = __umul24((unsigned)k, (unsigned)(DA_LD * 2)) + (unsigned)(c * 2); \
        DMA1(koff_, kb_, ldsK + (bq) * SHM_T + 1024u * t); DMA1(voff_, vb_, ldsV + (bq) * SHM_T + 1024u * t); } } while (0)
#define DMA_WAIT_BAR() do { asm volatile("s_waitcnt vmcnt(0)" ::: "memory"); __syncthreads(); } while (0)
    const int NT = nkeys / 64;
    DMA_TILE(0, 0); DMA_WAIT_BAR();
    for (int j = 0; j < NT; ++j) {
        const char* Kb = K_lds + (j & 1) * SHM_T; const int vb = vb0 + (j & 1) * SHM_T;
        if (j + 1 < NT) DMA_TILE((j + 1) * 64, (j + 1) & 1);
        f32x16 p[2][2];
#define QK_ALL() do { _Pragma("unroll") for (int rb = 0; rb < 2; ++rb) { \
            const v4u aw = {hi ? 0u : 0x3F80u, 0u, 0u, 0u}, bw = {__float_as_uint(-m_reg[rb]) >> 16, 0u, 0u, 0u}; \
            p[rb][0] = __builtin_amdgcn_mfma_f32_32x32x16_bf16(__builtin_bit_cast(bf16x8, aw), __builtin_bit_cast(bf16x8, bw), f32x16{}, 0, 0, 0); \
            p[rb][1] = __builtin_amdgcn_mfma_f32_32x32x16_bf16(__builtin_bit_cast(bf16x8, aw), __builtin_bit_cast(bf16x8, bw), f32x16{}, 0, 0, 0); } \
        _Pragma("unroll") for (int d0 = 0; d0 < 4; ++d0) { const int cb = ((mp * 4 + d0) * 16 + hi * 8) * 2; \
            const bf16x8 k0 = *(const bf16x8*)(Kb + KSWZ(r32, cb)), k1 = *(const bf16x8*)(Kb + KSWZ(32 + r32, cb)); \
            const bf16x8 q1 = *(const bf16x8*)(Q1_lds + q1off + (((mp * 8 + d0 * 2 + hi) ^ (r32 & 7)) << 4)); \
            p[0][0] = __builtin_amdgcn_mfma_f32_32x32x16_bf16(k0, qr[d0], p[0][0], 0, 0, 0); p[0][1] = __builtin_amdgcn_mfma_f32_32x32x16_bf16(k1, qr[d0], p[0][1], 0, 0, 0); \
            p[1][0] = __builtin_amdgcn_mfma_f32_32x32x16_bf16(k0, q1, p[1][0], 0, 0, 0); p[1][1] = __builtin_amdgcn_mfma_f32_32x32x16_bf16(k1, q1, p[1][1], 0, 0, 0); \
            SBAR(); } } while (0)
#define EXPSUM(rb) do { _Pragma("unroll") for (int r = 0; r < 16; ++r) { p[rb][0][r] = __builtin_amdgcn_exp2f(p[rb][0][r]); p[rb][1][r] = __builtin_amdgcn_exp2f(p[rb][1][r]); } \
            float ps_ = p[rb][0][0]; _Pragma("unroll") for (int r = 1; r < 16; ++r) ps_ += p[rb][0][r]; _Pragma("unroll") for (int r = 0; r < 16; ++r) ps_ += p[rb][1][r]; \
            { auto rr = __builtin_amdgcn_permlane32_swap(__float_as_uint(ps_), __float_as_uint(ps_), false, false); ps_ = __uint_as_float(rr[0]) + __uint_as_float(rr[1]); } psv[rb] = ps_; } while (0)
#define QK_ONE(rb) do { int tq_ = tid; asm volatile("" : "+v"(tq_)); const int r32q = tq_ & 31, hiq = (tq_ >> 5) & 1; \
        { const v4u aw = {hiq ? 0u : 0x3F80u, 0u, 0u, 0u}, bw = {__float_as_uint(-m_reg[rb]) >> 16, 0u, 0u, 0u}; \
            p[rb][0] = __builtin_amdgcn_mfma_f32_32x32x16_bf16(__builtin_bit_cast(bf16x8, aw), __builtin_bit_cast(bf16x8, bw), f32x16{}, 0, 0, 0); \
            p[rb][1] = __builtin_amdgcn_mfma_f32_32x32x16_bf16(__builtin_bit_cast(bf16x8, aw), __builtin_bit_cast(bf16x8, bw), f32x16{}, 0, 0, 0); } \
        _Pragma("unroll") for (int d0 = 0; d0 < 4; ++d0) { const int cb = ((mp * 4 + d0) * 16 + hiq * 8) * 2; \
            const bf16x8 k0 = *(const bf16x8*)(Kb + KSWZ(r32q, cb)), k1 = *(const bf16x8*)(Kb + KSWZ(32 + r32q, cb)); \
            const bf16x8 qq = (rb) ? *(const bf16x8*)(Q1_lds + (rgi * 32 + r32q) * 256 + (((mp * 8 + d0 * 2 + hiq) ^ (r32q & 7)) << 4)) : qr[d0]; \
            p[rb][0] = __builtin_amdgcn_mfma_f32_32x32x16_bf16(k0, qq, p[rb][0], 0, 0, 0); p[rb][1] = __builtin_amdgcn_mfma_f32_32x32x16_bf16(k1, qq, p[rb][1], 0, 0, 0); \
            SBAR(); } } while (0)
#define ROWMAX(rb, pm) do { pm = fmaxf(sm_max16(p[rb][0]), sm_max16(p[rb][1])); \
        auto rr = __builtin_amdgcn_permlane32_swap(__float_as_uint(pm), __float_as_uint(pm), false, false); pm = fmaxf(__uint_as_float(rr[0]), __uint_as_float(rr[1])); } while (0)
        QK_ALL();
        bf16x8 pa[2][4]; float psv[2];
#pragma unroll
        for (int rb = 0; rb < 2; ++rb) {
            float al = 1.f; bool raw = (j == 0);
            if (!raw) {
                EXPSUM(rb);
                if (__builtin_expect(__any(!(psv[rb] <= 256.f)), 0)) {
                    float pm; ROWMAX(rb, pm);
                    if (__any(!(pm < 3e38f))) raw = true;
                    else { float d = fmaxf(__builtin_amdgcn_logf(pm), 0.f); const float mnew = __uint_as_float(pk2(0.f, m_reg[rb] + d) & 0xffff0000u); d = mnew - m_reg[rb]; m_reg[rb] = mnew;
                        al = __builtin_amdgcn_exp2f(-d); psv[rb] *= al;
#pragma unroll
                        for (int r = 0; r < 16; ++r) { p[rb][0][r] *= al; p[rb][1][r] *= al; } } } }
            if (__builtin_expect(raw, 0)) {
                if (j != 0) QK_ONE(rb);
                float pm; ROWMAX(rb, pm);
                const float mnew = __uint_as_float(pk2(0.f, m_reg[rb] + (j == 0 ? pm : fmaxf(pm, 0.f))) & 0xffff0000u), d = mnew - m_reg[rb];
                m_reg[rb] = mnew; al = __builtin_amdgcn_exp2f(-d); sm_sub(p[rb][0], d); sm_sub(p[rb][1], d);
                EXPSUM(rb); }
            const float ps = psv[rb];
            l_reg[rb] = l_reg[rb] * al + ps;
#define PK4(P, BASE, OUT) do { unsigned a0 = cvtpk(P[BASE + 0], P[BASE + 1]), a1 = cvtpk(P[BASE + 2], P[BASE + 3]);   \
    unsigned b0 = cvtpk(P[BASE + 4], P[BASE + 5]), b1 = cvtpk(P[BASE + 6], P[BASE + 7]);                              \
    v4u w = {a0, a1, b0, b1}; OUT = __builtin_bit_cast(bf16x8, w); } while (0)
            PK4(p[rb][0], 0, pa[rb][0]); PK4(p[rb][0], 8, pa[rb][1]); PK4(p[rb][1], 0, pa[rb][2]); PK4(p[rb][1], 8, pa[rb][3]);
#undef PK4
            if (__any(al < 1.f)) { float* al_l = wsf + 64 + rb * 32; if (hi == 0) al_l[r32] = al; asm volatile("s_waitcnt lgkmcnt(0)" ::: "memory");
#pragma unroll
                for (int d = 0; d < 4; ++d)
#pragma unroll
                    for (int r = 0; r < 16; ++r) o[rb][d][r] *= al_l[crow(r, hi)]; }
        }
#undef QK_ALL
#undef QK_ONE
#undef ROWMAX
#undef EXPSUM
#define PV_READ(D0, v) do { v[0] = tr_read<((0) * 4 + D0) * 512>(vb); v[1] = tr_read<((1) * 4 + D0) * 512>(vb); v[2] = tr_read<((2) * 4 + D0) * 512>(vb); v[3] = tr_read<((3) * 4 + D0) * 512>(vb); \
        v[4] = tr_read<((4) * 4 + D0) * 512>(vb); v[5] = tr_read<((5) * 4 + D0) * 512>(vb); v[6] = tr_read<((6) * 4 + D0) * 512>(vb); v[7] = tr_read<((7) * 4 + D0) * 512>(vb); } while (0)
#define PV_MMA(D0, v) do { \
        const bf16x8 f0 = (bf16x8){v[0][0], v[0][1], v[0][2], v[0][3], v[1][0], v[1][1], v[1][2], v[1][3]}, f1 = (bf16x8){v[2][0], v[2][1], v[2][2], v[2][3], v[3][0], v[3][1], v[3][2], v[3][3]}; \
        const bf16x8 f2 = (bf16x8){v[4][0], v[4][1], v[4][2], v[4][3], v[5][0], v[5][1], v[5][2], v[5][3]}, f3 = (bf16x8){v[6][0], v[6][1], v[6][2], v[6][3], v[7][0], v[7][1], v[7][2], v[7][3]}; \
        _Pragma("unroll") for (int rb = 0; rb < 2; ++rb) { o[rb][D0] = __builtin_amdgcn_mfma_f32_32x32x16_bf16(pa[rb][0], f0, o[rb][D0], 0, 0, 0); o[rb][D0] = __builtin_amdgcn_mfma_f32_32x32x16_bf16(pa[rb][1], f1, o[rb][D0], 0, 0, 0); \
            o[rb][D0] = __builtin_amdgcn_mfma_f32_32x32x16_bf16(pa[rb][2], f2, o[rb][D0], 0, 0, 0); o[rb][D0] = __builtin_amdgcn_mfma_f32_32x32x16_bf16(pa[rb][3], f3, o[rb][D0], 0, 0, 0); } } while (0)
        { s16x4 va[8], vc[8];
          PV_READ(0, va);
          PV_READ(1, vc); asm volatile("s_waitcnt lgkmcnt(8)" ::: "memory"); SBAR(); PV_MMA(0, va); SBAR();
          PV_READ(2, va); asm volatile("s_waitcnt lgkmcnt(8)" ::: "memory"); SBAR(); PV_MMA(1, vc); SBAR();
          PV_READ(3, vc); asm volatile("s_waitcnt lgkmcnt(8)" ::: "memory"); SBAR(); PV_MMA(2, va); SBAR();
          asm volatile("s_waitcnt lgkmcnt(0)" ::: "memory"); SBAR(); PV_MMA(3, vc); }
#undef PV_READ
#undef PV_MMA
        DMA_WAIT_BAR();
    }
    float* xch = (float*)lds;
    int tide_ = tid; asm volatile("" : "+v"(tide_)); const int lanee = tide_ & 63, r32e = lanee & 31, hie = lanee >> 5;
#pragma unroll
    for (int rb = 0; rb < 2; ++rb) {
        float* li_l = wsf + rb * 32;
        if (hie == 0) li_l[r32e] = l_reg[rb]; asm volatile("s_waitcnt lgkmcnt(0)" ::: "memory");
        float rli[16];
#pragma unroll
        for (int r = 0; r < 16; ++r) rli[r] = __builtin_amdgcn_rcpf(li_l[crow(r, hie)]);
        if (rb) __syncthreads();
        if (mp == 1) {
#pragma unroll
            for (int d0 = 0; d0 < 4; ++d0)
#pragma unroll
                for (int r = 0; r < 16; ++r) xch[((rgi * 4 + d0) * 16 + r) * 64 + lanee] = o[rb][d0][r] * rli[r] * lam; }
        __syncthreads();
        if (mp == 0) {
#pragma unroll
            for (int d0 = 0; d0 < 4; ++d0)
#pragma unroll
                for (int r = 0; r < 16; ++r) o[rb][d0][r] = o[rb][d0][r] * rli[r] - xch[((rgi * 4 + d0) * 16 + r) * 64 + lanee];
            float g4[4];
#pragma unroll
            for (int d0 = 0; d0 < 4; ++d0) g4[d0] = subg[d0 * 32 + r32e] * oscale;
#pragma unroll
            for (int r = 0; r < 16; ++r) {
                float s = (o[rb][0][r] * o[rb][0][r] + o[rb][1][r] * o[rb][1][r]) + (o[rb][2][r] * o[rb][2][r] + o[rb][3][r] * o[rb][3][r]);
#define S_DPP(ctrl) s += __builtin_bit_cast(float, __builtin_amdgcn_update_dpp(0, __builtin_bit_cast(int, s), (ctrl), 0xF, 0xF, true))
                S_DPP(0xB1); S_DPP(0x4E); S_DPP(0x141); S_DPP(0x140);
#undef S_DPP
                { const unsigned u_ = __builtin_bit_cast(unsigned, s); auto rr_ = __builtin_amdgcn_permlane16_swap(u_, u_, false, false); s = __builtin_bit_cast(float, (unsigned)rr_[0]) + __builtin_bit_cast(float, (unsigned)rr_[1]); }
                const float rstd = __builtin_amdgcn_rsqf(s * (1.f / 128.f) + NORM_EPS);
                bf16* orow = O + (rb0 + q0 + rgi * 64 + rb * 32 + crow(r, hie)) * DM + h * 128 + r32e;
#pragma unroll
                for (int d0 = 0; d0 < 4; ++d0) orow[d0 * 32] = (bf16)(pk2(o[rb][d0][r] * rstd * g4[d0], 0.f) & 0xffffu);
            }
        }
    }
    __syncthreads();
#undef DMA1
#undef DMA_TILE
#undef DMA_WAIT_BAR
}

constexpr int WA_LD = 1536, SHM_T64 = 64 * 64 * 2;
#define KSWZ64(row, colB) ((row) * 128 + ((colB) ^ (((row) & 7) << 4)))
__device__ __forceinline__ void wa_unit(const bf16* __restrict__ QKV, bf16* __restrict__ O, int b, int g, int blk, const float* __restrict__ sink, char* lds, int wv) {
    const int tid = opaque_tid(wv), wid = tid >> 6, lane = tid & 63, r32 = lane & 31, hi = lane >> 5, hd = wid >> 1, hf = wid & 1;
    char* V_lds = lds; char* K_lds = lds + 2 * SHM_T;
    float* wsf = (float*)(lds + 4 * SHM_T) + wid * 64; float* li_l = wsf; float* al_l = wsf + 32;
    const size_t rb = (size_t)b * RPB;
    const bool isctx = blk < 4; const int q0 = (blk - 4) * 64;
    const int NT = isctx ? 4 : 10;
    float m_reg = -1e30f, l_reg = 0.f; f32x16 o[2] = {}; bf16x8 qr[4];
    const bf16* Qw = QKV + (rb + blk * 64 + hf * 32 + r32) * WA_LD + (g * 4 + hd) * 64 + hi * 8;
#pragma unroll
    for (int d0 = 0; d0 < 4; ++d0) qr[d0] = *(const bf16x8*)(Qw + d0 * 16);
    const bf16* Kh = QKV + rb * WA_LD + 1024 + g * 64; const bf16* Vh = Kh + 256;
    const int sr = tid >> 3, sc = (tid & 7) * 8, vst = v_st<2>(sr, sc);
    const int vb0 = (int)(uintptr_t)V_lds + v_rd_base(lane);
    const int qp = q0 + hf * 32 + r32;
#define TKP(t) (q0 - 128 + 64 * ((t) - 4))
#define TROW(t) (((t) < 4) ? 64 * (t) : (((t) < 9 && TKP(t) >= 0 && TKP(t) < SEQL) ? CTXL + TKP(t) : 0))
    bf16x8 vsA, ksA, vsB, ksB;
#define SLOADA(t) do { const int k0_ = TROW(t); vsA = *(const bf16x8*)(Vh + (size_t)(k0_ + sr) * WA_LD + sc); ksA = *(const bf16x8*)(Kh + (size_t)(k0_ + sr) * WA_LD + sc); } while (0)
#define SLOADB(t) do { const int k0_ = TROW(t); vsB = *(const bf16x8*)(Vh + (size_t)(k0_ + sr) * WA_LD + sc); ksB = *(const bf16x8*)(Kh + (size_t)(k0_ + sr) * WA_LD + sc); } while (0)
#define SWRITE(bq, V0, K0) do { *(bf16x8*)(V_lds + (bq) * SHM_T + vst) = V0; *(bf16x8*)(K_lds + (bq) * SHM_T + KSWZ64(sr, sc * 2)) = K0; } while (0)
#define SWAIT() asm volatile("s_waitcnt vmcnt(2)" ::: "memory")
#define RESC(al) do { if (__any((al) < 1.f)) { if (hi == 0) al_l[r32] = (al); asm volatile("s_waitcnt lgkmcnt(0)" ::: "memory"); \
    _Pragma("unroll") for (int d = 0; d < 2; ++d) _Pragma("unroll") for (int r = 0; r < 16; ++r) o[d][r] *= al_l[crow(r, hi)]; } } while (0)
#define MASKT(P0, P1, t) do { if ((t) >= 4) { const int kp0_ = TKP(t); const bool tv_ = ((t) < 9) && kp0_ >= 0 && kp0_ < SEQL; \
    if (!tv_) { _Pragma("unroll") for (int r = 0; r < 16; ++r) { P0[r] = -1e30f; P1[r] = -1e30f; } }                  \
    else if ((t) == 4 || (t) == 8) {                                                                                  \
    _Pragma("unroll") for (int r = 0; r < 16; ++r) { const int d0_ = qp - (kp0_ + crow(r, hi)); const int d1_ = d0_ - 32; \
        if (d0_ > 128 || d0_ < -128) P0[r] = -1e30f; if (d1_ > 128 || d1_ < -128) P1[r] = -1e30f; } } } } while (0)
#define QKT(P0, P1, KB, t) do { P0 = f32x16{}; P1 = f32x16{}; _Pragma("unroll") for (int d0 = 0; d0 < 4; ++d0) { const int cb = (d0 * 16 + hi * 8) * 2; \
    const bf16x8 b0 = *(const bf16x8*)((KB) + KSWZ64(r32, cb)); const bf16x8 b1 = *(const bf16x8*)((KB) + KSWZ64(32 + r32, cb)); \
    P0 = __builtin_amdgcn_mfma_f32_32x32x16_bf16(b0, qr[d0], P0, 0, 0, 0); P1 = __builtin_amdgcn_mfma_f32_32x32x16_bf16(b1, qr[d0], P1, 0, 0, 0); } MASKT(P0, P1, t); } while (0)
#define PV2(VB) do { pv_one<0, 2>(o[0], VB, pa0, pa1, pa2, pa3); pv_one<1, 2>(o[1], VB, pa0, pa1, pa2, pa3); } while (0)
    f32x16 pA0, pA1, pB0, pB1; float mnA, mnB, alA, alB; bf16x8 pa0, pa1, pa2, pa3;
    SLOADA(0); asm volatile("s_waitcnt vmcnt(0)" ::: "memory"); SWRITE(0, vsA, ksA); __syncthreads();
    QKT(pA0, pA1, K_lds, 0); partialSM(pA0, pA1, m_reg, mnA, alA);
    SLOADB(1); if (2 < NT) SLOADA(2);
    SWAIT(); SWRITE(1, vsB, ksB); __syncthreads();
    for (int j = 1; j + 1 < NT; j += 2) {
        SBAR(); QKT(pB0, pB1, K_lds + SHM_T, j);
        finishSM(pA0, pA1, alA, l_reg, pa0, pa1, pa2, pa3); SBAR();
        SLOADB(j + 2); SBAR();
        PV2(vb0); partialSM(pB0, pB1, m_reg, mnB, alB);
        __syncthreads(); SWAIT(); SWRITE(0, vsA, ksA);
        RESC(alB); __syncthreads();
        SBAR(); QKT(pA0, pA1, K_lds, j + 1);
        finishSM(pB0, pB1, alB, l_reg, pa0, pa1, pa2, pa3); SBAR();
        if (j + 3 < NT) SLOADA(j + 3); SBAR();
        PV2(vb0 + SHM_T); partialSM(pA0, pA1, m_reg, mnA, alA);
        __syncthreads(); SWAIT(); SWRITE(1, vsB, ksB);
        RESC(alA); __syncthreads();
    }
    SBAR(); QKT(pB0, pB1, K_lds + SHM_T, NT - 1);
    finishSM(pA0, pA1, alA, l_reg, pa0, pa1, pa2, pa3); SBAR();
    PV2(vb0); partialSM(pB0, pB1, m_reg, mnB, alB);
    __syncthreads(); RESC(alB);
    finishSM(pB0, pB1, alB, l_reg, pa0, pa1, pa2, pa3); SBAR();
    PV2(vb0 + SHM_T);
    l_reg += __builtin_amdgcn_exp2f(sink[g * 4 + hd] * 1.4426950408889634f - m_reg);
    if (hi == 0) li_l[r32] = l_reg; asm volatile("s_waitcnt lgkmcnt(0)" ::: "memory");
#pragma unroll
    for (int r = 0; r < 16; ++r) { const float rl = __builtin_amdgcn_rcpf(li_l[crow(r, hi)]);
        bf16* orow = O + (rb + blk * 64 + hf * 32 + crow(r, hi)) * DM + (g * 4 + hd) * 64 + r32;
        orow[0] = (bf16)(pk2(o[0][r] * rl, 0.f) & 0xffffu); orow[32] = (bf16)(pk2(o[1][r] * rl, 0.f) & 0xffffu); }
    __syncthreads();
#undef TKP
#undef TROW
#undef SLOADA
#undef SLOADB
#undef SWRITE
#undef SWAIT
#undef RESC
#undef MASKT
#undef QKT
#undef PV2
}
#undef KSWZ
#undef KSWZ64
#undef SBAR
}

namespace ret {
constexpr int LD = 6144, QS = 528, VS = 272, PS = 144, C = 64;
constexpr int L_Q = 0, L_K = 64 * QS, L_V = 2 * 64 * QS, L_P = L_V + 64 * VS, L_T = L_P + 64 * PS  , L_END = L_T + 80 * 4;
static_assert(L_END <= 131072, "retention LDS");
template <int O0, int O1, int O2, int O3> __device__ __forceinline__ void tr4(unsigned base, s16x4& a, s16x4& b, s16x4& c, s16x4& d) {
    asm volatile("ds_read_b64_tr_b16 %0, %4 offset:%5\n\tds_read_b64_tr_b16 %1, %4 offset:%6\n\tds_read_b64_tr_b16 %2, %4 offset:%7\n\tds_read_b64_tr_b16 %3, %4 offset:%8\n\ts_waitcnt lgkmcnt(0)"
                 : "=&v"(a), "=&v"(b), "=&v"(c), "=&v"(d) : "v"(base), "i"(O0), "i"(O1), "i"(O2), "i"(O3) : "memory");
}
template <int O0, int O1, int O2, int O3> __device__ __forceinline__ void tr4n(unsigned base, s16x4& a, s16x4& b, s16x4& c, s16x4& d) {
    asm volatile("ds_read_b64_tr_b16 %0, %4 offset:%5\n\tds_read_b64_tr_b16 %1, %4 offset:%6\n\tds_read_b64_tr_b16 %2, %4 offset:%7\n\tds_read_b64_tr_b16 %3, %4 offset:%8"
                 : "=&v"(a), "=&v"(b), "=&v"(c), "=&v"(d) : "v"(base), "i"(O0), "i"(O1), "i"(O2), "i"(O3) : "memory");
}
template <int O0, int O1, int O2, int O3> __device__ __forceinline__ void tr8(unsigned base0, unsigned base1, s16x4& a, s16x4& b, s16x4& c, s16x4& d, s16x4& e, s16x4& f, s16x4& g, s16x4& h) {
    asm volatile("ds_read_b64_tr_b16 %0, %8 offset:%10\n\tds_read_b64_tr_b16 %1, %8 offset:%11\n\tds_read_b64_tr_b16 %2, %8 offset:%12\n\tds_read_b64_tr_b16 %3, %8 offset:%13\n\t"
                 "ds_read_b64_tr_b16 %4, %9 offset:%10\n\tds_read_b64_tr_b16 %5, %9 offset:%11\n\tds_read_b64_tr_b16 %6, %9 offset:%12\n\tds_read_b64_tr_b16 %7, %9 offset:%13\n\ts_waitcnt lgkmcnt(0)"
                 : "=&v"(a), "=&v"(b), "=&v"(c), "=&v"(d), "=&v"(e), "=&v"(f), "=&v"(g), "=&v"(h) : "v"(base0), "v"(base1), "i"(O0), "i"(O1), "i"(O2), "i"(O3) : "memory");
}
__device__ __forceinline__ bf16x8 cat4(s16x4 l, s16x4 h) { return (bf16x8){l[0], l[1], l[2], l[3], h[0], h[1], h[2], h[3]}; }
__device__ __forceinline__ bf16x8 scale8(bf16x8 v, const float* sc) {
    v4u w = __builtin_bit_cast(v4u, v); v4u o;
    o.x = pk2(bflo(w.x) * sc[0], bfhi(w.x) * sc[1]); o.y = pk2(bflo(w.y) * sc[2], bfhi(w.y) * sc[3]);
    o.z = pk2(bflo(w.z) * sc[4], bfhi(w.z) * sc[5]); o.w = pk2(bflo(w.w) * sc[6], bfhi(w.w) * sc[7]);
    return __builtin_bit_cast(bf16x8, o);
}
constexpr int VS2 = 528, L2_Q = 0, L2_K = 64 * QS, L2_V = 2 * 64 * QS, L2_P = 3 * 64 * QS, L2_T = L2_P + 64 * PS, L2_END = L2_T + 80 * 4;
static_assert(L2_END <= 131072, "retention LDS (v2)");
__device__ __forceinline__ void ret_unit2(const bf16* __restrict__ QKVG, bf16* __restrict__ OB, bf16* __restrict__ OBL, bf16* __restrict__ OBC, const float* __restrict__ dlogit, int b, int h, int dir, int hv, char* lds, int wv) {
    const int tid0 = opaque_tid(wv), wid = __builtin_amdgcn_readfirstlane(tid0 >> 6);
    const size_t rb = (size_t)b * RPB;
    const unsigned ldsb = (unsigned)(uintptr_t)lds;
    const bf16* Qg = QKVG + rb * LD + h * 256; const bf16* Kg = Qg + 1024; const bf16* Vg = QKVG + rb * LD + 2048 + h * 512 + hv * 256;
    const int ocol = h * 512 + hv * 256 + wid * 32;
    bf16x8 sq[4], sk[4], sv[4];
#define R2LOADQK(row0) do { _Pragma("unroll") for (int i = 0; i < 4; ++i) { const int p = tid + 512 * i; sq[i] = *(const bf16x8*)(Qg + (size_t)((row0) + (p >> 5)) * LD + (p & 31) * 8); sk[i] = *(const bf16x8*)(Kg + (size_t)((row0) + (p >> 5)) * LD + (p & 31) * 8); } } while (0)
#define R2LOADV(row0) do { _Pragma("unroll") for (int i = 0; i < 4; ++i) { const int p = tid + 512 * i; sv[i] = *(const bf16x8*)(Vg + (size_t)((row0) + (p >> 5)) * LD + (p & 31) * 8); } } while (0)
#define R2WRITEQK() do { _Pragma("unroll") for (int i = 0; i < 4; ++i) { const int p = tid + 512 * i; *(bf16x8*)(lds + L2_Q + (p >> 5) * QS + (p & 31) * 16) = sq[i]; *(bf16x8*)(lds + L2_K + (p >> 5) * QS + (p & 31) * 16) = sk[i]; } } while (0)
#define R2WRITEV() do { _Pragma("unroll") for (int i = 0; i < 4; ++i) { const int p = tid + 512 * i; *(bf16x8*)(lds + L2_V + (p >> 5) * VS2 + (p & 31) * 16) = sv[i]; } } while (0)
    const float x = dlogit[dir * 4 + h];
    const float lg2d = -log1pf(expf(-x)) * 1.4426950408889634f;
    f32x4 S[16][2];
#pragma unroll
    for (int mb = 0; mb < 16; ++mb) { S[mb][0] = (f32x4){0.f, 0.f, 0.f, 0.f}; S[mb][1] = (f32x4){0.f, 0.f, 0.f, 0.f}; }
    const float gC = __builtin_amdgcn_exp2f(lg2d * (float)C);
    __syncthreads(); if (tid0 < 65) ((float*)(lds + L2_T))[tid0] = __builtin_amdgcn_exp2f(lg2d * (float)tid0); __syncthreads();
    const float* DT = (const float*)(lds + L2_T);
#define CROW(step) ((dir == 0) ? 64 * (step) : (((step) < 4) ? 64 * (3 - (step)) : CTXL + 64 * (67 - (step))))
    { int tid = tid0; asm volatile("" : "+v"(tid)); R2LOADQK(CROW(0)); }
    for (int step = 0; step < 68; ++step) {
        const int row0 = CROW(step);
        int tid = tid0; asm volatile("" : "+v"(tid));
        R2WRITEQK(); R2LOADV(row0); __syncthreads();
        if (step + 1 < 68) { const int rown = CROW(step + 1); R2LOADQK(rown); }
        asm volatile("" : "+v"(tid)); const int lane = tid & 63, l15 = lane & 15, g = lane >> 4;
        { const int qb = wid >> 1, tb0 = 2 * (wid & 1); f32x4 sc2[2] = {(f32x4){0.f, 0.f, 0.f, 0.f}, (f32x4){0.f, 0.f, 0.f, 0.f}};
#pragma unroll
          for (int s = 0; s < 8; ++s) { const bf16x8 af = *(const bf16x8*)(lds + L2_Q + (16 * qb + l15) * QS + (32 * s + 8 * g) * 2);
              const bf16x8 bf0 = *(const bf16x8*)(lds + L2_K + (16 * tb0 + l15) * QS + (32 * s + 8 * g) * 2), bf1 = *(const bf16x8*)(lds + L2_K + (16 * tb0 + 16 + l15) * QS + (32 * s + 8 * g) * 2);
              sc2[0] = __builtin_amdgcn_mfma_f32_16x16x32_bf16(af, bf0, sc2[0], 0, 0, 0); sc2[1] = __builtin_amdgcn_mfma_f32_16x16x32_bf16(af, bf1, sc2[1], 0, 0, 0); }
#pragma unroll
          for (int tt = 0; tt < 2; ++tt) { const int tb = tb0 + tt; const f32x4 sc = sc2[tt];
#pragma unroll
              for (int r = 0; r < 4; ++r) { const int i = 16 * qb + 4 * g + r, j = 16 * tb + l15; const int d = (dir == 0) ? (i - j) : (j - i);
                  const bool keep = (dir == 0) ? (d >= 0) : (d > 0);
                  const float pv = keep ? sc[r] * DT[d & 63] : 0.f;
                  *(bf16*)(lds + L2_P + i * PS + j * 2) = (bf16)(pk2(pv, 0.f) & 0xffffu); } } }
        f32x4 oi[4][2];
#pragma unroll
          for (int qb = 0; qb < 4; ++qb) { oi[qb][0] = (f32x4){0.f, 0.f, 0.f, 0.f}; oi[qb][1] = (f32x4){0.f, 0.f, 0.f, 0.f}; }
#pragma unroll
          for (int s = 0; s < 8; ++s) { v4u bw[2];
#pragma unroll
              for (int nb = 0; nb < 2; ++nb) { bw[nb].x = pk2(S[2 * s][nb][0], S[2 * s][nb][1]); bw[nb].y = pk2(S[2 * s][nb][2], S[2 * s][nb][3]); bw[nb].z = pk2(S[2 * s + 1][nb][0], S[2 * s + 1][nb][1]); bw[nb].w = pk2(S[2 * s + 1][nb][2], S[2 * s + 1][nb][3]); }
#pragma unroll
              for (int qb = 0; qb < 4; ++qb) { const char* qp = lds + L2_Q + (16 * qb + l15) * QS + (32 * s + 4 * g) * 2;
                  const v2u a0 = *(const v2u*)qp, a1 = *(const v2u*)(qp + 32);
                  v4u aw = {a0.x, a0.y, a1.x, a1.y};
                  oi[qb][0] = __builtin_amdgcn_mfma_f32_16x16x32_bf16(__builtin_bit_cast(bf16x8, aw), __builtin_bit_cast(bf16x8, bw[0]), oi[qb][0], 0, 0, 0);
                  oi[qb][1] = __builtin_amdgcn_mfma_f32_16x16x32_bf16(__builtin_bit_cast(bf16x8, aw), __builtin_bit_cast(bf16x8, bw[1]), oi[qb][1], 0, 0, 0); } }
        R2WRITEV();
        __syncthreads();
        int tid2 = tid0; asm volatile("" : "+v"(tid2)); const int lane2 = tid2 & 63, trq = (lane2 & 15) >> 2, trp = lane2 & 3, g2 = lane2 >> 4;
        const unsigned vtr = ldsb + L2_V + (8 * g2 + trq) * VS2 + (wid * 32 + 4 * trp) * 2;
        const unsigned ktr = ldsb + L2_K + (8 * g2 + trq) * QS + (4 * trp) * 2;
        bf16x8 vf[2][2];
#pragma unroll
        for (int nb = 0; nb < 2; ++nb) { s16x4 v00, v01, v10, v11; tr4<0, 4 * VS2, 32 * VS2, 36 * VS2>(vtr + nb * 32, v00, v01, v10, v11); vf[0][nb] = cat4(v00, v01); vf[1][nb] = cat4(v10, v11); }
        {
          bf16* Obase = (dir == 0) ? OB + (rb + row0) * 2048 : ((row0 < CTXL) ? OBC + ((size_t)b * CTXL + row0) * 2048 : OBL + ((size_t)b * SEQL + (row0 - CTXL)) * 2048);
#pragma unroll
          for (int qb = 0; qb < 4; ++qb) {
            const bf16x8 p0 = *(const bf16x8*)(lds + L2_P + (16 * qb + l15) * PS + (8 * g) * 2), p1 = *(const bf16x8*)(lds + L2_P + (16 * qb + l15) * PS + (32 + 8 * g) * 2);
#pragma unroll
            for (int nb = 0; nb < 2; ++nb) { f32x4 oo;
#pragma unroll
                for (int r = 0; r < 4; ++r) { const int i = 16 * qb + 4 * g + r; oo[r] = oi[qb][nb][r] * DT[dir == 0 ? (i + 1) : (C - i)]; }
                oo = __builtin_amdgcn_mfma_f32_16x16x32_bf16(p0, vf[0][nb], oo, 0, 0, 0);
                oo = __builtin_amdgcn_mfma_f32_16x16x32_bf16(p1, vf[1][nb], oo, 0, 0, 0);
#pragma unroll
                for (int r = 0; r < 4; ++r) *(Obase + (size_t)(16 * qb + 4 * g + r) * 2048 + ocol + nb * 16 + l15) = (bf16)(pk2(oo[r], 0.f) & 0xffffu); } } }
        { float vsc0[8], vsc1[8];
#pragma unroll
          for (int j = 0; j < 8; ++j) { const int t = 8 * g2 + j; vsc0[j] = DT[dir == 0 ? (C - 1 - t) : t]; vsc1[j] = DT[dir == 0 ? (C - 33 - t) : (t + 32)]; }
          bf16x8 vs[2][2];
#pragma unroll
          for (int nb = 0; nb < 2; ++nb) { vs[0][nb] = scale8(vf[0][nb], vsc0); vs[1][nb] = scale8(vf[1][nb], vsc1); }
#pragma unroll
          for (int mg = 0; mg < 8; ++mg) { s16x4 kk[2][4];
              tr8<0, 4 * QS, 32 * QS, 36 * QS>(ktr + (mg * 2) * 32, ktr + (mg * 2 + 1) * 32, kk[0][0], kk[0][1], kk[0][2], kk[0][3], kk[1][0], kk[1][1], kk[1][2], kk[1][3]);
#pragma unroll
              for (int q = 0; q < 2; ++q) { const int mb = mg * 2 + q; const bf16x8 k0f = cat4(kk[q][0], kk[q][1]), k1f = cat4(kk[q][2], kk[q][3]);
#pragma unroll
                  for (int nb = 0; nb < 2; ++nb) { f32x4 sn = S[mb][nb] * gC;
                      sn = __builtin_amdgcn_mfma_f32_16x16x32_bf16(k0f, vs[0][nb], sn, 0, 0, 0);
                      sn = __builtin_amdgcn_mfma_f32_16x16x32_bf16(k1f, vs[1][nb], sn, 0, 0, 0);
                      S[mb][nb] = sn; } } } }
        __syncthreads();
    }
#undef CROW
#undef R2LOADQK
#undef R2LOADV
#undef R2WRITEQK
#undef R2WRITEV
}
__device__ __forceinline__ void ret_finish2(const bf16* __restrict__ QKVG, bf16* __restrict__ OB, const bf16* __restrict__ OBL, const bf16* __restrict__ OBC, unsigned char* __restrict__ O8, int G, int wv) {
    const int tid = opaque_tid(wv), lane = tid & 63, gw = (int)blockIdx.x * NWAVES + __builtin_amdgcn_readfirstlane(tid >> 6), NGW = G * NWAVES;
    for (int it0 = gw; it0 < TA * 4; it0 += 2 * NGW) {
        v4u ow[2], gwv[2], bw[2]; bf16* opv[2]; bool ok[2];
#pragma unroll
        for (int u = 0; u < 2; ++u) { const int it = it0 + u * NGW; ok[u] = it < TA * 4; const int itq = ok[u] ? it : it0; const int r = itq >> 2, h = itq & 3; const int b = r / RPB, p = r - b * RPB;
            opv[u] = OB + (size_t)r * 2048 + h * 512 + lane * 8; const bf16* gp = QKVG + (size_t)r * LD + 4096 + h * 512 + lane * 8;
            const bf16* bp = ((p < CTXL) ? OBC + ((size_t)b * CTXL + p) * 2048 : OBL + ((size_t)b * SEQL + (p - CTXL)) * 2048) + h * 512 + lane * 8;
            ow[u] = *(const v4u*)opv[u]; gwv[u] = *(const v4u*)gp; bw[u] = *(const v4u*)bp; }
#pragma unroll
        for (int u = 0; u < 2; ++u) if (ok[u]) {
            float o[8] = {bflo(ow[u].x) + bflo(bw[u].x), bfhi(ow[u].x) + bfhi(bw[u].x), bflo(ow[u].y) + bflo(bw[u].y), bfhi(ow[u].y) + bfhi(bw[u].y), bflo(ow[u].z) + bflo(bw[u].z), bfhi(ow[u].z) + bfhi(bw[u].z), bflo(ow[u].w) + bflo(bw[u].w), bfhi(ow[u].w) + bfhi(bw[u].w)};
            float gg[8] = {bflo(gwv[u].x), bfhi(gwv[u].x), bflo(gwv[u].y), bfhi(gwv[u].y), bflo(gwv[u].z), bfhi(gwv[u].z), bflo(gwv[u].w), bfhi(gwv[u].w)};
            float ss = 0.f;
#pragma unroll
            for (int j = 0; j < 8; ++j) ss += o[j] * o[j];
            const float rstd = __builtin_amdgcn_rsqf(wave_sum(ss) * (1.f / 512.f) + NORM_EPS);
#pragma unroll
            for (int j = 0; j < 8; ++j) o[j] = o[j] * rstd * (gg[j] * __builtin_amdgcn_rcpf(1.f + __builtin_amdgcn_exp2f(-LOG2E_F * gg[j])));
            v4u w; w.x = pk2(o[0], o[1]); w.y = pk2(o[2], o[3]); w.z = pk2(o[4], o[5]); w.w = pk2(o[6], o[7]);
            if (O8) { const int it = it0 + u * NGW; const int r = it >> 2, h = it & 3; v2u w8; w8.x = pg8::pack4_fp8(o[0] * A8_SCALE, o[1] * A8_SCALE, o[2] * A8_SCALE, o[3] * A8_SCALE); w8.y = pg8::pack4_fp8(o[4] * A8_SCALE, o[5] * A8_SCALE, o[6] * A8_SCALE, o[7] * A8_SCALE);
                *(v2u*)(O8 + (size_t)r * 2048 + h * 512 + lane * 8) = w8; }
            else *(v4u*)opv[u] = w; } }
}
}

__device__ __forceinline__ void moe_gather(unsigned char* ws, const float* outp, int ml, int G, int wv) {
    const int tid = opaque_tid(wv), lane = tid & 63, gw = (int)blockIdx.x * NWAVES + __builtin_amdgcn_readfirstlane(tid >> 6), NGW = G * NWAVES;
    gu32* ctl = (gu32*)(ws + WS_CTL);
    int cum[9], ts[9]; cum[0] = 0; ts[0] = 0;
#pragma unroll
    for (int e = 0; e < 8; ++e) { const unsigned c = (unsigned)__builtin_amdgcn_readfirstlane((int)__hip_atomic_load(ctl + CW_MOECNT + 16 * ml + e, RLX_AGENT)); cum[e + 1] = cum[e] + (int)c; ts[e + 1] = ts[e] + (int)((c + 255u) >> 8); }
    const int* lists = (const int*)(ws + WS_LISTS); unsigned char* BUF = ws + BIG_BUF;
    for (int i = gw; i < cum[8]; i += 2 * NGW) {
        int tok[2]; size_t slot[2]; bool ok[2];
#pragma unroll
        for (int u = 0; u < 2; ++u) { const int iu = i + u * NGW; ok[u] = iu < cum[8];
            int e = 0;
#pragma unroll
            for (int k = 1; k < 8; ++k) e += (iu >= cum[k]) ? 1 : 0;
            int ce = 0, te = 0;
#pragma unroll
            for (int k = 0; k < 8; ++k) { ce = (k == e) ? cum[k] : ce; te = (k == e) ? ts[k] : te; }
            const int rank = iu - ce; tok[u] = ok[u] ? lists[(size_t)e * TA + rank] : 0; slot[u] = (size_t)te * 256 + rank; }
        v4u o[2];
#pragma unroll
        for (int u = 0; u < 2; ++u) o[u] = *((const v4u*)((const unsigned char*)outp + A8_OFF + (size_t)tok[u] * DM) + lane);
#pragma unroll
        for (int u = 0; u < 2; ++u) if (ok[u]) *((v4u*)(BUF + slot[u] * DM) + lane) = o[u];
    }
}

__global__ void __launch_bounds__(NWAVES * 64, 2) hybrid_fwd(Args args) {
    extern __shared__ __attribute__((aligned(16))) unsigned char lds[];
    LAS unsigned char* ldsl = (LAS unsigned char*)lds;
    volatile LAS unsigned* MISC = (volatile LAS unsigned*)(ldsl + MISC_OFF);
    const int tid = threadIdx.x;
    const int WV = __builtin_amdgcn_readfirstlane(tid >> 6);
    const int G = gridDim.x;
    unsigned char* ws = args.ws;
    gu32* ctl = (gu32*)(ws + WS_CTL);
    for (int u = tid; u < (LDS_BYTES - LDSCTL_OFF) / 4; u += NWAVES * 64) ((LAS unsigned*)(ldsl + LDSCTL_OFF))[u] = 0u;
    __syncthreads();
#if MK_MULTI
    XcdBarrier bar; bar.bar = (unsigned*)(ctl + CW_BAR); bar.x = 0; bar.st = nullptr; bar.wv = (unsigned)WV;
#define GRID_BAR() do { } while (0)
#else
    XcdBarrier bar = xcd_barrier_post((unsigned*)(ctl + CW_BAR), MISC + 8, (unsigned)WV);
#define GRID_BAR() xcd_barrier(bar)
#endif
#ifdef PH_ONLY
    const int lo = PH_ONLY, hi = PH_ONLY + 1; int ph = 0;
#else
    const int lo = args.ph_lo, hi = args.ph_hi; int ph = 0;
#endif
#ifndef REPEAT_PH
#define REPEAT_PH -1
#endif
    enum { PH_BASE = __COUNTER__ + 1 };
#define PHASE_BEGIN if (lo <= ph && ph < hi) { constexpr int pid_ = __COUNTER__ - PH_BASE; constexpr int nrep_ = (pid_ == REPEAT_PH) ? 2 : 1; asm volatile("; PHASE_MARK %0" :: "i"(pid_)); \
    _Pragma("unroll") for (int rep_ = 0; rep_ < nrep_; ++rep_) { if (rep_) GRID_BAR();
#define PHASE_END   } if (ph + 1 < hi) GRID_BAR(); } ++ph;

#define AY ((bf16*)args.out)
#define r2c ((const float*)(ws + WS_ROPE2))
#define r2s ((const float*)(ws + WS_ROPE2) + 64 * 16)
#define r1c ((const float*)(ws + WS_ROPE1))
#define r1s ((const float*)(ws + WS_ROPE1) + 4096 * 128)

    PHASE_BEGIN p0_prologue(args, ldsl, G, WV); PHASE_END
    PHASE_BEGIN resid_phase<0, false, false>(ws, args.out, args.in[0], args.in[2], ldsl, AY, 0, 0, 0, 0, 0, G, WV); PHASE_END

#define GEMM_PHASE8(F8, EPI, ORDER, AP, BP, NN, KK, SINIT, ...) { int kk_ = (KK); asm volatile("" : "+s"(kk_)); pg8::Gemm g{(const bf16*)(AP), (const bf16*)(BP), TA, NN, kk_}; ORDER S; SINIT; EPI E{__VA_ARGS__}; EPI_SETMODE \
        pg8::gemm_phase<EPI, ORDER, true, true, F8>(ldsl + RING_OFF, g, S, E, WV); }
#define GEMM_PHASE(...) GEMM_PHASE8(0, __VA_ARGS__)
#ifdef EPI_MODE
#define EPI_SETMODE E.mode = rep_ ? EPI_MODE : 0;
#else
#define EPI_SETMODE
#endif
#define SO_INIT(NN) S.init(TA, NN, G, (int)blockIdx.x)
#define ROPE2_LDS { LAS float* rl_ = (LAS float*)(ldsl + ROPE2_LDS_OFF); const float* rg_ = (const float*)(ws + WS_ROPE2); for (int i_ = opaque_tid(WV); i_ < 2048; i_ += NWAVES * 64) rl_[i_] = rg_[i_]; __syncthreads(); }
#define r2cl ((const LAS float*)(ldsl + ROPE2_LDS_OFF))
#define r2sl ((const LAS float*)(ldsl + ROPE2_LDS_OFF) + 64 * 16)
#define DA_INPROJ(j) PHASE_BEGIN ROPE2_LDS GEMM_PHASE(pg8::EpiRope2D, pg8::StaticOrder, AY, ws + W_DAIN + (size_t)(j) * 6 * MiB, 3072, 1024, SO_INIT(3072), (bf16*)(ws + BIG_QKV), 3072, 8, r2cl, r2sl) PHASE_END
#define DA_INPROJ8(j) PHASE_BEGIN ROPE2_LDS GEMM_PHASE8(FP8_GU, pg8::EpiRope2D, pg8::StaticOrder, (unsigned char*)args.out + A8_OFF, ws + W_DAIN + (size_t)(j) * 6 * MiB, 3072, 512, SO_INIT(3072), (bf16*)(ws + BIG_QKV), 3072, 8, r2cl, r2sl) PHASE_END
#define DA_LAYER(j, lam_init) \
    PHASE_BEGIN { const float lam = ((const float*)(ws + WS_SCAL))[j]; \
        for (int L = blockIdx.x; L < ((j) == 1 ? 2048 : 2176); L += G) { int bh, q0r, nk;     if (L < 2048) { const int c_ = L & 255; bh = 16 * (L >> 8) + (c_ & 7) + 8 * (c_ >> 7); q0r = CTXL + 256 * ((c_ >> 3) & 15); nk = RPB; } else { bh = L - 2048; q0r = 0; nk = CTXL; } \
            att::da_unit64((const bf16*)(ws + BIG_QKV), (bf16*)(ws + BIG_O), bh >> 3, bh & 7, q0r, nk, lam, 1.f - (lam_init), (const float*)(ws + WS_SMALL) + SM_SUBLN + (j) * 128, (char*)lds + RING_OFF, WV); } } PHASE_END \
    PHASE_BEGIN if ((j) == 1) GEMM_PHASE(pg8::EpiPlain, pg8::StaticOrderLat, ws + BIG_O, ws + W_DAOUT + (size_t)(j) * 2 * MiB, 1024, 1024, S.init(NBATCH * SEQL, 1024, G, (int)blockIdx.x), AY, 1024, 4, 0) \
                else GEMM_PHASE(pg8::EpiPlain, pg8::StaticOrder, ws + BIG_O, ws + W_DAOUT + (size_t)(j) * 2 * MiB, 1024, 1024, SO_INIT(1024), AY, 1024, 4, 0) PHASE_END
#define DENSE_FFN8(i) \
    PHASE_BEGIN GEMM_PHASE8(FP8_GU, pg8::EpiSwiGLU8, pg8::StaticOrder, (unsigned char*)args.out + A8_OFF, ws + W_FFNGU + (size_t)(i) * 11 * MiB, 5632, 512, SO_INIT(5632), ws + BIG_H, FFN, 22, 0, H8_SCALE) PHASE_END \
    PHASE_BEGIN GEMM_PHASE8(FP8_DN, pg8::EpiPlain, pg8::StaticOrder, ws + BIG_H, ws + W_FFNDN + (size_t)(i) * 11 * MiB / 2, 1024, FFN / 2, SO_INIT(1024), AY, 1024, 4, 0) PHASE_END
#define DENSE_FFN_H8(i) \
    PHASE_BEGIN GEMM_PHASE(pg8::EpiSwiGLU8, pg8::StaticOrder, AY, ws + W_FFNGU + (size_t)(i) * 11 * MiB, 5632, 1024, SO_INIT(5632), ws + BIG_H, FFN, 22, 0, H8_SCALE) PHASE_END \
    PHASE_BEGIN GEMM_PHASE8(FP8_DN, pg8::EpiPlain, pg8::StaticOrder, ws + BIG_H, ws + W_FFNDN + (size_t)(i) * 11 * MiB / 2, 1024, FFN / 2, SO_INIT(1024), AY, 1024, 4, 0) PHASE_END
#define DENSE_FFN(i) \
    PHASE_BEGIN GEMM_PHASE(pg8::EpiSwiGLU, pg8::StaticOrder, AY, ws + W_FFNGU + (size_t)(i) * 11 * MiB, 5632, 1024, SO_INIT(5632), (bf16*)(ws + BIG_H), FFN, 22, 0) PHASE_END \
    PHASE_BEGIN GEMM_PHASE(pg8::EpiPlain, pg8::StaticOrder, ws + BIG_H, ws + W_FFNDN + (size_t)(i) * 11 * MiB / 2, 1024, FFN, SO_INIT(1024), AY, 1024, 4, 0) PHASE_END
#define MOE_INIT(NCOL, T0, T1) { LAS int* tsl_ = (LAS int*)(ldsl + MISC_OFF + 64); int tsum_ = 0; \
        if (opaque_tid(WV) == 0) { tsl_[0] = 0; for (int e = 0; e < 8; ++e) { const unsigned c_ = __hip_atomic_load(ctl + CW_MOECNT + 16 * ml_ + e, RLX_AGENT); tsum_ += (int)((c_ + 255u) >> 8); tsl_[e + 1] = tsum_; } } \
        __syncthreads(); \
        S.ncol = NCOL; S.G = G; S.c = (int)blockIdx.x; S.tsl = tsl_; S.t0 = (T0); { const int t8_ = __builtin_amdgcn_readfirstlane(tsl_[8]); S.t1 = t8_ < (T1) ? t8_ : (T1); } }
#define MOE_FFN(ml) \
    PHASE_BEGIN moe_gather(ws, args.out, ml, G, WV); PHASE_END \
    { const int ml_ = (ml); \
        PHASE_BEGIN GEMM_PHASE8(FP8_GU, pg8::EpiSwiGLU8, pg8::MoeOrder, ws + BIG_BUF, ws + W_MOEGU + (size_t)(ml) * 56 * MiB, 7168, 512, MOE_INIT(28, 0, MOE_TILES_MAX), ws + BIG_MH, EDIM, 28, 0, H8_SCALE) PHASE_END \
        PHASE_BEGIN GEMM_PHASE8(FP8_DN, pg8::EpiPlain, pg8::MoeOrder, ws + BIG_MH, ws + W_MOEDN + (size_t)(ml) * 28 * MiB, 1024, EDIM / 2, MOE_INIT(4, 0, MOE_TILES_MAX), (bf16*)(ws + BIG_YE), 1024, 4, 0) PHASE_END }

    DA_INPROJ(0)
    DA_LAYER(0, 0.2f)
    PHASE_BEGIN resid_phase<1, false, false, (DENSE_FP8 & 1) != 0>(ws, args.out, nullptr, nullptr, ldsl, AY, 0, 0, 0, 1, 0, G, WV); PHASE_END
#if DENSE_FP8 & 1
    DENSE_FFN8(0)
#elif DENSE_H8 & 1
    DENSE_FFN_H8(0)
#else
    DENSE_FFN(0)
#endif
    PHASE_BEGIN resid_phase<1, false, false>(ws, args.out, nullptr, nullptr, ldsl, AY, 0, 1, 1, 0, 0, G, WV); PHASE_END

    PHASE_BEGIN ROPE2_LDS GEMM_PHASE(pg8::EpiRope2D, pg8::StaticOrder, AY, ws + W_WAIN, 1536, 1024, SO_INIT(1536), (bf16*)(ws + BIG_QKV), 1536, 5, r2cl, r2sl) PHASE_END
    PHASE_BEGIN { for (int L = blockIdx.x; L < 16 * 4 * 68; L += G) { const int bg = L / 68, blk = L - bg * 68;
            att::wa_unit((const bf16*)(ws + BIG_QKV), (bf16*)(ws + BIG_O), bg >> 2, bg & 3, blk, (const float*)(ws + WS_SMALL) + SM_SINK, (char*)lds + RING_OFF, WV); } } PHASE_END
    PHASE_BEGIN GEMM_PHASE(pg8::EpiPlain, pg8::StaticOrder, ws + BIG_O, ws + W_WAOUT, 1024, 1024, SO_INIT(1024), AY, 1024, 4, 0) PHASE_END
    PHASE_BEGIN resid_phase<1, true, false, true>(ws, args.out, nullptr, nullptr, ldsl, AY, 1, 0, 1, 1, 0, G, WV); PHASE_END
    MOE_FFN(0)
    PHASE_BEGIN resid_phase<2, false, false, (PROJ_FP8 & 1) != 0>(ws, args.out, nullptr, nullptr, ldsl, AY, 1, 1, 2, 0, 0, G, WV); PHASE_END

#if PROJ_FP8 & 1
    PHASE_BEGIN GEMM_PHASE8(FP8_GU, pg8::EpiRope1D, pg8::StaticOrder, (unsigned char*)args.out + A8_OFF, ws + W_RETIN, 6144, 512, SO_INIT(6144), (bf16*)(ws + BIG_RQ), 6144, 8, r1c, r1s) PHASE_END
#else
    PHASE_BEGIN GEMM_PHASE(pg8::EpiRope1D, pg8::StaticOrder, AY, ws + W_RETIN, 6144, 1024, SO_INIT(6144), (bf16*)(ws + BIG_RQ), 6144, 8, r1c, r1s) PHASE_END
#endif
    PHASE_BEGIN { for (int L = blockIdx.x; L < 256; L += G) ret::ret_unit2((const bf16*)(ws + BIG_RQ), (bf16*)(ws + BIG_RO), (bf16*)args.out, (bf16*)(ws + WS_OBC), (const float*)(ws + WS_SMALL) + SM_DECAY, L >> 4, (L >> 2) & 3, (L >> 1) & 1, L & 1, (char*)lds + RING_OFF, WV); } PHASE_END
    PHASE_BEGIN ret::ret_finish2((const bf16*)(ws + BIG_RQ), (bf16*)(ws + BIG_RO), (const bf16*)args.out, (const bf16*)(ws + WS_OBC), RETOUT_FP8 ? ws + WS_RO8 : nullptr, G, WV); PHASE_END
#if RETOUT_FP8
    PHASE_BEGIN GEMM_PHASE8(FP8_AO, pg8::EpiPlain, pg8::StaticOrder, ws + WS_RO8, ws + W_RETOUT, 1024, 1024, SO_INIT(1024), AY, 1024, 4, 0) PHASE_END
#else
    PHASE_BEGIN GEMM_PHASE(pg8::EpiPlain, pg8::StaticOrder, ws + BIG_RO, ws + W_RETOUT, 1024, 2048, SO_INIT(1024), AY, 1024, 4, 0) PHASE_END
#endif
    PHASE_BEGIN resid_phase<1, false, false, (DENSE_FP8 & 2) != 0>(ws, args.out, nullptr, nullptr, ldsl, AY, 2, 0, 2, 1, 0, G, WV); PHASE_END
#if DENSE_FP8 & 2
    DENSE_FFN8(1)
#else
    DENSE_FFN(1)
#endif
    PHASE_BEGIN resid_phase<1, false, false, (PROJ_FP8 & 4) != 0>(ws, args.out, nullptr, nullptr, ldsl, AY, 2, 1, 3, 0, 0, G, WV); PHASE_END

#if PROJ_FP8 & 4
    DA_INPROJ8(1)
#else
    DA_INPROJ(1)
#endif
    DA_LAYER(1, 0.55605820f)
    PHASE_BEGIN resid_phase<1, true, false, true, true>(ws, args.out, nullptr, nullptr, ldsl, AY, 3, 0, 3, 1, 1, G, WV); PHASE_END
    MOE_FFN(1)
    PHASE_BEGIN resid_phase<2, false, true>(ws, args.out, nullptr, nullptr, ldsl, AY, 3, 1, 3, 0, 1, G, WV); PHASE_END
#undef PHASE_BEGIN
#undef PHASE_END
}
constexpr int N_PHASES = 33;

extern "C" void kernel_launch(void* const* d_in, const int* in_sizes, int n_in, void* d_out, int out_size, void* d_ws, size_t ws_size, hipStream_t stream) {
    static int grid = 0;
    if (grid == 0) {
        if (n_in != 22 || in_sizes[0] != NBATCH * SEQL * DM || out_size != NBATCH * SEQL * DM || ws_size < WS_END) {
            fprintf(stderr, "kernel_launch: shape mismatch (n_in %d, in0 %d, out %d, ws %zu; need ws >= %zu); nothing launched\n", n_in, n_in > 0 ? in_sizes[0] : -1, out_size, ws_size, (size_t)WS_END); grid = -1; return; }
        int dev = 0, cus = 0, per_cu = 0;
        if (hipGetDevice(&dev) != hipSuccess || hipDeviceGetAttribute(&cus, hipDeviceAttributeMultiprocessorCount, dev) != hipSuccess) { fprintf(stderr, "kernel_launch: device query failed\n"); grid = -1; return; }
        if (hipFuncSetAttribute((const void*)hybrid_fwd, hipFuncAttributeMaxDynamicSharedMemorySize, LDS_BYTES) != hipSuccess) { fprintf(stderr, "kernel_launch: hipFuncSetAttribute failed\n"); grid = -1; return; }
        if (hipOccupancyMaxActiveBlocksPerMultiprocessor(&per_cu, (const void*)hybrid_fwd, NWAVES * 64, LDS_BYTES) != hipSuccess || per_cu < 1) {
            fprintf(stderr, "kernel_launch: occupancy query reports %d workgroups per CU\n", per_cu); }
        (void)hipGetLastError();
        if ((long)cus * NWAVES * 40 < (long)TA) { fprintf(stderr, "kernel_launch: %d CUs are too few for the routing phase's per-wave row table; nothing launched\n", cus); grid = -1; return; }
        grid = cus;
        if (grid != 256) fprintf(stderr, "kernel_launch: note: %d CUs (built and tuned for 256)\n", grid);
    }
    if (grid < 0) return;
    if (hipMemsetAsync((char*)d_ws + WS_CTL, 0, CTL_ZERO_BYTES, stream) != hipSuccess) { fprintf(stderr, "kernel_launch: memset failed\n"); return; }
    Args a{};
    for (int i = 0; i < 22; ++i) a.in[i] = (const float*)d_in[i];
    a.out = (float*)d_out; a.ws = (unsigned char*)d_ws;
#if MK_MULTI
    for (int p = 0; p < N_PHASES; ++p) { a.ph_lo = p; a.ph_hi = p + 1; hipLaunchKernelGGL(hybrid_fwd, dim3(grid), dim3(NWAVES * 64), LDS_BYTES, stream, a); }
#else
    a.ph_lo = 0; a.ph_hi = N_PHASES;
    hipLaunchKernelGGL(hybrid_fwd, dim3(grid), dim3(NWAVES * 64), LDS_BYTES, stream, a);
#endif
    const hipError_t le = hipPeekAtLastError();
    if (le != hipSuccess) fprintf(stderr, "kernel_launch: launch failed: %s\n", hipGetErrorName(le));
}
```

```cpp
#include <hip/hip_runtime.h>
#include <cstdio>
#include <cstdint>

#ifndef DBG
#define DBG 0
#endif
#ifndef PG8_RELAX
#define PG8_RELAX 1
#endif
#ifndef PG8_ASM_DMA
#define PG8_ASM_DMA 1
#endif
#ifndef MK_MULTI
#define MK_MULTI 0
#endif

__device__ __forceinline__ int opaque_tid(int wv) { int l; asm volatile("v_mbcnt_lo_u32_b32 %0, -1, 0\n\tv_mbcnt_hi_u32_b32 %0, -1, %0" : "=v"(l)); return (wv << 6) | l; }
namespace pg8 {
#define PG8_LAS __attribute__((address_space(3)))
typedef unsigned short bf16_t;
typedef short bf16x8 __attribute__((ext_vector_type(8)));
typedef float f32x4 __attribute__((ext_vector_type(4)));
typedef unsigned u32x4 __attribute__((ext_vector_type(4)));
constexpr int BM = 256, BK = 64, HALF = 128, HTB = HALF * BK * 2  , STAGE_BYTES = 8 * HTB, NXCD = 8, WGM = 4;

__host__ __device__ __forceinline__ int lds_byte(int r, int c) { const int st = (r >> 4) * 2 + (c >> 5), rr = r & 15, cc = c & 31, ob = rr * 64 + cc * 2; return st * 1024 + (ob ^ (((ob >> 9) & 1) << 5)); }
__host__ __device__ __forceinline__ void stage_rc(int b, int& R, int& C) { const int st = b / 1024, sb = b % 1024, swz = sb ^ (((sb >> 9) & 1) << 5); R = (st >> 1) * 16 + swz / 64; C = (st & 1) * 32 + (swz % 64) / 2; }
__host__ __device__ __forceinline__ int perm32(int rho) { const int n = rho >> 4, i = rho & 15; return 8 * (i >> 2) + 4 * n + (i & 3); }

struct Unit { int pm, pn; };
struct Gemm { const bf16_t* A; const bf16_t* Bt; int M, N, K; };

struct StaticOrder {
    int nM, nN, nwg, G, c;
    __host__ __device__ void init(int M, int N, int G_, int c_) { nM = M / BM; nN = N / BM; nwg = nM * nN; G = G_; c = c_; }
    __host__ __device__ bool next(int i, Unit& u) const {
        const long L = (long)i * G + c; if (L >= nwg) return false;
        int wgid = (int)L; { const int q = nwg / NXCD, r = nwg % NXCD, xcd = wgid % NXCD, off = wgid / NXCD; wgid = (xcd < r ? xcd * (q + 1) : r * (q + 1) + (xcd - r) * q) + off; }
        const int nig = WGM * nN, gid = wgid / nig, rem = wgid - gid * nig, fm = gid * WGM, gsz = (nM - fm) < WGM ? (nM - fm) : WGM;
        static_assert(WGM == 4, "the full-group case below shifts by log2(WGM)");
        if (gsz == WGM) { u.pm = fm + (rem & (WGM - 1)); u.pn = rem >> 2; } else { u.pm = fm + (rem % gsz); u.pn = rem / gsz; }
        return true;
    }
    __device__ __forceinline__ void a_ready(const Unit&) const {}
    __device__ __forceinline__ void done(const Unit&) const {}
};

struct StaticOrderLat : StaticOrder {
    __host__ __device__ bool next(int i, Unit& u) const { if (!StaticOrder::next(i, u)) return false; u.pm = (u.pm >> 4) * 17 + 1 + (u.pm & 15); return true; }
};

typedef int v8i __attribute__((ext_vector_type(8)));
typedef float f32x8 __attribute__((ext_vector_type(8)));
typedef int v4i_ __attribute__((ext_vector_type(4)));
__device__ __forceinline__ v8i cat8(bf16x8 lo, bf16x8 hi) { const v4i_ a = __builtin_bit_cast(v4i_, lo), b = __builtin_bit_cast(v4i_, hi); return __builtin_shufflevector(a, b, 0, 1, 2, 3, 4, 5, 6, 7); }
__device__ __forceinline__ bf16x8 lo8(v8i v) { return __builtin_bit_cast(bf16x8, __builtin_shufflevector(v, v, 0, 1, 2, 3)); }
__device__ __forceinline__ bf16x8 hi8(v8i v) { return __builtin_bit_cast(bf16x8, __builtin_shufflevector(v, v, 4, 5, 6, 7)); }
__device__ __forceinline__ unsigned cvt_pk_bf16(float lo, float hi) { unsigned r; asm volatile("v_cvt_pk_bf16_f32 %0, %1, %2" : "=v"(r) : "v"(lo), "v"(hi)); return r; }

#ifndef EPI_NT
#define EPI_NT 0
#endif
#if EPI_NT
#define EPI_ST(p, v) __builtin_nontemporal_store((v), (p))
#else
#define EPI_ST(p, v) (*(p) = (v))
#endif
__device__ __forceinline__ u32x4 pack8(const f32x4 a, const f32x4 b) { u32x4 w; w.x = cvt_pk_bf16(a[0], a[1]); w.y = cvt_pk_bf16(a[2], a[3]); w.z = cvt_pk_bf16(b[0], b[1]); w.w = cvt_pk_bf16(b[2], b[3]); return w; }

struct EpiPlain {
    static constexpr bool PERM = true, AFTER_DRAIN = false; static constexpr int NSTORE = 16;
    bf16_t* O; int ldc; int pn_mod; int pm_off; int mode;
    __device__ __forceinline__ void operator()(const f32x4 (&acc)[2][2][4][2], const Unit& u, int wr, int wc, int fr, int fq) const {
        if (mode == 1) return;
        const int row0 = (u.pm + pm_off) * BM + wr * 64 + fr, col0 = (u.pn % pn_mod) * BM + wc * 32 + 8 * fq;
#pragma unroll
        for (int ai = 0; ai < 2; ++ai)
#pragma unroll
            for (int m = 0; m < 4; ++m) { bf16_t* rowp = O + (size_t)(row0 + ai * HALF + m * 16) * ldc + col0;
#pragma unroll
                for (int bj = 0; bj < 2; ++bj) { const u32x4 w_ = pack8(acc[ai][bj][m][0], acc[ai][bj][m][1]); if (mode == 0 || w_.x == 0x7fc12345u) EPI_ST((u32x4*)(rowp + bj * HALF), w_); } }
    }
};
struct EpiRope2D {
    static constexpr bool PERM = true, AFTER_DRAIN = false; static constexpr int NSTORE = 16;
    bf16_t* O; int ldc; int rope_tiles; const PG8_LAS float* tabc; const PG8_LAS float* tabs; int mode;
    __device__ __forceinline__ void operator()(const f32x4 (&acc)[2][2][4][2], const Unit& u, int wr, int wc, int fr, int fq) const {
        const int row0 = u.pm * BM + wr * 64 + fr, col0 = u.pn * BM + wc * 32 + 8 * fq;
        const int pt = u.pm % 17; const bool rope = (u.pn < rope_tiles) && (pt != 0);
        const int pos0 = (pt - 1) * 256 + wr * 64 + fr;
#pragma unroll
        for (int ai = 0; ai < 2; ++ai)
#pragma unroll
            for (int m = 0; m < 4; ++m) { bf16_t* rowp = O + (size_t)(row0 + ai * HALF + m * 16) * ldc + col0;
                f32x4 cs = (f32x4){1.f, 1.f, 1.f, 1.f}, sn = (f32x4){0.f, 0.f, 0.f, 0.f};
                if (rope) { const int pos = pos0 + ai * HALF + m * 16; const int pidx = (wc & 1) ? (pos & 63) : (pos >> 6);
                    cs = *(const PG8_LAS f32x4*)(tabc + pidx * 16 + 4 * fq); sn = *(const PG8_LAS f32x4*)(tabs + pidx * 16 + 4 * fq); }
#pragma unroll
                for (int bj = 0; bj < 2; ++bj) { const f32x4 x0 = acc[ai][bj][m][0], x1 = acc[ai][bj][m][1];
                    const f32x4 y0 = x0 * cs - x1 * sn, y1 = x1 * cs + x0 * sn;
                    EPI_ST((u32x4*)(rowp + bj * HALF), pack8(y0, y1)); } }
    }
};
struct EpiRope1D {
    static constexpr bool PERM = true, AFTER_DRAIN = false; static constexpr int NSTORE = 16;
    bf16_t* O; int ldc; int rope_tiles; const float* tabc; const float* tabs; int mode;
    __device__ __forceinline__ void operator()(const f32x4 (&acc)[2][2][4][2], const Unit& u, int wr, int wc, int fr, int fq) const {
        const int row0 = u.pm * BM + wr * 64 + fr, col0 = u.pn * BM + wc * 32 + 8 * fq;
        const int pt = u.pm % 17; const bool rope = (u.pn < rope_tiles) && (pt != 0);
        const int pos0 = (pt - 1) * 256 + wr * 64 + fr;
#pragma unroll
        for (int ai = 0; ai < 2; ++ai)
#pragma unroll
            for (int m = 0; m < 4; ++m) { bf16_t* rowp = O + (size_t)(row0 + ai * HALF + m * 16) * ldc + col0;
                f32x4 y0[2], y1[2];
#pragma unroll
                for (int n = 0; n < 2; ++n) { const f32x4 x0 = acc[ai][0][m][n], x1 = acc[ai][1][m][n];
                    if (rope) { const int pos = pos0 + ai * HALF + m * 16; const int i0 = wc * 32 + 8 * fq + 4 * n;
                        const f32x4 cs = *(const f32x4*)(tabc + (size_t)pos * 128 + i0), sn = *(const f32x4*)(tabs + (size_t)pos * 128 + i0);
                        y0[n] = x0 * cs - x1 * sn; y1[n] = x1 * cs + x0 * sn; }
                    else { y0[n] = x0; y1[n] = x1; } }
                EPI_ST((u32x4*)(rowp), pack8(y0[0], y0[1])); EPI_ST((u32x4*)(rowp + HALF), pack8(y1[0], y1[1])); }
    }
};
__device__ __forceinline__ float silu_f(float t) { return t * __builtin_amdgcn_rcpf(1.f + __builtin_amdgcn_exp2f(-t)); }
struct EpiSwiGLU {
    static constexpr bool PERM = true, AFTER_DRAIN = false; static constexpr int NSTORE = 8;
    bf16_t* O; int ldc; int pn_mod; int pm_off; int mode;
    __device__ __forceinline__ void operator()(const f32x4 (&acc)[2][2][4][2], const Unit& u, int wr, int wc, int fr, int fq) const {
        if (mode == 1) return;
        const int row0 = (u.pm + pm_off) * BM + wr * 64 + fr, col0 = (u.pn % pn_mod) * HALF + wc * 32 + 8 * fq;
        if (mode == 3) { f32x4 s_ = (f32x4){0.f, 0.f, 0.f, 0.f};
#pragma unroll
            for (int ai = 0; ai < 2; ++ai)
#pragma unroll
                for (int bj = 0; bj < 2; ++bj)
#pragma unroll
                    for (int m = 0; m < 4; ++m) { s_ += acc[ai][bj][m][0]; s_ += acc[ai][bj][m][1]; }
            if (s_[0] + s_[1] + s_[2] + s_[3] == 1.2345e-30f) O[(size_t)row0 * ldc + col0] = 1; return; }
#pragma unroll
        for (int ai = 0; ai < 2; ++ai)
#pragma unroll
            for (int m = 0; m < 4; ++m) { bf16_t* rowp = O + (size_t)(row0 + ai * HALF + m * 16) * ldc + col0;
                f32x4 h[2];
#pragma unroll
                for (int n = 0; n < 2; ++n) { const f32x4 g = acc[ai][0][m][n], uu = acc[ai][1][m][n];
                    h[n] = (f32x4){silu_f(g[0]) * uu[0], silu_f(g[1]) * uu[1], silu_f(g[2]) * uu[2], silu_f(g[3]) * uu[3]}; }
                { const u32x4 w_ = pack8(h[0], h[1]); if (mode == 0 || w_.x == 0x7fc12345u) EPI_ST((u32x4*)(rowp), w_); } }
    }
};

__device__ __forceinline__ unsigned pack4_fp8(float a, float b, float c, float d) {
    a = __builtin_fminf(__builtin_fmaxf(a, -448.f), 448.f); b = __builtin_fminf(__builtin_fmaxf(b, -448.f), 448.f); c = __builtin_fminf(__builtin_fmaxf(c, -448.f), 448.f); d = __builtin_fminf(__builtin_fmaxf(d, -448.f), 448.f);
    int w = 0; w = __builtin_amdgcn_cvt_pk_fp8_f32(a, b, w, false); w = __builtin_amdgcn_cvt_pk_fp8_f32(c, d, w, true); return (unsigned)w; }
typedef unsigned u32x2 __attribute__((ext_vector_type(2)));
struct EpiSwiGLU8 {
    static constexpr bool PERM = true, AFTER_DRAIN = false; static constexpr int NSTORE = 8;
    unsigned char* O; int ldc; int pn_mod; int pm_off; float oscale; int mode;
    __device__ __forceinline__ void operator()(const f32x4 (&acc)[2][2][4][2], const Unit& u, int wr, int wc, int fr, int fq) const {
        const int row0 = (u.pm + pm_off) * BM + wr * 64 + fr, col0 = (u.pn % pn_mod) * HALF + wc * 32 + 8 * fq;
#pragma unroll
        for (int ai = 0; ai < 2; ++ai)
#pragma unroll
            for (int m = 0; m < 4; ++m) { unsigned char* rowp = O + (size_t)(row0 + ai * HALF + m * 16) * ldc + col0;
                u32x2 w;
#pragma unroll
                for (int n = 0; n < 2; ++n) { const f32x4 g = acc[ai][0][m][n], uu = acc[ai][1][m][n];
                    const unsigned p = pack4_fp8(silu_f(g[0]) * uu[0], silu_f(g[1]) * uu[1], silu_f(g[2]) * uu[2], silu_f(g[3]) * uu[3]);
                    if (n == 0) w.x = p; else w.y = p; }
                EPI_ST((u32x2*)(rowp), w); }
    }
};
struct MoeOrder {
    int t0, t1, ncol, G, c; const PG8_LAS int* tsl;
    __device__ __forceinline__ bool next(int i, Unit& u) const {
        const unsigned L = (unsigned)i * (unsigned)G + (unsigned)c; const int nt = t1 - t0; if (L >= (unsigned)nt * (unsigned)ncol) return false;
        const unsigned nig = 8u * (unsigned)ncol, gid = L / nig, rem = L - gid * nig; const int fm = (int)gid * 8, gsz = (nt - fm) < 8 ? (nt - fm) : 8;
        const int t = t0 + fm + (gsz == 8 ? (int)(rem & 7u) : (int)(rem % (unsigned)gsz)), j = (gsz == 8) ? (int)(rem >> 3) : (int)(rem / (unsigned)gsz);
        int e = 0;
#pragma unroll
        for (int k = 1; k < 8; ++k) e += (t >= tsl[k]) ? 1 : 0;
        u.pm = t; u.pn = e * ncol + j; return true;
    }
    __device__ __forceinline__ void a_ready(const Unit&) const {}
    __device__ __forceinline__ void done(const Unit&) const {}
};
template <class Epi, class Sched, bool ALIGN_EPI = false, bool SP2 = false, int FP8 = 0  >
__device__ __forceinline__ void gemm_phase(PG8_LAS unsigned char* lds, const Gemm g, const Sched& S, const Epi& E, const int wv) {
    const int tid = opaque_tid(wv), wid = __builtin_amdgcn_readfirstlane(tid >> 6), lane = tid & 63, wr = wid >> 2, wc = wid & 3, fr = lane & 15, fq = lane >> 4;
    const int K = g.K, nt = K / BK;
    constexpr bool RELAX_ST = ALIGN_EPI && SP2 && !Epi::AFTER_DRAIN && (PG8_RELAX != 0);
    unsigned voffA[2], voffB[2];
#pragma unroll
    for (int i = 0; i < 2; ++i) { int R, C; stage_rc(tid * 16 + i * 8192, R, C); const int Rb = Epi::PERM ? ((R & ~31) + perm32(R & 31)) : R;
        voffA[i] = (unsigned)(R * K + C) * 2u; voffB[i] = (unsigned)(Rb * K + C) * 2u; }
    const size_t kstep = (size_t)(BK * 2);
    const size_t hstep = (size_t)HALF * K * 2;
    const size_t tstep = 2 * hstep;
    const unsigned ldsw = (unsigned)wid * 1024u; const unsigned ldsbase = (unsigned)(size_t)lds;
    const int aoff = lds_byte(wr * 64 + fr, fq * 8), boff = lds_byte(wc * 32 + fr, fq * 8);
#define PG8_SA(b, h) (((b) * 2 + (h)) * HTB)
#define PG8_SB(b, h) ((4 + (b) * 2 + (h)) * HTB)
#define PG8_STAGE(bufoff, gbase, voff) do { _Pragma("unroll") for (int _i = 0; _i < 2; ++_i) { \
        if constexpr (FP8 == 0 && !PG8_ASM_DMA) __builtin_amdgcn_global_load_lds((const unsigned*)((const char*)(gbase) + (voff)[_i]), (PG8_LAS unsigned*)(lds + (bufoff) + ldsw + _i * 8192), 16, 0, 0); \
        else { unsigned keep_; asm volatile("s_mov_b32 %0, m0\n\ts_mov_b32 m0, %3\n\ts_nop 0\n\tglobal_load_lds_dwordx4 %1, %2\n\ts_mov_b32 m0, %0" : "=&s"(keep_) : "v"((voff)[_i]), "s"((const char*)(gbase)), "s"((unsigned)__builtin_amdgcn_readfirstlane((int)(ldsbase + (unsigned)(bufoff) + ldsw + _i * 8192))) : "memory"); } } } while (0)
#define PG8_LDA(dst, b, h) do { _Pragma("unroll") for (int m = 0; m < 4; ++m) { const bf16x8 f0_ = *(const PG8_LAS bf16x8*)(lds + PG8_SA(b, h) + aoff + m * 2048), f1_ = *(const PG8_LAS bf16x8*)(lds + PG8_SA(b, h) + aoff + m * 2048 + 1024); dst[m] = cat8(f0_, f1_); } } while (0)
#define PG8_LDB(dst, b, h) do { _Pragma("unroll") for (int n = 0; n < 2; ++n) { const bf16x8 f0_ = *(const PG8_LAS bf16x8*)(lds + PG8_SB(b, h) + boff + n * 2048), f1_ = *(const PG8_LAS bf16x8*)(lds + PG8_SB(b, h) + boff + n * 2048 + 1024); dst[n] = cat8(f0_, f1_); } } while (0)
#define PG8_MMA(ai, bj, At, Bt) do { __builtin_amdgcn_s_setprio(1); \
        if constexpr (FP8 == 0) { _Pragma("unroll") for (int m = 0; m < 4; ++m) _Pragma("unroll") for (int n = 0; n < 2; ++n) { \
            acc[ai][bj][m][n] = __builtin_amdgcn_mfma_f32_16x16x32_bf16(lo8(Bt[n]), lo8(At[m]), acc[ai][bj][m][n], 0, 0, 0); \
            acc[ai][bj][m][n] = __builtin_amdgcn_mfma_f32_16x16x32_bf16(hi8(Bt[n]), hi8(At[m]), acc[ai][bj][m][n], 0, 0, 0); } } \
        else { \
            _Pragma("unroll") for (int m = 0; m < 4; ++m) _Pragma("unroll") for (int n = 0; n < 2; ++n) \
            asm volatile("v_mfma_scale_f32_16x16x128_f8f6f4 %0, %1, %2, %0, %3, %4 op_sel_hi:[0,0,0]" : "+v"(acc[ai][bj][m][n]) : "v"(Bt[n]), "v"(At[m]), "v"(scb_), "v"(sca_)); } \
        __builtin_amdgcn_s_setprio(0); } while (0)
#define PG8_MMA0(ai, bj, At, Bt) do { __builtin_amdgcn_s_setprio(1); \
        if constexpr (FP8 == 0) { _Pragma("unroll") for (int m = 0; m < 4; ++m) _Pragma("unroll") for (int n = 0; n < 2; ++n) { \
            acc[ai][bj][m][n] = __builtin_amdgcn_mfma_f32_16x16x32_bf16(lo8(Bt[n]), lo8(At[m]), (f32x4){0.f, 0.f, 0.f, 0.f}, 0, 0, 0); \
            acc[ai][bj][m][n] = __builtin_amdgcn_mfma_f32_16x16x32_bf16(hi8(Bt[n]), hi8(At[m]), acc[ai][bj][m][n], 0, 0, 0); } } \
        else { \
            _Pragma("unroll") for (int m = 0; m < 4; ++m) _Pragma("unroll") for (int n = 0; n < 2; ++n) \
            asm volatile("v_mfma_scale_f32_16x16x128_f8f6f4 %0, %1, %2, 0, %3, %4 op_sel_hi:[0,0,0]" : "+v"(acc[ai][bj][m][n]) : "v"(Bt[n]), "v"(At[m]), "v"(scb_), "v"(sca_)); }   \
        __builtin_amdgcn_s_setprio(0); } while (0)
#define PG8_MMAX(first, ai, bj, At, Bt) do { if (first) PG8_MMA0(ai, bj, At, Bt); else PG8_MMA(ai, bj, At, Bt); } while (0)
#define PG8_WAIT_V(n) asm volatile("s_waitcnt vmcnt(" #n ")" ::: "memory")
#define PG8_WAIT_L(n) asm volatile("s_waitcnt lgkmcnt(" #n ")" ::: "memory")
#define PG8_WAIT_VX(rx) do { if (rx) asm volatile("s_waitcnt vmcnt(%0)" :: "n"(8 + Epi::NSTORE) : "memory"); else PG8_WAIT_V(8); } while (0)
#define PG8_BAR __builtin_amdgcn_s_barrier()
#define PG8_SCHED __builtin_amdgcn_sched_barrier(0)
    Unit cur, nxt; int ui = 0;
    PG8_LAS unsigned* utab = (PG8_LAS unsigned*)(lds + STAGE_BYTES + 1024);
    if (tid < 64) { Unit u_; utab[tid] = S.next(tid, u_) ? ((unsigned)u_.pm | ((unsigned)u_.pn << 16)) : 0xffffffffu; }
    __syncthreads();
#define PG8_NEXT(i, u, ok) do { const int i_ = (i); if (i_ < 64) { const unsigned v_ = (unsigned)__builtin_amdgcn_readfirstlane((int)utab[i_]); ok = (v_ != 0xffffffffu); u.pm = (int)(v_ & 0xffffu); u.pn = (int)(v_ >> 16); } else ok = S.next(i_, u); } while (0)
    { bool ok0_; PG8_NEXT(0, cur, ok0_); if (!ok0_) return; }
    f32x4 acc[2][2][4][2];
    const int sca_ = (FP8 & 0xff) * 0x01010101, scb_ = ((FP8 >> 8) & 0xff) * 0x01010101;
    {
#pragma unroll
    for (int a = 0; a < 2; ++a)
#pragma unroll
        for (int b = 0; b < 2; ++b)
#pragma unroll
            for (int m = 0; m < 4; ++m)
#pragma unroll
                for (int n = 0; n < 2; ++n) acc[a][b][m][n] = (f32x4){0.f, 0.f, 0.f, 0.f};
    }
    v8i At[4], B0[2], B1[2];
    const char* cA = (const char*)g.A + (size_t)cur.pm * tstep; const char* cB = (const char*)g.Bt + (size_t)cur.pn * tstep;
    S.a_ready(cur);
    if constexpr (SP2) {
        PG8_STAGE(PG8_SB(0, 0), cB, voffB); PG8_STAGE(PG8_SB(0, 1), cB + hstep, voffB); PG8_STAGE(PG8_SA(0, 0), cA, voffA); PG8_STAGE(PG8_SA(0, 1), cA + hstep, voffA);
        if (wr == 1) PG8_BAR;
        PG8_WAIT_V(2); PG8_BAR;
        PG8_STAGE(PG8_SB(1, 0), cB + kstep, voffB); PG8_STAGE(PG8_SA(1, 0), cA + kstep, voffA); PG8_STAGE(PG8_SB(1, 1), cB + hstep + kstep, voffB);
        PG8_WAIT_V(6); PG8_BAR;
    } else {
        PG8_STAGE(PG8_SB(0, 0), cB, voffB); PG8_STAGE(PG8_SA(0, 0), cA, voffA); PG8_STAGE(PG8_SB(0, 1), cB + hstep, voffB); PG8_STAGE(PG8_SA(0, 1), cA + hstep, voffA);
        if (wr == 1) PG8_BAR;
        PG8_WAIT_V(4); PG8_BAR;
        PG8_STAGE(PG8_SB(1, 0), cB + kstep, voffB); PG8_STAGE(PG8_SA(1, 0), cA + kstep, voffA); PG8_STAGE(PG8_SB(1, 1), cB + hstep + kstep, voffB);
        PG8_WAIT_V(6); PG8_BAR;
    }
    for (;;) {
        bool has_next; PG8_NEXT(ui + 1, nxt, has_next);
        const char* nA = has_next ? (const char*)g.A + (size_t)nxt.pm * tstep : cA; const char* nB = has_next ? (const char*)g.Bt + (size_t)nxt.pn * tstep : cB;
        for (int t = 0; t < nt; t += 2) {
            const bool last = (t == nt - 2);
            const char* a1 = cA + (size_t)(t + 1) * kstep;
            const char* a2 = last ? nA : cA + (size_t)(t + 2) * kstep; const char* b2 = last ? nB : cB + (size_t)(t + 2) * kstep;
            const char* a3 = a2 + kstep; const char* b3 = b2 + kstep;
            if (last && has_next) S.a_ready(nxt);
            if constexpr (SP2) {
            const bool relax = RELAX_ST && (t == 0) && (ui > 0);
            const bool first0 = SP2 && (t == 0);
            PG8_LDB(B0, 0, 0); PG8_LDB(B1, 0, 1); PG8_SCHED; PG8_LDA(At, 0, 0); if (!relax) PG8_STAGE(PG8_SA(1, 1), a1 + hstep, voffA);
            PG8_WAIT_VX(relax); PG8_WAIT_L(0); PG8_BAR; PG8_MMAX(first0, 0, 0, At, B0); PG8_MMAX(first0, 0, 1, At, B1); PG8_BAR; PG8_SCHED;
            PG8_LDA(At, 0, 1); PG8_STAGE(PG8_SB(0, 0), b2, voffB); PG8_STAGE(PG8_SB(0, 1), b2 + hstep, voffB); PG8_STAGE(PG8_SA(0, 0), a2, voffA);
            PG8_WAIT_VX(relax); PG8_WAIT_L(0); PG8_BAR; PG8_MMAX(first0, 1, 0, At, B0); PG8_MMAX(first0, 1, 1, At, B1); PG8_BAR; PG8_SCHED;
            PG8_LDB(B0, 1, 0); PG8_LDB(B1, 1, 1); PG8_SCHED; PG8_LDA(At, 1, 0); PG8_STAGE(PG8_SA(0, 1), a2 + hstep, voffA);
            PG8_WAIT_VX(relax); PG8_WAIT_L(0); PG8_BAR; PG8_MMA(0, 0, At, B0); PG8_MMA(0, 1, At, B1); PG8_BAR; PG8_SCHED;
            PG8_LDA(At, 1, 1); PG8_STAGE(PG8_SB(1, 0), b3, voffB); PG8_STAGE(PG8_SB(1, 1), b3 + hstep, voffB); PG8_STAGE(PG8_SA(1, 0), a3, voffA);
            PG8_WAIT_V(8); PG8_WAIT_L(0); PG8_BAR; PG8_MMA(1, 0, At, B0); PG8_MMA(1, 1, At, B1); PG8_BAR; PG8_SCHED;
            } else {
            PG8_LDB(B0, 0, 0); PG8_SCHED; PG8_LDA(At, 0, 0); PG8_STAGE(PG8_SA(1, 1), a1 + hstep, voffA);
            PG8_WAIT_L(8); PG8_BAR; PG8_WAIT_L(0); PG8_MMA(0, 0, At, B0); PG8_BAR; PG8_SCHED;
            PG8_LDB(B1, 0, 1); PG8_STAGE(PG8_SB(0, 0), b2, voffB);
            PG8_BAR; PG8_WAIT_L(0); PG8_MMA(0, 1, At, B1); PG8_BAR;
            PG8_LDA(At, 0, 1); PG8_STAGE(PG8_SA(0, 0), a2, voffA);
            PG8_BAR; PG8_WAIT_L(0); PG8_MMA(1, 0, At, B0); PG8_BAR; PG8_SCHED;
            PG8_STAGE(PG8_SB(0, 1), b2 + hstep, voffB);
            PG8_WAIT_V(6); PG8_BAR; PG8_MMA(1, 1, At, B1); PG8_BAR;
            PG8_LDB(B0, 1, 0); PG8_SCHED; PG8_LDA(At, 1, 0); PG8_STAGE(PG8_SA(0, 1), a2 + hstep, voffA);
            PG8_WAIT_L(8); PG8_BAR; PG8_WAIT_L(0); PG8_MMA(0, 0, At, B0); PG8_BAR; PG8_SCHED;
            PG8_LDB(B1, 1, 1); PG8_STAGE(PG8_SB(1, 0), b3, voffB);
            PG8_BAR; PG8_WAIT_L(0); PG8_MMA(0, 1, At, B1); PG8_BAR;
            PG8_LDA(At, 1, 1); PG8_STAGE(PG8_SA(1, 0), a3, voffA);
            PG8_BAR; PG8_WAIT_L(0); PG8_MMA(1, 0, At, B0); PG8_BAR; PG8_SCHED;
            PG8_STAGE(PG8_SB(1, 1), b3 + hstep, voffB);
            PG8_WAIT_V(6); PG8_BAR; PG8_MMA(1, 1, At, B1); PG8_BAR;
            }
        }
        if constexpr (ALIGN_EPI) { if (wr == 0) PG8_BAR; }
        if constexpr (RELAX_ST) { if (has_next) PG8_STAGE(PG8_SA(1, 1), nA + kstep + hstep, voffA); }
        if constexpr (FP8 != 0) asm volatile("s_nop 15\n\ts_nop 15\n\ts_nop 7" ::: "memory");
        if constexpr (!Epi::AFTER_DRAIN) { int tide_ = tid; asm volatile("" : "+v"(tide_)); const int le_ = tide_ & 63;
            E(acc, cur, wr, wc, le_ & 15, le_ >> 4); S.done(cur); }
        if (!has_next) break;
        if constexpr (!SP2) {
#pragma unroll
        for (int a = 0; a < 2; ++a)
#pragma unroll
            for (int b = 0; b < 2; ++b)
#pragma unroll
                for (int m = 0; m < 4; ++m)
#pragma unroll
                    for (int n = 0; n < 2; ++n) acc[a][b][m][n] = (f32x4){0.f, 0.f, 0.f, 0.f};
        }
        cur = nxt; cA = nA; cB = nB; ++ui;
        if constexpr (ALIGN_EPI) { if (wr == 1) PG8_BAR; }
    }
    PG8_WAIT_V(0);
    if constexpr (!ALIGN_EPI) { if (wr == 0) PG8_BAR; }
    PG8_BAR;
    if constexpr (Epi::AFTER_DRAIN) { E.fused(acc, cur, wr, wc, fr, fq, lds, wid, lane); S.done(cur); }
#undef PG8_SA
#undef PG8_SB
#undef PG8_STAGE
#undef PG8_LDA
#undef PG8_LDB
#undef PG8_MMA
#undef PG8_MMA0
#undef PG8_MMAX
#undef PG8_NEXT
#undef PG8_WAIT_V
#undef PG8_WAIT_L
#undef PG8_WAIT_VX
#undef PG8_BAR
#undef PG8_SCHED
}
}

constexpr int DM = 1024, NBATCH = 16, SEQL = 4096, CTXL = 256, RPB = SEQL + CTXL  , TA = NBATCH * RPB  ;
constexpr int FFN = 2816, NEXP = 8, EDIM = 3584, NWAVES = 8;
constexpr float NORM_EPS = 1e-6f;
constexpr float LOG2E_F = 1.4426950408889634f;
constexpr float QSCALE = 0.125f * 1.4426950408889634f;
constexpr int MOE_TILES_MAX = 552, MOE_PASS_TILES = 276;

constexpr size_t MiB = 1u << 20;
constexpr size_t WS_CTL = 0, CTL_ZERO_BYTES = 1 * MiB;
constexpr size_t WS_MODV = 1 * MiB;
constexpr size_t WS_ROPE2 = 3 * MiB;
constexpr size_t WS_SCAL = 3 * MiB + 64 * 1024;
constexpr size_t WS_ROUTW = 3 * MiB + 128 * 1024;
constexpr size_t WS_SMALL = 3 * MiB + 256 * 1024;
constexpr int SM_NORMG = 0, SM_SUBLN = 16384, SM_SINK = 16384 + 256, SM_DECAY = 16384 + 256 + 16;
constexpr size_t WS_ROPE1 = 4 * MiB;
constexpr size_t WS_TOKINFO = 8 * MiB;
constexpr size_t WS_LISTS = 10 * MiB;
constexpr size_t WS_W = 16 * MiB;
constexpr size_t W_DAIN = WS_W, W_DAOUT = W_DAIN + 12 * MiB, W_WAIN = W_DAOUT + 4 * MiB, W_WAOUT = W_WAIN + 3 * MiB, W_RETIN = W_WAOUT + 2 * MiB, W_RETOUT = W_RETIN + 12 * MiB,
                 W_FFNGU = W_RETOUT + 4 * MiB, W_FFNDN = W_FFNGU + 22 * MiB, W_MOEGU = W_FFNDN + 11 * MiB, W_MOEDN = W_MOEGU + 224 * MiB, W_END = W_MOEDN + 112 * MiB;
constexpr size_t WS_X = 424 * MiB;
constexpr size_t WS_RO8 = 560 * MiB;
constexpr size_t WS_BIG = 696 * MiB;
constexpr size_t WS_END = 1792 * MiB;
static_assert(W_END <= WS_X && WS_X + (size_t)TA * DM * 2 <= WS_RO8 && WS_RO8 + (size_t)TA * 2048 <= WS_BIG, "ws map");
constexpr size_t BIG_QKV = WS_BIG, BIG_O = WS_BIG + 408 * MiB;
constexpr size_t BIG_RQ = WS_BIG, BIG_RO = WS_BIG + 816 * MiB;
constexpr size_t BIG_H = WS_BIG;
constexpr size_t BIG_BUF = WS_BIG, BIG_YE = WS_BIG + 138 * MiB, BIG_MH = WS_BIG + 414 * MiB;
static_assert(BIG_RO + (size_t)TA * 2048 * 2 <= WS_END && BIG_MH + (size_t)MOE_TILES_MAX * 256 * EDIM <= WS_END, "ws map (big)");
#ifndef DENSE_FP8
#define DENSE_FP8 2
#endif
#ifndef DENSE_H8
#define DENSE_H8 1
#endif
#ifndef RETOUT_FP8
#define RETOUT_FP8 1
#endif
#ifndef RESID_NR
#define RESID_NR 3
#endif
#ifndef PROJ_FP8
#define PROJ_FP8 5
#endif
constexpr size_t A8_OFF = 136 * MiB;
constexpr float A8_SCALE = 8.f, H8_SCALE = 4.f, WGU8_SCALE = 32.f, WDN8_SCALE = 64.f;
constexpr int FP8_GU = ((127 - 5) << 8) | (127 - 3), FP8_DN = ((127 - 6) << 8) | (127 - 2), FP8_AO = ((127 - 6) << 8) | (127 - 3);

constexpr size_t WS_OBC = 200 * MiB;
static_assert(WS_OBC >= W_MOEGU + 112 * MiB && WS_OBC + (size_t)NBATCH * CTXL * 2048 * 2 <= W_MOEDN, "OBC placement");
constexpr int CW_TMO = 0, CW_CODE = 1, CW_DBG = 2;
constexpr int CW_MOECNT = 64;
constexpr int CW_WQ = 128;
constexpr int CW_BAR = 4096;

constexpr int RING_OFF = 0, RING_BYTES = 131072;
constexpr int LDSCTL_OFF = RING_BYTES, MISC_OFF = LDSCTL_OFF + 320;
constexpr int ROPE2_LDS_OFF = LDSCTL_OFF + 2048;
constexpr int LDS_BYTES = 147456;

#define GAS __attribute__((address_space(1)))
#define LAS __attribute__((address_space(3)))
typedef unsigned short bf16;
typedef unsigned v4u __attribute__((ext_vector_type(4)));
typedef unsigned v2u __attribute__((ext_vector_type(2)));
typedef float f32x4 __attribute__((ext_vector_type(4)));
typedef float f32x2 __attribute__((ext_vector_type(2)));
typedef short bf16x8 __attribute__((ext_vector_type(8)));
typedef short s16x4 __attribute__((ext_vector_type(4)));
typedef float f32x16 __attribute__((ext_vector_type(16)));
typedef GAS unsigned gu32;
#define RLX_AGENT __ATOMIC_RELAXED, __HIP_MEMORY_SCOPE_AGENT
#define LDS_WAIT() asm volatile("s_waitcnt lgkmcnt(0)" ::: "memory")
#define VM_WAIT() asm volatile("s_waitcnt vmcnt(0)" ::: "memory")
__device__ __forceinline__ unsigned f2bf(float f) { unsigned u = __builtin_bit_cast(unsigned, f); return (u + 0x7fffu + ((u >> 16) & 1u)) >> 16; }
typedef __bf16 bf16x2_t_ __attribute__((ext_vector_type(2)));
__device__ __forceinline__ unsigned pk2(float lo, float hi) { const f32x2 v = {lo, hi}; const bf16x2_t_ b = __builtin_convertvector(v, bf16x2_t_); return __builtin_bit_cast(unsigned, b); }
__device__ __forceinline__ float bf2f(unsigned short h) { return __builtin_bit_cast(float, (unsigned)h << 16); }
__device__ __forceinline__ float bflo(unsigned w) { return __builtin_bit_cast(float, w << 16); }
__device__ __forceinline__ float bfhi(unsigned w) { return __builtin_bit_cast(float, w & 0xffff0000u); }
__device__ __forceinline__ float wave_sum(float v) {
#define WS_DPP(ctrl) v += __builtin_bit_cast(float, __builtin_amdgcn_update_dpp(0, __builtin_bit_cast(int, v), (ctrl), 0xF, 0xF, true))
    WS_DPP(0xB1);
    WS_DPP(0x4E);
    WS_DPP(0x141);
    WS_DPP(0x140);
#undef WS_DPP
    { const unsigned u = __builtin_bit_cast(unsigned, v); auto rr = __builtin_amdgcn_permlane16_swap(u, u, false, false); v = __builtin_bit_cast(float, (unsigned)rr[0]) + __builtin_bit_cast(float, (unsigned)rr[1]); }
    { const unsigned u = __builtin_bit_cast(unsigned, v); auto rr = __builtin_amdgcn_permlane32_swap(u, u, false, false); v = __builtin_bit_cast(float, (unsigned)rr[0]) + __builtin_bit_cast(float, (unsigned)rr[1]); }
    return v;
}
#define XB_TMO      128
#define XB_XCNT(j)  (256  + 64 * (j))
#define XB_XSUB(j)  (1280 + 64 * (j))
#define XB_XGEN(j)  (2304 + 64 * (j))
#define XB_TOP      3328
#define XB_TOPGEN   3392
#define XCD_BAR_WORDS 3456
#define XB_SPIN_CAP (1u << 22)

__device__ __forceinline__ unsigned xb_ld(unsigned* p)              { return __hip_atomic_load(p, __ATOMIC_RELAXED, __HIP_MEMORY_SCOPE_AGENT); }
__device__ __forceinline__ unsigned xb_add(unsigned* p, unsigned v) { return __hip_atomic_fetch_add(p, v, __ATOMIC_RELAXED, __HIP_MEMORY_SCOPE_AGENT); }
__device__ __forceinline__ unsigned xb_xcc_id() { return (unsigned)__builtin_amdgcn_s_getreg((3 << 11) | 20) & 0xFu; }
#define XB_SPIN(cond, bar) do { unsigned _sp = 0; while (cond) { __builtin_amdgcn_s_sleep(1); \
    if ((++_sp & 255u) == 0u) { if (xb_ld(&(bar)[XB_TMO])) break; if (_sp > XB_SPIN_CAP) { atomicAdd(&(bar)[XB_TMO], 1u); break; } } } } while (0)

struct XcdBarrier {
    unsigned* bar; unsigned x;
    unsigned wv;
    volatile LAS unsigned* st;
};

__device__ __forceinline__ XcdBarrier xcd_barrier_post(unsigned* bar, volatile LAS unsigned* st, unsigned wv) {
    XcdBarrier b; b.bar = bar; b.x = xb_xcc_id(); b.st = st; b.wv = wv;
    if (opaque_tid((int)wv) == 0) (void)xb_add(&bar[XB_XCNT(b.x)], 1u);
    return b;
}
__device__ __forceinline__ void xcd_barrier_complete(unsigned* bar, unsigned x, unsigned& nloc, unsigned& nx) {
    const unsigned G = gridDim.x * gridDim.y * gridDim.z;
    unsigned sum, cnt, mine, sp = 0u;
    for (;;) {
        sum = 0u; cnt = 0u; mine = 0u;
#pragma unroll
        for (unsigned j = 0; j < 16; ++j) { const unsigned c = xb_ld(&bar[XB_XCNT(j)]); sum += c; cnt += (c > 0u) ? 1u : 0u; mine = (j == x) ? c : mine; }
        if (sum == G) break;
        __builtin_amdgcn_s_sleep(1);
        if ((++sp & 255u) == 0u) { if (xb_ld(&bar[XB_TMO])) break; if (sp > XB_SPIN_CAP) { atomicAdd(&bar[XB_TMO], 1u); break; } }
    }
    nloc = mine > 0u ? mine : 1u; nx = cnt > 0u ? cnt : 1u;
}

__device__ __forceinline__ void xcd_barrier(const XcdBarrier& b) {
    asm volatile("s_waitcnt vmcnt(0)" ::: "memory");
    __syncthreads();
    if (opaque_tid((int)b.wv) == 0) {
        unsigned* bar = b.bar;
        __builtin_amdgcn_s_waitcnt(0);
        unsigned nloc = b.st[0], nx = b.st[1];
        if (nloc == 0u) { xcd_barrier_complete(bar, b.x, nloc, nx); b.st[0] = nloc; b.st[1] = nx; }
        const unsigned old = xb_add(&bar[XB_XSUB(b.x)], 1u);
        const unsigned gen = old / nloc;
        if (old + 1u == (gen + 1u) * nloc) {
            __builtin_amdgcn_fence(__ATOMIC_RELEASE, "agent");
            asm volatile("s_waitcnt vmcnt(0)" ::: "memory");
            const unsigned og = xb_add(&bar[XB_TOP], 1u);
            const unsigned tg = og / nx;
            if (og + 1u == (tg + 1u) * nx) xb_add(&bar[XB_TOPGEN], 1u);
            else XB_SPIN(xb_ld(&bar[XB_TOPGEN]) == tg, bar);
            __builtin_amdgcn_fence(__ATOMIC_ACQUIRE, "agent");
            xb_add(&bar[XB_XGEN(b.x)], 1u);
            asm volatile("s_waitcnt vmcnt(0)" ::: "memory");
        } else {
            XB_SPIN(xb_ld(&bar[XB_XGEN(b.x)]) == gen, bar);
            __builtin_amdgcn_fence(__ATOMIC_ACQUIRE, "agent");
            asm volatile("s_waitcnt vmcnt(0)" ::: "memory");
        }
    }
    __syncthreads();
}

struct Args { const float* in[22]; float* out; unsigned char* ws; int ph_lo, ph_hi; };

struct WJob { const float* src; bf16* dst; int K, Nsrc, Ndst, mode; float f8scale; float upscale; };
__device__ __forceinline__ void wjob_get(const Args& a, int j, WJob& w) {
    unsigned char* ws = a.ws; w.f8scale = 0.f; w.upscale = 1.f;
    if (j < 2)        { w.src = a.in[7] + (size_t)j * 1024 * 3072;  w.dst = (bf16*)(ws + W_DAIN + (size_t)j * 6 * MiB);   w.K = 1024; w.Nsrc = 3072; w.Ndst = 3072; w.mode = 1; w.f8scale = (j == 1 && (PROJ_FP8 & 4)) ? WGU8_SCALE : 0.f; }
    else if (j < 4)   { const int i = j - 2; w.src = a.in[8] + (size_t)i * 1024 * 1024; w.dst = (bf16*)(ws + W_DAOUT + (size_t)i * 2 * MiB); w.K = 1024; w.Nsrc = 1024; w.Ndst = 1024; w.mode = 0; }
    else if (j == 4)  { w.src = a.in[11]; w.dst = (bf16*)(ws + W_WAIN);  w.K = 1024; w.Nsrc = 1536; w.Ndst = 1536; w.mode = 2; }
    else if (j == 5)  { w.src = a.in[12]; w.dst = (bf16*)(ws + W_WAOUT); w.K = 1024; w.Nsrc = 1024; w.Ndst = 1024; w.mode = 0; }
    else if (j == 6)  { w.src = a.in[14]; w.dst = (bf16*)(ws + W_RETIN); w.K = 1024; w.Nsrc = 6144; w.Ndst = 6144; w.mode = 3; w.f8scale = (PROJ_FP8 & 1) ? WGU8_SCALE : 0.f; }
    else if (j == 7)  { w.src = a.in[15]; w.dst = (bf16*)(ws + W_RETOUT); w.K = 2048; w.Nsrc = 1024; w.Ndst = 1024; w.mode = 0; w.f8scale = RETOUT_FP8 ? WDN8_SCALE : 0.f; }
    else if (j < 10)  { const int i = j - 8;  w.src = a.in[17] + (size_t)i * 1024 * 5632; w.dst = (bf16*)(ws + W_FFNGU + (size_t)i * 11 * MiB); w.K = 1024; w.Nsrc = 5632; w.Ndst = 5632; w.mode = 4; w.f8scale = ((DENSE_FP8 >> i) & 1) ? WGU8_SCALE : 0.f; w.upscale = ((((DENSE_FP8 | DENSE_H8) >> i) & 1) ? H8_SCALE : 1.f) * (1.f / LOG2E_F); }
    else if (j < 12)  { const int i = j - 10; w.src = a.in[18] + (size_t)i * 2816 * 1024; w.dst = (bf16*)(ws + W_FFNDN + (size_t)i * 11 * MiB / 2); w.K = 2816; w.Nsrc = 1024; w.Ndst = 1024; w.mode = 0; w.f8scale = (((DENSE_FP8 | DENSE_H8) >> i) & 1) ? WDN8_SCALE : 0.f; }
    else if (j < 28)  { const int i = j - 12; w.src = a.in[20] + (size_t)i * 1024 * 7168; w.dst = (bf16*)(ws + W_MOEGU + (size_t)i * 7 * MiB); w.K = 1024; w.Nsrc = 7168; w.Ndst = 7168; w.mode = 4; w.f8scale = WGU8_SCALE; w.upscale = H8_SCALE * (1.f / LOG2E_F); }
    else              { const int i = j - 28; w.src = a.in[21] + (size_t)i * 3584 * 1024; w.dst = (bf16*)(ws + W_MOEDN + (size_t)i * 7 * MiB / 2);  w.K = 3584; w.Nsrc = 1024; w.Ndst = 1024; w.mode = 0; w.f8scale = WDN8_SCALE; }
}
constexpr int W_ITEMS = 103936;
__device__ __forceinline__ int wsrc_col(int mode, int n, int Nsrc, float upscale, float& scale) {
    scale = 1.f;
    if (mode == 0) return n;
    if (mode == 1 || mode == 2) {
        const int nrope = (mode == 1) ? 2048 : 1280;
        if (n < 1024) scale = QSCALE;
        if (n >= nrope) return n;
        const int n64 = n & 63, half = n64 >> 5, p = n64 & 31, sg = 4 * (p >> 3) + (p & 3) + 16 * ((p >> 2) & 1);
        return (n & ~63) + 32 * half + sg;
    }
    if (mode == 3) { if (n >= 1024 && n < 2048) scale = 0.0625f; return n; }
    const int F = Nsrc >> 1, pn = n >> 8, w = n & 255;
    scale = (w < 128) ? LOG2E_F : upscale;
    return (w < 128) ? (128 * pn + w) : (F + 128 * pn + (w - 128));
}
__device__ __forceinline__ void p0_transpose_item(const WJob& w, LAS float* scr, int item, int lane) {
    const int nblk = w.Ndst / 32, kb = item / nblk, nb = item % nblk, k0 = 64 * kb, n0 = 32 * nb;
    const int r = lane >> 3, c4 = lane & 7;
    float scale; const int sc = wsrc_col(w.mode, n0 + 4 * c4, w.Nsrc, w.upscale, scale);
    if (w.f8scale != 0.f) scale *= w.f8scale;
    const float* W = w.src + (size_t)(k0 + r) * w.Nsrc + sc;
    f32x4 v[8];
#pragma unroll
    for (int i = 0; i < 8; ++i) v[i] = *(const f32x4*)(W + (size_t)(8 * i) * w.Nsrc);
#pragma unroll
    for (int i = 0; i < 8; ++i) { LAS float* d = scr + (8 * i + r) * 33 + 4 * c4; d[0] = v[i][0] * scale; d[1] = v[i][1] * scale; d[2] = v[i][2] * scale; d[3] = v[i][3] * scale; }
    LDS_WAIT(); asm volatile("" ::: "memory");
    const int c = lane & 7;
#pragma unroll
    for (int j = 0; j < 4; ++j) { const int n = (lane >> 3) + 8 * j; const LAS float* s = scr + (8 * c) * 33 + n;
        if (w.f8scale != 0.f) { v2u o; o.x = pg8::pack4_fp8(s[0 * 33], s[1 * 33], s[2 * 33], s[3 * 33]); o.y = pg8::pack4_fp8(s[4 * 33], s[5 * 33], s[6 * 33], s[7 * 33]);
            *(GAS v2u*)((unsigned char*)w.dst + (size_t)(n0 + n) * w.K + k0 + 8 * c) = o; }
        else { v4u o; o.x = pk2(s[0 * 33], s[1 * 33]); o.y = pk2(s[2 * 33], s[3 * 33]); o.z = pk2(s[4 * 33], s[5 * 33]); o.w = pk2(s[6 * 33], s[7 * 33]);
            *(GAS v4u*)(w.dst + (size_t)(n0 + n) * w.K + k0 + 8 * c) = o; } }
    LDS_WAIT(); asm volatile("" ::: "memory");
}
__device__ __forceinline__ void p0_prologue(const Args& a, LAS unsigned char* lds, int G, int wv) {
    const int tid = opaque_tid(wv), lane = tid & 63, wave = __builtin_amdgcn_readfirstlane(tid >> 6);
    unsigned char* ws = a.ws;
    const int bx = blockIdx.x;
    if (bx < 48) {
        LAS float* s = (LAS float*)lds;
        for (int i = tid; i < 17 * 1024; i += NWAVES * 64) { const float v = (i < 16384) ? a.in[1][i] : a.in[3][i - 16384]; s[(i & 1023) * 20 + (i >> 10)] = v / (1.f + __expf(-v)); }
        __syncthreads();
        const int idx = bx * 512 + tid, l = idx / 6144, n = idx - l * 6144;
        float acc[17];
#pragma unroll
        for (int mi = 0; mi < 17; ++mi) acc[mi] = 0.f;
        const float* wp = a.in[4] + (size_t)l * 1024 * 6144 + n;
#pragma unroll 4
        for (int k = 0; k < 1024; ++k) { const float wv = wp[(size_t)k * 6144];
#pragma unroll
            for (int q = 0; q < 4; ++q) { const f32x4 sv = *(const LAS f32x4*)(s + k * 20 + 4 * q); acc[4 * q] += sv[0] * wv; acc[4 * q + 1] += sv[1] * wv; acc[4 * q + 2] += sv[2] * wv; acc[4 * q + 3] += sv[3] * wv; }
            acc[16] += s[k * 20 + 16] * wv; }
        float* modv = (float*)(ws + WS_MODV); const float bb = a.in[5][l * 6144 + n];
#pragma unroll
        for (int mi = 0; mi < 17; ++mi) modv[(size_t)(l * 17 + mi) * 6144 + n] = acc[mi] + bb;
        __syncthreads();
    }
    { const int gt = bx * (NWAVES * 64) + tid, NT = G * NWAVES * 64;
      float* r1c = (float*)(ws + WS_ROPE1); float* r1s = r1c + 4096 * 128;
      for (int idx = gt; idx < 4096 * 128; idx += NT) { const int pos = idx >> 7, i = idx & 127; const float inv = powf(10000.f, -(float)(2 * i) / 256.f); const float ang = (float)pos * inv;
          double sd, cd; sincos((double)ang, &sd, &cd); r1c[idx] = (float)cd; r1s[idx] = (float)sd; }
      float* r2c = (float*)(ws + WS_ROPE2); float* r2s = r2c + 64 * 16;
      for (int idx = gt; idx < 64 * 16; idx += NT) { const int pos = idx >> 4, i = idx & 15; const float inv = powf(10000.f, -(float)(2 * i) / 32.f); const float ang = (float)pos * inv;
          double sd, cd; sincos((double)ang, &sd, &cd); r2c[idx] = (float)cd; r2s[idx] = (float)sd; }
      float* rw = (float*)(ws + WS_ROUTW);
      for (int idx = gt; idx < 2 * 8 * 1024; idx += NT) { const int l = idx >> 13, e = (idx >> 10) & 7, k = idx & 1023; rw[idx] = a.in[19][((size_t)l * 1024 + k) * 8 + e]; }
      { float* sm = (float*)(ws + WS_SMALL);
        for (int idx = gt; idx < 16384; idx += NT) sm[SM_NORMG + idx] = a.in[6][idx];
        if (gt < 256) sm[SM_SUBLN + gt] = a.in[10][gt];
        if (gt < 16) sm[SM_SINK + gt] = a.in[13][gt];
        if (gt < 8) sm[SM_DECAY + gt] = a.in[16][gt]; }
      if (gt < 2) { const float* lp = a.in[9] + gt * 256; float s01 = 0.f, s23 = 0.f;
          for (int i = 0; i < 64; ++i) { s01 += lp[i] * lp[64 + i]; s23 += lp[128 + i] * lp[192 + i]; }
          const float lam_init = 0.8f - 0.6f * expf(-0.3f * (float)(gt == 0 ? 0 : 3));
          ((float*)(ws + WS_SCAL))[gt] = expf(s01) - expf(s23) + lam_init; }
    }
    { LAS float* scr = (LAS float*)(lds + wave * 16384);
      gu32* wq = (gu32*)(ws + WS_CTL) + CW_WQ;
      constexpr int CH = 8;
      int j = 0, base = 0; WJob w; wjob_get(a, 0, w); int n = (w.K / 64) * (w.Ndst / 32);
      for (;;) {
          unsigned i0 = 0; if (lane == 0) i0 = __hip_atomic_fetch_add(wq, (unsigned)CH, RLX_AGENT); i0 = __builtin_amdgcn_readfirstlane(i0);
          if (i0 >= (unsigned)W_ITEMS) break;
          for (int t = 0; t < CH; ++t) { const int it = (int)i0 + t; if (it >= W_ITEMS) break;
              while (it >= base + n) { base += n; ++j; wjob_get(a, j, w); n = (w.K / 64) * (w.Ndst / 32); }
              p0_transpose_item(w, scr, it - base, lane); } } }
}

#define RC(j) (8 * lane + 512 * ((j) >> 1) + 4 * ((j) & 1))
template <int VAR, bool ROUTE, bool FINAL, bool A8 = false, bool NOCTX = false>
__device__ __forceinline__ void resid_phase(unsigned char* ws, float* outp, const float* in_x, const float* in_ctx, LAS unsigned char* lds, const bf16* Ysrc, int layY, int subY, int layA, int subA, int moe_l, int G, int wv) {
    const int tid = opaque_tid(wv), lane = tid & 63, wave = __builtin_amdgcn_readfirstlane(tid >> 6);
    const int gw = blockIdx.x * NWAVES + wave, NGW = G * NWAVES;
    const float* modv = (const float*)(ws + WS_MODV);
    bf16* X = (bf16*)(ws + WS_X); bf16* AY = (bf16*)outp;
    const float* ngY = (const float*)(ws + WS_SMALL) + SM_NORMG + (size_t)(layY * 4 + (subY ? 3 : 1)) * 1024;
    const float* ngA = (const float*)(ws + WS_SMALL) + SM_NORMG + (size_t)(layA * 4 + (subA ? 2 : 0)) * 1024;
    gu32* ctl = (gu32*)(ws + WS_CTL);
    int ts[9];
    if (VAR == 2) { ts[0] = 0;
#pragma unroll
        for (int e = 0; e < 8; ++e) { const unsigned c = (unsigned)__builtin_amdgcn_readfirstlane((int)__hip_atomic_load(ctl + CW_MOECNT + 16 * moe_l + e, RLX_AGENT)); ts[e + 1] = ts[e] + (int)((c + 255u) >> 8); } }
    const int moe_r = ROUTE ? moe_l : 0;
    LAS float* wr = (LAS float*)lds; LAS int* lcnt = (LAS int*)(lds + 32768); LAS int* lbase = lcnt + 8; LAS unsigned* info = (LAS unsigned*)(lds + 33024) + wave * (40 * 4);
    if (ROUTE) { const float* rw = (const float*)(ws + WS_ROUTW) + (size_t)moe_r * 8192;
        for (int i = tid; i < 8192; i += NWAVES * 64) wr[i] = rw[i];
        if (tid < 8) lcnt[tid] = 0;
        __syncthreads(); }
    constexpr int NR = RESID_NR;
    const int RPW = (TA + NGW - 1) / NGW, rbeg = gw * RPW, rend = (rbeg + RPW < TA) ? rbeg + RPW : TA;
    f32x4 ngY_r[4], ngA_r[4], gate_r[4], sh_r[4], sc_r[4]; int miY = -1, miA = -1;
#pragma unroll
    for (int j = 0; j < 4; ++j) { ngY_r[j] = *(const f32x4*)(ngY + RC(j)); ngA_r[j] = *(const f32x4*)(ngA + RC(j)); }
    for (int r0 = rbeg, nrow = 0; r0 < rend; r0 += NR, nrow += NR) {
        int rr[NR], bb[NR], pp[NR], mi[NR]; bool isctx[NR], act[NR];
#pragma unroll
        for (int u = 0; u < NR; ++u) { rr[u] = r0 + u; const bool valid = rr[u] < rend; const int rq = valid ? rr[u] : r0; bb[u] = rq / RPB; pp[u] = rq - bb[u] * RPB; isctx[u] = pp[u] < CTXL; mi[u] = isctx[u] ? 16 : bb[u];
            act[u] = valid && !((NOCTX || FINAL) && isctx[u]);
            if (ROUTE && valid && !act[u] && lane == 0) info[(nrow + u) * 4] = 0xffu;
            rr[u] = rq; }
        f32x4 xv[NR][4]; v2u xraw[NR][4], yraw[NR][4], y1raw[NR][4]; v4u ti[NR];
#pragma unroll
        for (int u = 0; u < NR; ++u) if (act[u]) {
            if (VAR == 0) { const float* src = isctx[u] ? in_ctx + ((size_t)bb[u] * CTXL + pp[u]) * DM : in_x + ((size_t)bb[u] * SEQL + (pp[u] - CTXL)) * DM;
#pragma unroll
                for (int j = 0; j < 4; ++j) xv[u][j] = *(const f32x4*)(src + RC(j)); }
            else { const bf16* xr = X + (size_t)rr[u] * DM;
#pragma unroll
                for (int jj = 0; jj < 2; ++jj) { const v4u w4_ = *(const v4u*)(xr + RC(2 * jj)); xraw[u][2 * jj] = (v2u){w4_.x, w4_.y}; xraw[u][2 * jj + 1] = (v2u){w4_.z, w4_.w}; }
                if (VAR == 1) { const bf16* yr = Ysrc + (size_t)rr[u] * DM;
#pragma unroll
                    for (int jj = 0; jj < 2; ++jj) { const v4u w4_ = *(const v4u*)(yr + RC(2 * jj)); yraw[u][2 * jj] = (v2u){w4_.x, w4_.y}; yraw[u][2 * jj + 1] = (v2u){w4_.z, w4_.w}; } }
                else ti[u] = *(const v4u*)(ws + WS_TOKINFO + (size_t)rr[u] * 16); } }
        float g0v[NR], g1v[NR];
        if (VAR == 2) {
#pragma unroll
            for (int u = 0; u < NR; ++u) if (act[u]) {
                const int e0 = ti[u].x & 15, e1 = ti[u].y & 15; int s0 = 0, s1 = 0;
#pragma unroll
                for (int e = 0; e < 8; ++e) { s0 = (e == e0) ? ts[e] : s0; s1 = (e == e1) ? ts[e] : s1; }
                s0 = s0 * 256 + (int)(ti[u].x >> 4); s1 = s1 * 256 + (int)(ti[u].y >> 4);
                const unsigned gz_ = ti[u].z, gw_ = ti[u].w;
                g0v[u] = __uint_as_float(gz_); g1v[u] = __uint_as_float(gw_);
                const bf16* y0 = (const bf16*)(ws + BIG_YE) + (size_t)s0 * DM; const bf16* y1 = (const bf16*)(ws + BIG_YE) + (size_t)s1 * DM;
#pragma unroll
                for (int jj = 0; jj < 2; ++jj) { const v4u a4_ = *(const v4u*)(y0 + RC(2 * jj)), b4_ = *(const v4u*)(y1 + RC(2 * jj));
                    yraw[u][2 * jj] = (v2u){a4_.x, a4_.y}; yraw[u][2 * jj + 1] = (v2u){a4_.z, a4_.w}; y1raw[u][2 * jj] = (v2u){b4_.x, b4_.y}; y1raw[u][2 * jj + 1] = (v2u){b4_.z, b4_.w}; } } }
#pragma unroll
        for (int u = 0; u < NR; ++u) if (act[u]) {
        const int r = rr[u], b = bb[u], p = pp[u];
        if (VAR != 0) {
            f32x4 yv[4];
#pragma unroll
            for (int j = 0; j < 4; ++j) { const v2u w = yraw[u][j]; yv[j] = (f32x4){bflo(w.x), bfhi(w.x), bflo(w.y), bfhi(w.y)};
                if (VAR == 2) { const v2u w1 = y1raw[u][j]; yv[j] = yv[j] * g0v[u] + (f32x4){bflo(w1.x), bfhi(w1.x), bflo(w1.y), bfhi(w1.y)} * g1v[u]; } }
            float ss = 0.f;
#pragma unroll
            for (int j = 0; j < 4; ++j) ss += (yv[j].x * yv[j].x + yv[j].y * yv[j].y) + (yv[j].z * yv[j].z + yv[j].w * yv[j].w);
            const float rstd = __builtin_amdgcn_rsqf(wave_sum(ss) * (1.f / DM) + NORM_EPS);
            if (mi[u] != miY) { miY = mi[u]; const float* gate = modv + ((size_t)(layY * 17 + miY) * 6 + (subY ? 5 : 2)) * 1024;
#pragma unroll
                for (int j = 0; j < 4; ++j) gate_r[j] = *(const f32x4*)(gate + RC(j)) * ngY_r[j]; }
#pragma unroll
            for (int j = 0; j < 4; ++j) { const f32x4 g = gate_r[j]; const v2u xw_ = xraw[u][j]; const f32x4 x0 = (f32x4){bflo(xw_.x), bfhi(xw_.x), bflo(xw_.y), bfhi(xw_.y)};
                xv[u][j] = x0 + g * (yv[j] * rstd); }
        }
        if (FINAL) { float* orow = outp + ((size_t)b * SEQL + (p - CTXL)) * DM;
#pragma unroll
                for (int j = 0; j < 4; ++j) *(f32x4*)(orow + RC(j)) = xv[u][j]; }
        else {
            bf16* xw = X + (size_t)r * DM;
#pragma unroll
            for (int jj = 0; jj < 2; ++jj) { v4u w; w.x = pk2(xv[u][2 * jj].x, xv[u][2 * jj].y); w.y = pk2(xv[u][2 * jj].z, xv[u][2 * jj].w); w.z = pk2(xv[u][2 * jj + 1].x, xv[u][2 * jj + 1].y); w.w = pk2(xv[u][2 * jj + 1].z, xv[u][2 * jj + 1].w);
                *(v4u*)(xw + RC(2 * jj)) = w;
                xv[u][2 * jj] = (f32x4){bflo(w.x), bfhi(w.x), bflo(w.y), bfhi(w.y)}; xv[u][2 * jj + 1] = (f32x4){bflo(w.z), bfhi(w.z), bflo(w.w), bfhi(w.w)}; }
            float ss = 0.f;
#pragma unroll
            for (int j = 0; j < 4; ++j) ss += (xv[u][j].x * xv[u][j].x + xv[u][j].y * xv[u][j].y) + (xv[u][j].z * xv[u][j].z + xv[u][j].w * xv[u][j].w);
            const float rstd = __builtin_amdgcn_rsqf(wave_sum(ss) * (1.f / DM) + NORM_EPS);
            if (mi[u] != miA) { miA = mi[u]; const float* sh = modv + ((size_t)(layA * 17 + miA) * 6 + (subA ? 3 : 0)) * 1024; const float* sc = sh + 1024;
#pragma unroll
                for (int j = 0; j < 4; ++j) { sh_r[j] = *(const f32x4*)(sh + RC(j)); sc_r[j] = (*(const f32x4*)(sc + RC(j)) + 1.f) * ngA_r[j]; } }
            bf16* ar = AY + (size_t)r * DM; f32x4 av[4];
#pragma unroll
            for (int j = 0; j < 4; ++j) { const f32x4 s1 = sc_r[j], s0 = sh_r[j]; av[j] = (xv[u][j] * rstd) * s1 + s0; }
#pragma unroll
            for (int jj = 0; jj < 2; ++jj) { const int c = RC(2 * jj); const f32x4 a0 = av[2 * jj], a1 = av[2 * jj + 1];
                if (A8) { v2u w8; w8.x = pg8::pack4_fp8(a0.x * A8_SCALE, a0.y * A8_SCALE, a0.z * A8_SCALE, a0.w * A8_SCALE); w8.y = pg8::pack4_fp8(a1.x * A8_SCALE, a1.y * A8_SCALE, a1.z * A8_SCALE, a1.w * A8_SCALE);
                    *(v2u*)((unsigned char*)outp + A8_OFF + (size_t)r * DM + c) = w8; }
                else { v4u w; w.x = pk2(a0.x, a0.y); w.y = pk2(a0.z, a0.w); w.z = pk2(a1.x, a1.y); w.w = pk2(a1.z, a1.w); *(v4u*)(ar + c) = w; } }
            if (ROUTE) {
                float lg[8];
#pragma unroll
                for (int e = 0; e < 8; ++e) { float s = 0.f;
#pragma unroll
                    for (int j = 0; j < 4; ++j) { const f32x4 w4 = *(const LAS f32x4*)(wr + e * 1024 + RC(j)); s += (av[j].x * w4.x + av[j].y * w4.y) + (av[j].z * w4.z + av[j].w * w4.w); }
                    lg[e] = wave_sum(s); }
                int i0 = 0; float v0 = lg[0];
#pragma unroll
                for (int e = 1; e < 8; ++e) if (lg[e] > v0) { v0 = lg[e]; i0 = e; }
                int i1 = 0; float v1 = -3.0e38f;
#pragma unroll
                for (int e = 0; e < 8; ++e) if (e != i0 && lg[e] > v1) { v1 = lg[e]; i1 = e; }
                const float g0 = 1.f / (1.f + __expf(v1 - v0)), g1 = 1.f - g0;
                if (lane == 0) { const int q0_ = __hip_atomic_fetch_add(lcnt + i0, 1, __ATOMIC_RELAXED, __HIP_MEMORY_SCOPE_WORKGROUP), q1_ = __hip_atomic_fetch_add(lcnt + i1, 1, __ATOMIC_RELAXED, __HIP_MEMORY_SCOPE_WORKGROUP);
                    LAS unsigned* q = info + (nrow + u) * 4; q[0] = (unsigned)i0; q[1] = (unsigned)q0_; q[2] = (unsigned)i1; q[3] = (unsigned)q1_;
                    v2u gg; gg.x = __builtin_bit_cast(unsigned, g0); gg.y = __builtin_bit_cast(unsigned, g1); *(v2u*)(ws + WS_TOKINFO + (size_t)r * 16 + 8) = gg; }
            }
        }
        }
    }
    if (ROUTE) {
        __syncthreads();
        if (tid < 8) lbase[tid] = (int)__hip_atomic_fetch_add(ctl + CW_MOECNT + 16 * moe_r + tid, (unsigned)lcnt[tid], RLX_AGENT);
        __syncthreads();
        if (lane == 0) { int k = 0; int* lists = (int*)(ws + WS_LISTS);
            for (int r = rbeg; r < rend; ++r, ++k) { const LAS unsigned* q = info + k * 4; if (q[0] == 0xffu) continue; const int e0 = (int)q[0], e1 = (int)q[2]; const int r0 = (int)q[1] + lbase[e0], r1 = (int)q[3] + lbase[e1];
                lists[(size_t)e0 * TA + r0] = r; lists[(size_t)e1 * TA + r1] = r;
                v2u ti; ti.x = (unsigned)e0 | ((unsigned)r0 << 4); ti.y = (unsigned)e1 | ((unsigned)r1 << 4);
                *(v2u*)(ws + WS_TOKINFO + (size_t)r * 16) = ti; } }
        __syncthreads();
    }
}

namespace att {
#define SBAR() __builtin_amdgcn_sched_barrier(0)
#define SWZX(v, k) __builtin_bit_cast(float, __builtin_amdgcn_ds_swizzle(__builtin_bit_cast(int, (float)(v)), ((k) << 10) | 0x1f))
constexpr float THRL = 8.f;
__device__ __forceinline__ int crow(int r, int hi) { return (r & 3) + 8 * (r >> 2) + 4 * hi; }
__device__ __forceinline__ unsigned cvtpk(float lo, float hi) { unsigned r; asm volatile("v_cvt_pk_bf16_f32 %0, %1, %2" : "=v"(r) : "v"(lo), "v"(hi)); return r; }
__device__ __forceinline__ void partialSM(f32x16& p0, f32x16& p1, float& m_reg, float& mn, float& alpha) {
    float pmax = p0[0];
#pragma unroll
    for (int r = 1; r < 16; ++r) pmax = fmaxf(pmax, p0[r]);
#pragma unroll
    for (int r = 0; r < 16; ++r) pmax = fmaxf(pmax, p1[r]);
    { auto rr = __builtin_amdgcn_permlane32_swap(__float_as_uint(pmax), __float_as_uint(pmax), false, false);
      pmax = fmaxf(__uint_as_float(rr[0]), __uint_as_float(rr[1])); }
    if (__builtin_expect(__all(pmax - m_reg <= THRL), 1)) { mn = m_reg; alpha = 1.f; }
    else { mn = fmaxf(m_reg, pmax); alpha = __builtin_amdgcn_exp2f(m_reg - mn); m_reg = mn; }
#pragma unroll
    for (int r = 0; r < 16; ++r) p0[r] = p0[r] - mn;
#pragma unroll
    for (int r = 0; r < 16; ++r) p1[r] = p1[r] - mn;
#pragma unroll
    for (int r = 0; r < 16; ++r) p0[r] = __builtin_amdgcn_exp2f(p0[r]);
}

__device__ __forceinline__ float sm_max16(const f32x16& p) { float a = p[0];
#pragma unroll
    for (int r = 1; r < 16; ++r) a = fmaxf(a, p[r]);
    return a; }
__device__ __forceinline__ void sm_decide(float pmax, float& m_reg, float& mn, float& alpha) {
    { auto rr = __builtin_amdgcn_permlane32_swap(__float_as_uint(pmax), __float_as_uint(pmax), false, false);
      pmax = fmaxf(__uint_as_float(rr[0]), __uint_as_float(rr[1])); }
    if (__builtin_expect(__all(pmax - m_reg <= THRL), 1)) { mn = m_reg; alpha = 1.f; }
    else { mn = fmaxf(m_reg, pmax); alpha = __builtin_amdgcn_exp2f(m_reg - mn); m_reg = mn; } }
__device__ __forceinline__ void sm_subexp(f32x16& p, float mn) {
#pragma unroll
    for (int r = 0; r < 16; ++r) p[r] = __builtin_amdgcn_exp2f(p[r] - mn); }
__device__ __forceinline__ void sm_sub(f32x16& p, float mn) {
#pragma unroll
    for (int r = 0; r < 16; ++r) p[r] = p[r] - mn; }
__device__ __forceinline__ void finishSM(f32x16& p0, f32x16& p1, float alpha, float& l_reg, bf16x8& pa0, bf16x8& pa1, bf16x8& pa2, bf16x8& pa3) {
#pragma unroll
    for (int r = 0; r < 16; ++r) p1[r] = __builtin_amdgcn_exp2f(p1[r]);
    float ps = 0;
#pragma unroll
    for (int r = 0; r < 16; ++r) ps += p0[r];
#pragma unroll
    for (int r = 0; r < 16; ++r) ps += p1[r];
    { auto rr = __builtin_amdgcn_permlane32_swap(__float_as_uint(ps), __float_as_uint(ps), false, false);
      ps = __uint_as_float(rr[0]) + __uint_as_float(rr[1]); }
    l_reg = l_reg * alpha + ps;
#define PK4(P, BASE, OUT) do { unsigned a0 = cvtpk(P[BASE + 0], P[BASE + 1]), a1 = cvtpk(P[BASE + 2], P[BASE + 3]);   \
    unsigned b0 = cvtpk(P[BASE + 4], P[BASE + 5]), b1 = cvtpk(P[BASE + 6], P[BASE + 7]);                              \
    v4u w = {a0, a1, b0, b1}; OUT = __builtin_bit_cast(bf16x8, w); } while (0)
    PK4(p0, 0, pa0); PK4(p0, 8, pa1); PK4(p1, 0, pa2); PK4(p1, 8, pa3);
#undef PK4
}
template <int NCB> __device__ __forceinline__ int v_st(int k, int c) { const int kk = k; return ((kk >> 3) * NCB + (c >> 5)) * 512 + ((kk & 7) * 32 + (c & 31)) * 2; }
__device__ __forceinline__ int v_rd_base(int lane) { return ((lane & 3) << 3) | (((lane >> 2) & 3) << 6) | (((lane >> 4) & 1) << 5) | (((lane >> 5) & 1) << 8); }
template <int OFF> __device__ __forceinline__ s16x4 tr_read(int vb) { s16x4 r; asm volatile("ds_read_b64_tr_b16 %0, %1 offset:%2" : "=&v"(r) : "v"(vb), "i"(OFF) : "memory"); return r; }
template <int D0, int NCB> __device__ __forceinline__ void pv_one(f32x16& od, int vb, bf16x8 pa0, bf16x8 pa1, bf16x8 pa2, bf16x8 pa3) {
#define VOFF(ks, half) (((2 * (ks) + (half)) * NCB + D0) * 512)
    const s16x4 l0 = tr_read<VOFF(0, 0)>(vb), h0 = tr_read<VOFF(0, 1)>(vb), l1 = tr_read<VOFF(1, 0)>(vb), h1 = tr_read<VOFF(1, 1)>(vb);
    const s16x4 l2 = tr_read<VOFF(2, 0)>(vb), h2 = tr_read<VOFF(2, 1)>(vb), l3 = tr_read<VOFF(3, 0)>(vb), h3 = tr_read<VOFF(3, 1)>(vb);
#undef VOFF
    asm volatile("s_waitcnt lgkmcnt(0)" ::: "memory"); SBAR();
#define PK(L, H) (bf16x8){L[0], L[1], L[2], L[3], H[0], H[1], H[2], H[3]}
    od = __builtin_amdgcn_mfma_f32_32x32x16_bf16(pa0, PK(l0, h0), od, 0, 0, 0);
    od = __builtin_amdgcn_mfma_f32_32x32x16_bf16(pa1, PK(l1, h1), od, 0, 0, 0);
    od = __builtin_amdgcn_mfma_f32_32x32x16_bf16(pa2, PK(l2, h2), od, 0, 0, 0);
    od = __builtin_amdgcn_mfma_f32_32x32x16_bf16(pa3, PK(l3, h3), od, 0, 0, 0);
#undef PK
}

constexpr int DA_LD = 3072, SHM_T = 64 * 128 * 2;
#define KSWZ(row, colB) ((row) * 256 + ((colB) ^ (((row) & 7) << 4)))
__device__ __forceinline__ void da_unit64(const bf16* __restrict__ QKV_, bf16* __restrict__ O_, int b, int h, int q0, int nkeys, float lam, float oscale, const float* __restrict__ subg, char* lds, int wv) {
    const int tid = opaque_tid(wv), wid = __builtin_amdgcn_readfirstlane(tid >> 6), lane = tid & 63, r32 = lane & 31, hi = lane >> 5, mp = wid >> 2, rgi = wid & 3;
    const bf16* QKV = QKV_; bf16* O = O_; asm volatile("" : "+s"(QKV), "+s"(O));
    char* V_lds = lds; char* K_lds = lds + 2 * SHM_T;
    char* Q1_lds = lds + 4 * SHM_T;
    float* wsf = (float*)(lds + 6 * SHM_T) + wid * 128;
    const size_t rb0 = (size_t)b * RPB;
    float m_reg[2] = {0.f, 0.f}, l_reg[2] = {0.f, 0.f}; f32x16 o[2][4] = {}; bf16x8 qr[4]; asm volatile("" : "+v"(m_reg[0]), "+v"(m_reg[1]));
    { const bf16* Qw = QKV + (rb0 + q0 + rgi * 64 + r32) * DA_LD + h * 128 + mp * 64 + hi * 8;
#pragma unroll
        for (int d0 = 0; d0 < 4; ++d0) qr[d0] = *(const bf16x8*)(Qw + d0 * 16);
#pragma unroll
        for (int i = 0; i < 4; ++i) { const int p = tid + 512 * i, row = p >> 4, ch = p & 15;
            const bf16x8 v = *(const bf16x8*)(QKV + (rb0 + q0 + (row >> 5) * 64 + 32 + (row & 31)) * DA_LD + h * 128 + ch * 8);
            *(bf16x8*)(Q1_lds + row * 256 + ((ch ^ (row & 7)) << 4)) = v; } }
    const int q1off = (rgi * 32 + r32) * 256;
    const bf16* Kh = QKV + rb0 * DA_LD + 1024 + h * 128; const bf16* Vh = Kh + 1024;
    const int vb0 = (int)(uintptr_t)V_lds + v_rd_base(lane);
    const unsigned ldsK = (unsigned)(uintptr_t)K_lds + wid * 2048u, ldsV = (unsigned)(uintptr_t)V_lds + wid * 2048u;
#define DMA1(voffs, gbase, ldsdst) do { unsigned keep_; asm volatile("s_mov_b32 %0, m0\n\ts_mov_b32 m0, %3\n\ts_nop 0\n\tglobal_load_lds_dwordx4 %1, %2\n\ts_mov_b32 m0, %0" : "=&s"(keep_) : "v"(voffs), "s"(gbase), "s"((unsigned)__builtin_amdgcn_readfirstlane((int)(ldsdst))) : "memory"); } while (0)
#define DMA_TILE(k0, bq) do { const char* kb_ = (const char*)(Kh + (size_t)(k0) * DA_LD); const char* vb_ = (const char*)(Vh + (size_t)(k0) * DA_LD); \
    int t_ = tid; asm volatile("" : "+v"(t_)); const int ln = t_ & 63;       \
    _Pragma("unroll") for (int t = 0; t < 2; ++t) { const int i = wid * 2 + t; \
        const int row = 4 * i + (ln >> 4), chp = ln & 15, gch = chp ^ (row & 7); const unsigned koff_ = __umul24((unsigned)row, (unsigned)(DA_LD * 2)) + (unsigned)(gch * 16);   \
        const int p16 = 64 * i + ln, sub = p16 >> 5, within = p16 & 31, kk = (sub >> 2) * 8 + (within >> 2), c = (sub & 3) * 32 + (within & 3) * 8; \
        const int k = kk; const unsigned voff_ = __umul24((unsigned)k, (unsigned)(DA_LD * 2)) + (unsigned)(c * 2); \
        DMA1(koff_, kb_, ldsK + (bq) * SHM_T + 1024u * t); DMA1(voff_, vb_, ldsV + (bq) * SHM_T + 1024u * t); } } while (0)
#define DMA_WAIT_BAR() do { asm volatile("s_waitcnt vmcnt(0)" ::: "memory"); __syncthreads(); } while (0)
    const int NT = nkeys / 64;
    DMA_TILE(0, 0); DMA_WAIT_BAR();
    for (int j = 0; j < NT; ++j) {
        const char* Kb = K_lds + (j & 1) * SHM_T; const int vb = vb0 + (j & 1) * SHM_T;
        if (j + 1 < NT) DMA_TILE((j + 1) * 64, (j + 1) & 1);
        f32x16 p[2][2];
#define QK_ALL() do { _Pragma("unroll") for (int rb = 0; rb < 2; ++rb) { \
            const v4u aw = {hi ? 0u : 0x3F80u, 0u, 0u, 0u}, bw = {__float_as_uint(-m_reg[rb]) >> 16, 0u, 0u, 0u}; \
            p[rb][0] = __builtin_amdgcn_mfma_f32_32x32x16_bf16(__builtin_bit_cast(bf16x8, aw), __builtin_bit_cast(bf16x8, bw), f32x16{}, 0, 0, 0); \
            p[rb][1] = __builtin_amdgcn_mfma_f32_32x32x16_bf16(__builtin_bit_cast(bf16x8, aw), __builtin_bit_cast(bf16x8, bw), f32x16{}, 0, 0, 0); } \
        _Pragma("unroll") for (int d0 = 0; d0 < 4; ++d0) { const int cb = ((mp * 4 + d0) * 16 + hi * 8) * 2; \
            const bf16x8 k0 = *(const bf16x8*)(Kb + KSWZ(r32, cb)), k1 = *(const bf16x8*)(Kb + KSWZ(32 + r32, cb)); \
            const bf16x8 q1 = *(const bf16x8*)(Q1_lds + q1off + (((mp * 8 + d0 * 2 + hi) ^ (r32 & 7)) << 4)); \
            p[0][0] = __builtin_amdgcn_mfma_f32_32x32x16_bf16(k0, qr[d0], p[0][0], 0, 0, 0); p[0][1] = __builtin_amdgcn_mfma_f32_32x32x16_bf16(k1, qr[d0], p[0][1], 0, 0, 0); \
            p[1][0] = __builtin_amdgcn_mfma_f32_32x32x16_bf16(k0, q1, p[1][0], 0, 0, 0); p[1][1] = __builtin_amdgcn_mfma_f32_32x32x16_bf16(k1, q1, p[1][1], 0, 0, 0); \
            SBAR(); } } while (0)
#define EXPSUM(rb) do { _Pragma("unroll") for (int r = 0; r < 16; ++r) { p[rb][0][r] = __builtin_amdgcn_exp2f(p[rb][0][r]); p[rb][1][r] = __builtin_amdgcn_exp2f(p[rb][1][r]); } \
            float ps_ = p[rb][0][0]; _Pragma("unroll") for (int r = 1; r < 16; ++r) ps_ += p[rb][0][r]; _Pragma("unroll") for (int r = 0; r < 16; ++r) ps_ += p[rb][1][r]; \
            { auto rr = __builtin_amdgcn_permlane32_swap(__float_as_uint(ps_), __float_as_uint(ps_), false, false); ps_ = __uint_as_float(rr[0]) + __uint_as_float(rr[1]); } psv[rb] = ps_; } while (0)
#define QK_ONE(rb) do { int tq_ = tid; asm volatile("" : "+v"(tq_)); const int r32q = tq_ & 31, hiq = (tq_ >> 5) & 1; \
        { const v4u aw = {hiq ? 0u : 0x3F80u, 0u, 0u, 0u}, bw = {__float_as_uint(-m_reg[rb]) >> 16, 0u, 0u, 0u}; \
            p[rb][0] = __builtin_amdgcn_mfma_f32_32x32x16_bf16(__builtin_bit_cast(bf16x8, aw), __builtin_bit_cast(bf16x8, bw), f32x16{}, 0, 0, 0); \
            p[rb][1] = __builtin_amdgcn_mfma_f32_32x32x16_bf16(__builtin_bit_cast(bf16x8, aw), __builtin_bit_cast(bf16x8, bw), f32x16{}, 0, 0, 0); } \
        _Pragma("unroll") for (int d0 = 0; d0 < 4; ++d0) { const int cb = ((mp * 4 + d0) * 16 + hiq * 8) * 2; \
            const bf16x8 k0 = *(const bf16x8*)(Kb + KSWZ(r32q, cb)), k1 = *(const bf16x8*)(Kb + KSWZ(32 + r32q, cb)); \
            const bf16x8 qq = (rb) ? *(const bf16x8*)(Q1_lds + (rgi * 32 + r32q) * 256 + (((mp * 8 + d0 * 2 + hiq) ^ (r32q & 7)) << 4)) : qr[d0]; \
            p[rb][0] = __builtin_amdgcn_mfma_f32_32x32x16_bf16(k0, qq, p[rb][0], 0, 0, 0); p[rb][1] = __builtin_amdgcn_mfma_f32_32x32x16_bf16(k1, qq, p[rb][1], 0, 0, 0); \
            SBAR(); } } while (0)
#define ROWMAX(rb, pm) do { pm = fmaxf(sm_max16(p[rb][0]), sm_max16(p[rb][1])); \
        auto rr = __builtin_amdgcn_permlane32_swap(__float_as_uint(pm), __float_as_uint(pm), false, false); pm = fmaxf(__uint_as_float(rr[0]), __uint_as_float(rr[1])); } while (0)
        QK_ALL();
        bf16x8 pa[2][4]; float psv[2];
#pragma unroll
        for (int rb = 0; rb < 2; ++rb) {
            float al = 1.f; bool raw = (j == 0);
            if (!raw) {
                EXPSUM(rb);
                if (__builtin_expect(__any(!(psv[rb] <= 256.f)), 0)) {
                    float pm; ROWMAX(rb, pm);
                    if (__any(!(pm < 3e38f))) raw = true;
                    else { float d = fmaxf(__builtin_amdgcn_logf(pm), 0.f); const float mnew = __uint_as_float(pk2(0.f, m_reg[rb] + d) & 0xffff0000u); d = mnew - m_reg[rb]; m_reg[rb] = mnew;
                        al = __builtin_amdgcn_exp2f(-d); psv[rb] *= al;
#pragma unroll
                        for (int r = 0; r < 16; ++r) { p[rb][0][r] *= al; p[rb][1][r] *= al; } } } }
            if (__builtin_expect(raw, 0)) {
                if (j != 0) QK_ONE(rb);
                float pm; ROWMAX(rb, pm);
                const float mnew = __uint_as_float(pk2(0.f, m_reg[rb] + (j == 0 ? pm : fmaxf(pm, 0.f))) & 0xffff0000u), d = mnew - m_reg[rb];
                m_reg[rb] = mnew; al = __builtin_amdgcn_exp2f(-d); sm_sub(p[rb][0], d); sm_sub(p[rb][1], d);
                EXPSUM(rb); }
            const float ps = psv[rb];
            l_reg[rb] = l_reg[rb] * al + ps;
#define PK4(P, BASE, OUT) do { unsigned a0 = cvtpk(P[BASE + 0], P[BASE + 1]), a1 = cvtpk(P[BASE + 2], P[BASE + 3]);   \
    unsigned b0 = cvtpk(P[BASE + 4], P[BASE + 5]), b1 = cvtpk(P[BASE + 6], P[BASE + 7]);                              \
    v4u w = {a0, a1, b0, b1}; OUT = __builtin_bit_cast(bf16x8, w); } while (0)
            PK4(p[rb][0], 0, pa[rb][0]); PK4(p[rb][0], 8, pa[rb][1]); PK4(p[rb][1], 0, pa[rb][2]); PK4(p[rb][1], 8, pa[rb][3]);
#undef PK4
            if (__any(al < 1.f)) { float* al_l = wsf + 64 + rb * 32; if (hi == 0) al_l[r32] = al; asm volatile("s_waitcnt lgkmcnt(0)" ::: "memory");
#pragma unroll
                for (int d = 0; d < 4; ++d)
#pragma unroll
                    for (int r = 0; r < 16; ++r) o[rb][d][r] *= al_l[crow(r, hi)]; }
        }
#undef QK_ALL
#undef QK_ONE
#undef ROWMAX
#undef EXPSUM
#define PV_READ(D0, v) do { v[0] = tr_read<((0) * 4 + D0) * 512>(vb); v[1] = tr_read<((1) * 4 + D0) * 512>(vb); v[2] = tr_read<((2) * 4 + D0) * 512>(vb); v[3] = tr_read<((3) * 4 + D0) * 512>(vb); \
        v[4] = tr_read<((4) * 4 + D0) * 512>(vb); v[5] = tr_read<((5) * 4 + D0) * 512>(vb); v[6] = tr_read<((6) * 4 + D0) * 512>(vb); v[7] = tr_read<((7) * 4 + D0) * 512>(vb); } while (0)
#define PV_MMA(D0, v) do { \
        const bf16x8 f0 = (bf16x8){v[0][0], v[0][1], v[0][2], v[0][3], v[1][0], v[1][1], v[1][2], v[1][3]}, f1 = (bf16x8){v[2][0], v[2][1], v[2][2], v[2][3], v[3][0], v[3][1], v[3][2], v[3][3]}; \
        const bf16x8 f2 = (bf16x8){v[4][0], v[4][1], v[4][2], v[4][3], v[5][0], v[5][1], v[5][2], v[5][3]}, f3 = (bf16x8){v[6][0], v[6][1], v[6][2], v[6][3], v[7][0], v[7][1], v[7][2], v[7][3]}; \
        _Pragma("unroll") for (int rb = 0; rb < 2; ++rb) { o[rb][D0] = __builtin_amdgcn_mfma_f32_32x32x16_bf16(pa[rb][0], f0, o[rb][D0], 0, 0, 0); o[rb][D0] = __builtin_amdgcn_mfma_f32_32x32x16_bf16(pa[rb][1], f1, o[rb][D0], 0, 0, 0); \
            o[rb][D0] = __builtin_amdgcn_mfma_f32_32x32x16_bf16(pa[rb][2], f2, o[rb][D0], 0, 0, 0); o[rb][D0] = __builtin_amdgcn_mfma_f32_32x32x16_bf16(pa[rb][3], f3, o[rb][D0], 0, 0, 0); } } while (0)
        { s16x4 va[8], vc[8];
          PV_READ(0, va);
          PV_READ(1, vc); asm volatile("s_waitcnt lgkmcnt(8)" ::: "memory"); SBAR(); PV_MMA(0, va); SBAR();
          PV_READ(2, va); asm volatile("s_waitcnt lgkmcnt(8)" ::: "memory"); SBAR(); PV_MMA(1, vc); SBAR();
          PV_READ(3, vc); asm volatile("s_waitcnt lgkmcnt(8)" ::: "memory"); SBAR(); PV_MMA(2, va); SBAR();
          asm volatile("s_waitcnt lgkmcnt(0)" ::: "memory"); SBAR(); PV_MMA(3, vc); }
#undef PV_READ
#undef PV_MMA
        DMA_WAIT_BAR();
    }
    float* xch = (float*)lds;
    int tide_ = tid; asm volatile("" : "+v"(tide_)); const int lanee = tide_ & 63, r32e = lanee & 31, hie = lanee >> 5;
#pragma unroll
    for (int rb = 0; rb < 2; ++rb) {
        float* li_l = wsf + rb * 32;
        if (hie == 0) li_l[r32e] = l_reg[rb]; asm volatile("s_waitcnt lgkmcnt(0)" ::: "memory");
        float rli[16];
#pragma unroll
        for (int r = 0; r < 16; ++r) rli[r] = __builtin_amdgcn_rcpf(li_l[crow(r, hie)]);
        if (rb) __syncthreads();
        if (mp == 1) {
#pragma unroll
            for (int d0 = 0; d0 < 4; ++d0)
#pragma unroll
                for (int r = 0; r < 16; ++r) xch[((rgi * 4 + d0) * 16 + r) * 64 + lanee] = o[rb][d0][r] * rli[r] * lam; }
        __syncthreads();
        if (mp == 0) {
#pragma unroll
            for (int d0 = 0; d0 < 4; ++d0)
#pragma unroll
                for (int r = 0; r < 16; ++r) o[rb][d0][r] = o[rb][d0][r] * rli[r] - xch[((rgi * 4 + d0) * 16 + r) * 64 + lanee];
            float g4[4];
#pragma unroll
            for (int d0 = 0; d0 < 4; ++d0) g4[d0] = subg[d0 * 32 + r32e] * oscale;
#pragma unroll
            for (int r = 0; r < 16; ++r) {
                float s = (o[rb][0][r] * o[rb][0][r] + o[rb][1][r] * o[rb][1][r]) + (o[rb][2][r] * o[rb][2][r] + o[rb][3][r] * o[rb][3][r]);
#define S_DPP(ctrl) s += __builtin_bit_cast(float, __builtin_amdgcn_update_dpp(0, __builtin_bit_cast(int, s), (ctrl), 0xF, 0xF, true))
                S_DPP(0xB1); S_DPP(0x4E); S_DPP(0x141); S_DPP(0x140);
#undef S_DPP
                { const unsigned u_ = __builtin_bit_cast(unsigned, s); auto rr_ = __builtin_amdgcn_permlane16_swap(u_, u_, false, false); s = __builtin_bit_cast(float, (unsigned)rr_[0]) + __builtin_bit_cast(float, (unsigned)rr_[1]); }
                const float rstd = __builtin_amdgcn_rsqf(s * (1.f / 128.f) + NORM_EPS);
                bf16* orow = O + (rb0 + q0 + rgi * 64 + rb * 32 + crow(r, hie)) * DM + h * 128 + r32e;
#pragma unroll
                for (int d0 = 0; d0 < 4; ++d0) orow[d0 * 32] = (bf16)(pk2(o[rb][d0][r] * rstd * g4[d0], 0.f) & 0xffffu);
            }
        }
    }
    __syncthreads();
#undef DMA1
#undef DMA_TILE
#undef DMA_WAIT_BAR
}

constexpr int WA_LD = 1536, SHM_T64 = 64 * 64 * 2;
#define KSWZ64(row, colB) ((row) * 128 + ((colB) ^ (((row) & 7) << 4)))
__device__ __forceinline__ void wa_unit(const bf16* __restrict__ QKV, bf16* __restrict__ O, int b, int g, int blk, const float* __restrict__ sink, char* lds, int wv) {
    const int tid = opaque_tid(wv), wid = tid >> 6, lane = tid & 63, r32 = lane & 31, hi = lane >> 5, hd = wid >> 1, hf = wid & 1;
    char* V_lds = lds; char* K_lds = lds + 2 * SHM_T;
    float* wsf = (float*)(lds + 4 * SHM_T) + wid * 64; float* li_l = wsf; float* al_l = wsf + 32;
    const size_t rb = (size_t)b * RPB;
    const bool isctx = blk < 4; const int q0 = (blk - 4) * 64;
    const int NT = isctx ? 4 : 10;
    float m_reg = -1e30f, l_reg = 0.f; f32x16 o[2] = {}; bf16x8 qr[4];
    const bf16* Qw = QKV + (rb + blk * 64 + hf * 32 + r32) * WA_LD + (g * 4 + hd) * 64 + hi * 8;
#pragma unroll
    for (int d0 = 0; d0 < 4; ++d0) qr[d0] = *(const bf16x8*)(Qw + d0 * 16);
    const bf16* Kh = QKV + rb * WA_LD + 1024 + g * 64; const bf16* Vh = Kh + 256;
    const int sr = tid >> 3, sc = (tid & 7) * 8, vst = v_st<2>(sr, sc);
    const int vb0 = (int)(uintptr_t)V_lds + v_rd_base(lane);
    const int qp = q0 + hf * 32 + r32;
#define TKP(t) (q0 - 128 + 64 * ((t) - 4))
#define TROW(t) (((t) < 4) ? 64 * (t) : (((t) < 9 && TKP(t) >= 0 && TKP(t) < SEQL) ? CTXL + TKP(t) : 0))
    bf16x8 vsA, ksA, vsB, ksB;
#define SLOADA(t) do { const int k0_ = TROW(t); vsA = *(const bf16x8*)(Vh + (size_t)(k0_ + sr) * WA_LD + sc); ksA = *(const bf16x8*)(Kh + (size_t)(k0_ + sr) * WA_LD + sc); } while (0)
#define SLOADB(t) do { const int k0_ = TROW(t); vsB = *(const bf16x8*)(Vh + (size_t)(k0_ + sr) * WA_LD + sc); ksB = *(const bf16x8*)(Kh + (size_t)(k0_ + sr) * WA_LD + sc); } while (0)
#define SWRITE(bq, V0, K0) do { *(bf16x8*)(V_lds + (bq) * SHM_T + vst) = V0; *(bf16x8*)(K_lds + (bq) * SHM_T + KSWZ64(sr, sc * 2)) = K0; } while (0)
#define SWAIT() asm volatile("s_waitcnt vmcnt(2)" ::: "memory")
#define RESC(al) do { if (__any((al) < 1.f)) { if (hi == 0) al_l[r32] = (al); asm volatile("s_waitcnt lgkmcnt(0)" ::: "memory"); \
    _Pragma("unroll") for (int d = 0; d < 2; ++d) _Pragma("unroll") for (int r = 0; r < 16; ++r) o[d][r] *= al_l[crow(r, hi)]; } } while (0)
#define MASKT(P0, P1, t) do { if ((t) >= 4) { const int kp0_ = TKP(t); const bool tv_ = ((t) < 9) && kp0_ >= 0 && kp0_ < SEQL; \
    if (!tv_) { _Pragma("unroll") for (int r = 0; r < 16; ++r) { P0[r] = -1e30f; P1[r] = -1e30f; } }                  \
    else if ((t) == 4 || (t) == 8) {                                                                                  \
    _Pragma("unroll") for (int r = 0; r < 16; ++r) { const int d0_ = qp - (kp0_ + crow(r, hi)); const int d1_ = d0_ - 32; \
        if (d0_ > 128 || d0_ < -128) P0[r] = -1e30f; if (d1_ > 128 || d1_ < -128) P1[r] = -1e30f; } } } } while (0)
#define QKT(P0, P1, KB, t) do { P0 = f32x16{}; P1 = f32x16{}; _Pragma("unroll") for (int d0 = 0; d0 < 4; ++d0) { const int cb = (d0 * 16 + hi * 8) * 2; \
    const bf16x8 b0 = *(const bf16x8*)((KB) + KSWZ64(r32, cb)); const bf16x8 b1 = *(const bf16x8*)((KB) + KSWZ64(32 + r32, cb)); \
    P0 = __builtin_amdgcn_mfma_f32_32x32x16_bf16(b0, qr[d0], P0, 0, 0, 0); P1 = __builtin_amdgcn_mfma_f32_32x32x16_bf16(b1, qr[d0], P1, 0, 0, 0); } MASKT(P0, P1, t); } while (0)
#define PV2(VB) do { pv_one<0, 2>(o[0], VB, pa0, pa1, pa2, pa3); pv_one<1, 2>(o[1], VB, pa0, pa1, pa2, pa3); } while (0)
    f32x16 pA0, pA1, pB0, pB1; float mnA, mnB, alA, alB; bf16x8 pa0, pa1, pa2, pa3;
    SLOADA(0); asm volatile("s_waitcnt vmcnt(0)" ::: "memory"); SWRITE(0, vsA, ksA); __syncthreads();
    QKT(pA0, pA1, K_lds, 0); partialSM(pA0, pA1, m_reg, mnA, alA);
    SLOADB(1); if (2 < NT) SLOADA(2);
    SWAIT(); SWRITE(1, vsB, ksB); __syncthreads();
    for (int j = 1; j + 1 < NT; j += 2) {
        SBAR(); QKT(pB0, pB1, K_lds + SHM_T, j);
        finishSM(pA0, pA1, alA, l_reg, pa0, pa1, pa2, pa3); SBAR();
        SLOADB(j + 2); SBAR();
        PV2(vb0); partialSM(pB0, pB1, m_reg, mnB, alB);
        __syncthreads(); SWAIT(); SWRITE(0, vsA, ksA);
        RESC(alB); __syncthreads();
        SBAR(); QKT(pA0, pA1, K_lds, j + 1);
        finishSM(pB0, pB1, alB, l_reg, pa0, pa1, pa2, pa3); SBAR();
        if (j + 3 < NT) SLOADA(j + 3); SBAR();
        PV2(vb0 + SHM_T); partialSM(pA0, pA1, m_reg, mnA, alA);
        __syncthreads(); SWAIT(); SWRITE(1, vsB, ksB);
        RESC(alA); __syncthreads();
    }
    SBAR(); QKT(pB0, pB1, K_lds + SHM_T, NT - 1);
    finishSM(pA0, pA1, alA, l_reg, pa0, pa1, pa2, pa3); SBAR();
    PV2(vb0); partialSM(pB0, pB1, m_reg, mnB, alB);
    __syncthreads(); RESC(alB);
    finishSM(pB0, pB1, alB, l_reg, pa0, pa1, pa2, pa3); SBAR();
    PV2(vb0 + SHM_T);
    l_reg += __builtin_amdgcn_exp2f(sink[g * 4 + hd] * 1.4426950408889634f - m_reg);
    if (hi == 0) li_l[r32] = l_reg; asm volatile("s_waitcnt lgkmcnt(0)" ::: "memory");
#pragma unroll
    for (int r = 0; r < 16; ++r) { const float rl = __builtin_amdgcn_rcpf(li_l[crow(r, hi)]);
        bf16* orow = O + (rb + blk * 64 + hf * 32 + crow(r, hi)) * DM + (g * 4 + hd) * 64 + r32;
        orow[0] = (bf16)(pk2(o[0][r] * rl, 0.f) & 0xffffu); orow[32] = (bf16)(pk2(o[1][r] * rl, 0.f) & 0xffffu); }
    __syncthreads();
#undef TKP
#undef TROW
#undef SLOADA
#undef SLOADB
#undef SWRITE
#undef SWAIT
#undef RESC
#undef MASKT
#undef QKT
#undef PV2
}
#undef KSWZ
#undef KSWZ64
#undef SBAR
}

namespace ret {
constexpr int LD = 6144, QS = 528, VS = 272, PS = 144, C = 64;
constexpr int L_Q = 0, L_K = 64 * QS, L_V = 2 * 64 * QS, L_P = L_V + 64 * VS, L_T = L_P + 64 * PS  , L_END = L_T + 80 * 4;
static_assert(L_END <= 131072, "retention LDS");
template <int O0, int O1, int O2, int O3> __device__ __forceinline__ void tr4(unsigned base, s16x4& a, s16x4& b, s16x4& c, s16x4& d) {
    asm volatile("ds_read_b64_tr_b16 %0, %4 offset:%5\n\tds_read_b64_tr_b16 %1, %4 offset:%6\n\tds_read_b64_tr_b16 %2, %4 offset:%7\n\tds_read_b64_tr_b16 %3, %4 offset:%8\n\ts_waitcnt lgkmcnt(0)"
                 : "=&v"(a), "=&v"(b), "=&v"(c), "=&v"(d) : "v"(base), "i"(O0), "i"(O1), "i"(O2), "i"(O3) : "memory");
}
template <int O0, int O1, int O2, int O3> __device__ __forceinline__ void tr4n(unsigned base, s16x4& a, s16x4& b, s16x4& c, s16x4& d) {
    asm volatile("ds_read_b64_tr_b16 %0, %4 offset:%5\n\tds_read_b64_tr_b16 %1, %4 offset:%6\n\tds_read_b64_tr_b16 %2, %4 offset:%7\n\tds_read_b64_tr_b16 %3, %4 offset:%8"
                 : "=&v"(a), "=&v"(b), "=&v"(c), "=&v"(d) : "v"(base), "i"(O0), "i"(O1), "i"(O2), "i"(O3) : "memory");
}
template <int O0, int O1, int O2, int O3> __device__ __forceinline__ void tr8(unsigned base0, unsigned base1, s16x4& a, s16x4& b, s16x4& c, s16x4& d, s16x4& e, s16x4& f, s16x4& g, s16x4& h) {
    asm volatile("ds_read_b64_tr_b16 %0, %8 offset:%10\n\tds_read_b64_tr_b16 %1, %8 offset:%11\n\tds_read_b64_tr_b16 %2, %8 offset:%12\n\tds_read_b64_tr_b16 %3, %8 offset:%13\n\t"
                 "ds_read_b64_tr_b16 %4, %9 offset:%10\n\tds_read_b64_tr_b16 %5, %9 offset:%11\n\tds_read_b64_tr_b16 %6, %9 offset:%12\n\tds_read_b64_tr_b16 %7, %9 offset:%13\n\ts_waitcnt lgkmcnt(0)"
                 : "=&v"(a), "=&v"(b), "=&v"(c), "=&v"(d), "=&v"(e), "=&v"(f), "=&v"(g), "=&v"(h) : "v"(base0), "v"(base1), "i"(O0), "i"(O1), "i"(O2), "i"(O3) : "memory");
}
__device__ __forceinline__ bf16x8 cat4(s16x4 l, s16x4 h) { return (bf16x8){l[0], l[1], l[2], l[3], h[0], h[1], h[2], h[3]}; }
__device__ __forceinline__ bf16x8 scale8(bf16x8 v, const float* sc) {
    v4u w = __builtin_bit_cast(v4u, v); v4u o;
    o.x = pk2(bflo(w.x) * sc[0], bfhi(w.x) * sc[1]); o.y = pk2(bflo(w.y) * sc[2], bfhi(w.y) * sc[3]);
    o.z = pk2(bflo(w.z) * sc[4], bfhi(w.z) * sc[5]); o.w = pk2(bflo(w.w) * sc[6], bfhi(w.w) * sc[7]);
    return __builtin_bit_cast(bf16x8, o);
}
constexpr int VS2 = 528, L2_Q = 0, L2_K = 64 * QS, L2_V = 2 * 64 * QS, L2_P = 3 * 64 * QS, L2_T = L2_P + 64 * PS, L2_END = L2_T + 80 * 4;
static_assert(L2_END <= 131072, "retention LDS (v2)");
__device__ __forceinline__ void ret_unit2(const bf16* __restrict__ QKVG, bf16* __restrict__ OB, bf16* __restrict__ OBL, bf16* __restrict__ OBC, const float* __restrict__ dlogit, int b, int h, int dir, int hv, char* lds, int wv) {
    const int tid0 = opaque_tid(wv), wid = __builtin_amdgcn_readfirstlane(tid0 >> 6);
    const size_t rb = (size_t)b * RPB;
    const unsigned ldsb = (unsigned)(uintptr_t)lds;
    const bf16* Qg = QKVG + rb * LD + h * 256; const bf16* Kg = Qg + 1024; const bf16* Vg = QKVG + rb * LD + 2048 + h * 512 + hv * 256;
    const int ocol = h * 512 + hv * 256 + wid * 32;
    bf16x8 sq[4], sk[4], sv[4];
#define R2LOADQK(row0) do { _Pragma("unroll") for (int i = 0; i < 4; ++i) { const int p = tid + 512 * i; sq[i] = *(const bf16x8*)(Qg + (size_t)((row0) + (p >> 5)) * LD + (p & 31) * 8); sk[i] = *(const bf16x8*)(Kg + (size_t)((row0) + (p >> 5)) * LD + (p & 31) * 8); } } while (0)
#define R2LOADV(row0) do { _Pragma("unroll") for (int i = 0; i < 4; ++i) { const int p = tid + 512 * i; sv[i] = *(const bf16x8*)(Vg + (size_t)((row0) + (p >> 5)) * LD + (p & 31) * 8); } } while (0)
#define R2WRITEQK() do { _Pragma("unroll") for (int i = 0; i < 4; ++i) { const int p = tid + 512 * i; *(bf16x8*)(lds + L2_Q + (p >> 5) * QS + (p & 31) * 16) = sq[i]; *(bf16x8*)(lds + L2_K + (p >> 5) * QS + (p & 31) * 16) = sk[i]; } } while (0)
#define R2WRITEV() do { _Pragma("unroll") for (int i = 0; i < 4; ++i) { const int p = tid + 512 * i; *(bf16x8*)(lds + L2_V + (p >> 5) * VS2 + (p & 31) * 16) = sv[i]; } } while (0)
    const float x = dlogit[dir * 4 + h];
    const float lg2d = -log1pf(expf(-x)) * 1.4426950408889634f;
    f32x4 S[16][2];
#pragma unroll
    for (int mb = 0; mb < 16; ++mb) { S[mb][0] = (f32x4){0.f, 0.f, 0.f, 0.f}; S[mb][1] = (f32x4){0.f, 0.f, 0.f, 0.f}; }
    const float gC = __builtin_amdgcn_exp2f(lg2d * (float)C);
    __syncthreads(); if (tid0 < 65) ((float*)(lds + L2_T))[tid0] = __builtin_amdgcn_exp2f(lg2d * (float)tid0); __syncthreads();
    const float* DT = (const float*)(lds + L2_T);
#define CROW(step) ((dir == 0) ? 64 * (step) : (((step) < 4) ? 64 * (3 - (step)) : CTXL + 64 * (67 - (step))))
    { int tid = tid0; asm volatile("" : "+v"(tid)); R2LOADQK(CROW(0)); }
    for (int step = 0; step < 68; ++step) {
        const int row0 = CROW(step);
        int tid = tid0; asm volatile("" : "+v"(tid));
        R2WRITEQK(); R2LOADV(row0); __syncthreads();
        if (step + 1 < 68) { const int rown = CROW(step + 1); R2LOADQK(rown); }
        asm volatile("" : "+v"(tid)); const int lane = tid & 63, l15 = lane & 15, g = lane >> 4;
        { const int qb = wid >> 1, tb0 = 2 * (wid & 1); f32x4 sc2[2] = {(f32x4){0.f, 0.f, 0.f, 0.f}, (f32x4){0.f, 0.f, 0.f, 0.f}};
#pragma unroll
          for (int s = 0; s < 8; ++s) { const bf16x8 af = *(const bf16x8*)(lds + L2_Q + (16 * qb + l15) * QS + (32 * s + 8 * g) * 2);
              const bf16x8 bf0 = *(const bf16x8*)(lds + L2_K + (16 * tb0 + l15) * QS + (32 * s + 8 * g) * 2), bf1 = *(const bf16x8*)(lds + L2_K + (16 * tb0 + 16 + l15) * QS + (32 * s + 8 * g) * 2);
              sc2[0] = __builtin_amdgcn_mfma_f32_16x16x32_bf16(af, bf0, sc2[0], 0, 0, 0); sc2[1] = __builtin_amdgcn_mfma_f32_16x16x32_bf16(af, bf1, sc2[1], 0, 0, 0); }
#pragma unroll
          for (int tt = 0; tt < 2; ++tt) { const int tb = tb0 + tt; const f32x4 sc = sc2[tt];
#pragma unroll
              for (int r = 0; r < 4; ++r) { const int i = 16 * qb + 4 * g + r, j = 16 * tb + l15; const int d = (dir == 0) ? (i - j) : (j - i);
                  const bool keep = (dir == 0) ? (d >= 0) : (d > 0);
                  const float pv = keep ? sc[r] * DT[d & 63] : 0.f;
                  *(bf16*)(lds + L2_P + i * PS + j * 2) = (bf16)(pk2(pv, 0.f) & 0xffffu); } } }
        f32x4 oi[4][2];
#pragma unroll
          for (int qb = 0; qb < 4; ++qb) { oi[qb][0] = (f32x4){0.f, 0.f, 0.f, 0.f}; oi[qb][1] = (f32x4){0.f, 0.f, 0.f, 0.f}; }
#pragma unroll
          for (int s = 0; s < 8; ++s) { v4u bw[2];
#pragma unroll
              for (int nb = 0; nb < 2; ++nb) { bw[nb].x = pk2(S[2 * s][nb][0], S[2 * s][nb][1]); bw[nb].y = pk2(S[2 * s][nb][2], S[2 * s][nb][3]); bw[nb].z = pk2(S[2 * s + 1][nb][0], S[2 * s + 1][nb][1]); bw[nb].w = pk2(S[2 * s + 1][nb][2], S[2 * s + 1][nb][3]); }
#pragma unroll
              for (int qb = 0; qb < 4; ++qb) { const char* qp = lds + L2_Q + (16 * qb + l15) * QS + (32 * s + 4 * g) * 2;
                  const v2u a0 = *(const v2u*)qp, a1 = *(const v2u*)(qp + 32);
                  v4u aw = {a0.x, a0.y, a1.x, a1.y};
                  oi[qb][0] = __builtin_amdgcn_mfma_f32_16x16x32_bf16(__builtin_bit_cast(bf16x8, aw), __builtin_bit_cast(bf16x8, bw[0]), oi[qb][0], 0, 0, 0);
                  oi[qb][1] = __builtin_amdgcn_mfma_f32_16x16x32_bf16(__builtin_bit_cast(bf16x8, aw), __builtin_bit_cast(bf16x8, bw[1]), oi[qb][1], 0, 0, 0); } }
        R2WRITEV();
        __syncthreads();
        int tid2 = tid0; asm volatile("" : "+v"(tid2)); const int lane2 = tid2 & 63, trq = (lane2 & 15) >> 2, trp = lane2 & 3, g2 = lane2 >> 4;
        const unsigned vtr = ldsb + L2_V + (8 * g2 + trq) * VS2 + (wid * 32 + 4 * trp) * 2;
        const unsigned ktr = ldsb + L2_K + (8 * g2 + trq) * QS + (4 * trp) * 2;
        bf16x8 vf[2][2];
#pragma unroll
        for (int nb = 0; nb < 2; ++nb) { s16x4 v00, v01, v10, v11; tr4<0, 4 * VS2, 32 * VS2, 36 * VS2>(vtr + nb * 32, v00, v01, v10, v11); vf[0][nb] = cat4(v00, v01); vf[1][nb] = cat4(v10, v11); }
        {
          bf16* Obase = (dir == 0) ? OB + (rb + row0) * 2048 : ((row0 < CTXL) ? OBC + ((size_t)b * CTXL + row0) * 2048 : OBL + ((size_t)b * SEQL + (row0 - CTXL)) * 2048);
#pragma unroll
          for (int qb = 0; qb < 4; ++qb) {
            const bf16x8 p0 = *(const bf16x8*)(lds + L2_P + (16 * qb + l15) * PS + (8 * g) * 2), p1 = *(const bf16x8*)(lds + L2_P + (16 * qb + l15) * PS + (32 + 8 * g) * 2);
#pragma unroll
            for (int nb = 0; nb < 2; ++nb) { f32x4 oo;
#pragma unroll
                for (int r = 0; r < 4; ++r) { const int i = 16 * qb + 4 * g + r; oo[r] = oi[qb][nb][r] * DT[dir == 0 ? (i + 1) : (C - i)]; }
                oo = __builtin_amdgcn_mfma_f32_16x16x32_bf16(p0, vf[0][nb], oo, 0, 0, 0);
                oo = __builtin_amdgcn_mfma_f32_16x16x32_bf16(p1, vf[1][nb], oo, 0, 0, 0);
#pragma unroll
                for (int r = 0; r < 4; ++r) *(Obase + (size_t)(16 * qb + 4 * g + r) * 2048 + ocol + nb * 16 + l15) = (bf16)(pk2(oo[r], 0.f) & 0xffffu); } } }
        { float vsc0[8], vsc1[8];
#pragma unroll
          for (int j = 0; j < 8; ++j) { const int t = 8 * g2 + j; vsc0[j] = DT[dir == 0 ? (C - 1 - t) : t]; vsc1[j] = DT[dir == 0 ? (C - 33 - t) : (t + 32)]; }
          bf16x8 vs[2][2];
#pragma unroll
          for (int nb = 0; nb < 2; ++nb) { vs[0][nb] = scale8(vf[0][nb], vsc0); vs[1][nb] = scale8(vf[1][nb], vsc1); }
#pragma unroll
          for (int mg = 0; mg < 8; ++mg) { s16x4 kk[2][4];
              tr8<0, 4 * QS, 32 * QS, 36 * QS>(ktr + (mg * 2) * 32, ktr + (mg * 2 + 1) * 32, kk[0][0], kk[0][1], kk[0][2], kk[0][3], kk[1][0], kk[1][1], kk[1][2], kk[1][3]);
#pragma unroll
              for (int q = 0; q < 2; ++q) { const int mb = mg * 2 + q; const bf16x8 k0f = cat4(kk[q][0], kk[q][1]), k1f = cat4(kk[q][2], kk[q][3]);
#pragma unroll
                  for (int nb = 0; nb < 2; ++nb) { f32x4 sn = S[mb][nb] * gC;
                      sn = __builtin_amdgcn_mfma_f32_16x16x32_bf16(k0f, vs[0][nb], sn, 0, 0, 0);
                      sn = __builtin_amdgcn_mfma_f32_16x16x32_bf16(k1f, vs[1][nb], sn, 0, 0, 0);
                      S[mb][nb] = sn; } } } }
        __syncthreads();
    }
#undef CROW
#undef R2LOADQK
#undef R2LOADV
#undef R2WRITEQK
#undef R2WRITEV
}
__device__ __forceinline__ void ret_finish2(const bf16* __restrict__ QKVG, bf16* __restrict__ OB, const bf16* __restrict__ OBL, const bf16* __restrict__ OBC, unsigned char* __restrict__ O8, int G, int wv) {
    const int tid = opaque_tid(wv), lane = tid & 63, gw = (int)blockIdx.x * NWAVES + __builtin_amdgcn_readfirstlane(tid >> 6), NGW = G * NWAVES;
    for (int it0 = gw; it0 < TA * 4; it0 += 2 * NGW) {
        v4u ow[2], gwv[2], bw[2]; bf16* opv[2]; bool ok[2];
#pragma unroll
        for (int u = 0; u < 2; ++u) { const int it = it0 + u * NGW; ok[u] = it < TA * 4; const int itq = ok[u] ? it : it0; const int r = itq >> 2, h = itq & 3; const int b = r / RPB, p = r - b * RPB;
            opv[u] = OB + (size_t)r * 2048 + h * 512 + lane * 8; const bf16* gp = QKVG + (size_t)r * LD + 4096 + h * 512 + lane * 8;
            const bf16* bp = ((p < CTXL) ? OBC + ((size_t)b * CTXL + p) * 2048 : OBL + ((size_t)b * SEQL + (p - CTXL)) * 2048) + h * 512 + lane * 8;
            ow[u] = *(const v4u*)opv[u]; gwv[u] = *(const v4u*)gp; bw[u] = *(const v4u*)bp; }
#pragma unroll
        for (int u = 0; u < 2; ++u) if (ok[u]) {
            float o[8] = {bflo(ow[u].x) + bflo(bw[u].x), bfhi(ow[u].x) + bfhi(bw[u].x), bflo(ow[u].y) + bflo(bw[u].y), bfhi(ow[u].y) + bfhi(bw[u].y), bflo(ow[u].z) + bflo(bw[u].z), bfhi(ow[u].z) + bfhi(bw[u].z), bflo(ow[u].w) + bflo(bw[u].w), bfhi(ow[u].w) + bfhi(bw[u].w)};
            float gg[8] = {bflo(gwv[u].x), bfhi(gwv[u].x), bflo(gwv[u].y), bfhi(gwv[u].y), bflo(gwv[u].z), bfhi(gwv[u].z), bflo(gwv[u].w), bfhi(gwv[u].w)};
            float ss = 0.f;
#pragma unroll
            for (int j = 0; j < 8; ++j) ss += o[j] * o[j];
            const float rstd = __builtin_amdgcn_rsqf(wave_sum(ss) * (1.f / 512.f) + NORM_EPS);
#pragma unroll
            for (int j = 0; j < 8; ++j) o[j] = o[j] * rstd * (gg[j] * __builtin_amdgcn_rcpf(1.f + __builtin_amdgcn_exp2f(-LOG2E_F * gg[j])));
            v4u w; w.x = pk2(o[0], o[1]); w.y = pk2(o[2], o[3]); w.z = pk2(o[4], o[5]); w.w = pk2(o[6], o[7]);
            if (O8) { const int it = it0 + u * NGW; const int r = it >> 2, h = it & 3; v2u w8; w8.x = pg8::pack4_fp8(o[0] * A8_SCALE, o[1] * A8_SCALE, o[2] * A8_SCALE, o[3] * A8_SCALE); w8.y = pg8::pack4_fp8(o[4] * A8_SCALE, o[5] * A8_SCALE, o[6] * A8_SCALE, o[7] * A8_SCALE);
                *(v2u*)(O8 + (size_t)r * 2048 + h * 512 + lane * 8) = w8; }
            else *(v4u*)opv[u] = w; } }
}
}

__device__ __forceinline__ void moe_gather(unsigned char* ws, const float* outp, int ml, int G, int wv) {
    const int tid = opaque_tid(wv), lane = tid & 63, gw = (int)blockIdx.x * NWAVES + __builtin_amdgcn_readfirstlane(tid >> 6), NGW = G * NWAVES;
    gu32* ctl = (gu32*)(ws + WS_CTL);
    int cum[9], ts[9]; cum[0] = 0; ts[0] = 0;
#pragma unroll
    for (int e = 0; e < 8; ++e) { const unsigned c = (unsigned)__builtin_amdgcn_readfirstlane((int)__hip_atomic_load(ctl + CW_MOECNT + 16 * ml + e, RLX_AGENT)); cum[e + 1] = cum[e] + (int)c; ts[e + 1] = ts[e] + (int)((c + 255u) >> 8); }
    const int* lists = (const int*)(ws + WS_LISTS); unsigned char* BUF = ws + BIG_BUF;
    for (int i = gw; i < cum[8]; i += 3 * NGW) {
        int tok[3]; size_t slot[3]; bool ok[3];
#pragma unroll
        for (int u = 0; u < 3; ++u) { const int iu = i + u * NGW; ok[u] = iu < cum[8];
            int e = 0;
#pragma unroll
            for (int k = 1; k < 8; ++k) e += (iu >= cum[k]) ? 1 : 0;
            int ce = 0, te = 0;
#pragma unroll
            for (int k = 0; k < 8; ++k) { ce = (k == e) ? cum[k] : ce; te = (k == e) ? ts[k] : te; }
            const int rank = iu - ce; tok[u] = ok[u] ? lists[(size_t)e * TA + rank] : 0; slot[u] = (size_t)te * 256 + rank; }
        v4u o[3];
#pragma unroll
        for (int u = 0; u < 3; ++u) o[u] = *((const v4u*)((const unsigned char*)outp + A8_OFF + (size_t)tok[u] * DM) + lane);
#pragma unroll
        for (int u = 0; u < 3; ++u) if (ok[u]) *((v4u*)(BUF + slot[u] * DM) + lane) = o[u];
    }
}

__global__ void __launch_bounds__(NWAVES * 64, 2) hybrid_fwd(Args args) {
    extern __shared__ __attribute__((aligned(16))) unsigned char lds[];
    LAS unsigned char* ldsl = (LAS unsigned char*)lds;
    volatile LAS unsigned* MISC = (volatile LAS unsigned*)(ldsl + MISC_OFF);
    const int tid = threadIdx.x;
    const int WV = __builtin_amdgcn_readfirstlane(tid >> 6);
    const int G = gridDim.x;
    unsigned char* ws = args.ws;
    gu32* ctl = (gu32*)(ws + WS_CTL);
    for (int u = tid; u < (LDS_BYTES - LDSCTL_OFF) / 4; u += NWAVES * 64) ((LAS unsigned*)(ldsl + LDSCTL_OFF))[u] = 0u;
    __syncthreads();
#if MK_MULTI
    XcdBarrier bar; bar.bar = (unsigned*)(ctl + CW_BAR); bar.x = 0; bar.st = nullptr; bar.wv = (unsigned)WV;
#define GRID_BAR() do { } while (0)
#else
    XcdBarrier bar = xcd_barrier_post((unsigned*)(ctl + CW_BAR), MISC + 8, (unsigned)WV);
#define GRID_BAR() xcd_barrier(bar)
#endif
#ifdef PH_ONLY
    const int lo = PH_ONLY, hi = PH_ONLY + 1; int ph = 0;
#else
    const int lo = args.ph_lo, hi = args.ph_hi; int ph = 0;
#endif
#ifndef REPEAT_PH
#define REPEAT_PH -1
#endif
    enum { PH_BASE = __COUNTER__ + 1 };
#define PHASE_BEGIN if (lo <= ph && ph < hi) { constexpr int pid_ = __COUNTER__ - PH_BASE; constexpr int nrep_ = (pid_ == REPEAT_PH) ? 2 : 1; asm volatile("; PHASE_MARK %0" :: "i"(pid_)); \
    _Pragma("unroll") for (int rep_ = 0; rep_ < nrep_; ++rep_) { if (rep_) GRID_BAR();
#define PHASE_END   } if (ph + 1 < hi) GRID_BAR(); } ++ph;

#define AY ((bf16*)args.out)
#define r2c ((const float*)(ws + WS_ROPE2))
#define r2s ((const float*)(ws + WS_ROPE2) + 64 * 16)
#define r1c ((const float*)(ws + WS_ROPE1))
#define r1s ((const float*)(ws + WS_ROPE1) + 4096 * 128)

    PHASE_BEGIN p0_prologue(args, ldsl, G, WV); PHASE_END
    PHASE_BEGIN resid_phase<0, false, false>(ws, args.out, args.in[0], args.in[2], ldsl, AY, 0, 0, 0, 0, 0, G, WV); PHASE_END

#define GEMM_PHASE8(F8, EPI, ORDER, AP, BP, NN, KK, SINIT, ...) { int kk_ = (KK); asm volatile("" : "+s"(kk_)); pg8::Gemm g{(const bf16*)(AP), (const bf16*)(BP), TA, NN, kk_}; ORDER S; SINIT; EPI E{__VA_ARGS__}; EPI_SETMODE \
        pg8::gemm_phase<EPI, ORDER, true, true, F8>(ldsl + RING_OFF, g, S, E, WV); }
#define GEMM_PHASE(...) GEMM_PHASE8(0, __VA_ARGS__)
#ifdef EPI_MODE
#define EPI_SETMODE E.mode = rep_ ? EPI_MODE : 0;
#else
#define EPI_SETMODE
#endif
#define SO_INIT(NN) S.init(TA, NN, G, (int)blockIdx.x)
#define ROPE2_LDS { LAS float* rl_ = (LAS float*)(ldsl + ROPE2_LDS_OFF); const float* rg_ = (const float*)(ws + WS_ROPE2); for (int i_ = opaque_tid(WV); i_ < 2048; i_ += NWAVES * 64) rl_[i_] = rg_[i_]; __syncthreads(); }
#define r2cl ((const LAS float*)(ldsl + ROPE2_LDS_OFF))
#define r2sl ((const LAS float*)(ldsl + ROPE2_LDS_OFF) + 64 * 16)
#define DA_INPROJ(j) PHASE_BEGIN ROPE2_LDS GEMM_PHASE(pg8::EpiRope2D, pg8::StaticOrder, AY, ws + W_DAIN + (size_t)(j) * 6 * MiB, 3072, 1024, SO_INIT(3072), (bf16*)(ws + BIG_QKV), 3072, 8, r2cl, r2sl) PHASE_END
#define DA_INPROJ8(j) PHASE_BEGIN ROPE2_LDS GEMM_PHASE8(FP8_GU, pg8::EpiRope2D, pg8::StaticOrder, (unsigned char*)args.out + A8_OFF, ws + W_DAIN + (size_t)(j) * 6 * MiB, 3072, 512, SO_INIT(3072), (bf16*)(ws + BIG_QKV), 3072, 8, r2cl, r2sl) PHASE_END
#define DA_LAYER(j, lam_init) \
    PHASE_BEGIN { const float lam = ((const float*)(ws + WS_SCAL))[j]; \
        for (int L = blockIdx.x; L < ((j) == 1 ? 2048 : 2176); L += G) { int bh, q0r, nk;     if (L < 2048) { const int c_ = L & 255; bh = 16 * (L >> 8) + (c_ & 7) + 8 * (c_ >> 7); q0r = CTXL + 256 * ((c_ >> 3) & 15); nk = RPB; } else { bh = L - 2048; q0r = 0; nk = CTXL; } \
            att::da_unit64((const bf16*)(ws + BIG_QKV), (bf16*)(ws + BIG_O), bh >> 3, bh & 7, q0r, nk, lam, 1.f - (lam_init), (const float*)(ws + WS_SMALL) + SM_SUBLN + (j) * 128, (char*)lds + RING_OFF, WV); } } PHASE_END \
    PHASE_BEGIN if ((j) == 1) GEMM_PHASE(pg8::EpiPlain, pg8::StaticOrderLat, ws + BIG_O, ws + W_DAOUT + (size_t)(j) * 2 * MiB, 1024, 1024, S.init(NBATCH * SEQL, 1024, G, (int)blockIdx.x), AY, 1024, 4, 0) \
                else GEMM_PHASE(pg8::EpiPlain, pg8::StaticOrder, ws + BIG_O, ws + W_DAOUT + (size_t)(j) * 2 * MiB, 1024, 1024, SO_INIT(1024), AY, 1024, 4, 0) PHASE_END
#define DENSE_FFN8(i) \
    PHASE_BEGIN GEMM_PHASE8(FP8_GU, pg8::EpiSwiGLU8, pg8::StaticOrder, (unsigned char*)args.out + A8_OFF, ws + W_FFNGU + (size_t)(i) * 11 * MiB, 5632, 512, SO_INIT(5632), ws + BIG_H, FFN, 22, 0, H8_SCALE) PHASE_END \
    PHASE_BEGIN GEMM_PHASE8(FP8_DN, pg8::EpiPlain, pg8::StaticOrder, ws + BIG_H, ws + W_FFNDN + (size_t)(i) * 11 * MiB / 2, 1024, FFN / 2, SO_INIT(1024), AY, 1024, 4, 0) PHASE_END
#define DENSE_FFN_H8(i) \
    PHASE_BEGIN GEMM_PHASE(pg8::EpiSwiGLU8, pg8::StaticOrder, AY, ws + W_FFNGU + (size_t)(i) * 11 * MiB, 5632, 1024, SO_INIT(5632), ws + BIG_H, FFN, 22, 0, H8_SCALE) PHASE_END \
    PHASE_BEGIN GEMM_PHASE8(FP8_DN, pg8::EpiPlain, pg8::StaticOrder, ws + BIG_H, ws + W_FFNDN + (size_t)(i) * 11 * MiB / 2, 1024, FFN / 2, SO_INIT(1024), AY, 1024, 4, 0) PHASE_END
#define DENSE_FFN(i) \
    PHASE_BEGIN GEMM_PHASE(pg8::EpiSwiGLU, pg8::StaticOrder, AY, ws + W_FFNGU + (size_t)(i) * 11 * MiB, 5632, 1024, SO_INIT(5632), (bf16*)(ws + BIG_H), FFN, 22, 0) PHASE_END \
    PHASE_BEGIN GEMM_PHASE(pg8::EpiPlain, pg8::StaticOrder, ws + BIG_H, ws + W_FFNDN + (size_t)(i) * 11 * MiB / 2, 1024, FFN, SO_INIT(1024), AY, 1024, 4, 0) PHASE_END
#define MOE_INIT(NCOL, T0, T1) { LAS int* tsl_ = (LAS int*)(ldsl + MISC_OFF + 64); int tsum_ = 0; \
        if (opaque_tid(WV) == 0) { tsl_[0] = 0; for (int e = 0; e < 8; ++e) { const unsigned c_ = __hip_atomic_load(ctl + CW_MOECNT + 16 * ml_ + e, RLX_AGENT); tsum_ += (int)((c_ + 255u) >> 8); tsl_[e + 1] = tsum_; } } \
        __syncthreads(); \
        S.ncol = NCOL; S.G = G; S.c = (int)blockIdx.x; S.tsl = tsl_; S.t0 = (T0); { const int t8_ = __builtin_amdgcn_readfirstlane(tsl_[8]); S.t1 = t8_ < (T1) ? t8_ : (T1); } }
#define MOE_FFN(ml) \
    PHASE_BEGIN moe_gather(ws, args.out, ml, G, WV); PHASE_END \
    { const int ml_ = (ml); \
        PHASE_BEGIN GEMM_PHASE8(FP8_GU, pg8::EpiSwiGLU8, pg8::MoeOrder, ws + BIG_BUF, ws + W_MOEGU + (size_t)(ml) * 56 * MiB, 7168, 512, MOE_INIT(28, 0, MOE_TILES_MAX), ws + BIG_MH, EDIM, 28, 0, H8_SCALE) PHASE_END \
        PHASE_BEGIN GEMM_PHASE8(FP8_DN, pg8::EpiPlain, pg8::MoeOrder, ws + BIG_MH, ws + W_MOEDN + (size_t)(ml) * 28 * MiB, 1024, EDIM / 2, MOE_INIT(4, 0, MOE_TILES_MAX), (bf16*)(ws + BIG_YE), 1024, 4, 0) PHASE_END }

    DA_INPROJ(0)
    DA_LAYER(0, 0.2f)
    PHASE_BEGIN resid_phase<1, false, false, (DENSE_FP8 & 1) != 0>(ws, args.out, nullptr, nullptr, ldsl, AY, 0, 0, 0, 1, 0, G, WV); PHASE_END
#if DENSE_FP8 & 1
    DENSE_FFN8(0)
#elif DENSE_H8 & 1
    DENSE_FFN_H8(0)
#else
    DENSE_FFN(0)
#endif
    PHASE_BEGIN resid_phase<1, false, false>(ws, args.out, nullptr, nullptr, ldsl, AY, 0, 1, 1, 0, 0, G, WV); PHASE_END

    PHASE_BEGIN ROPE2_LDS GEMM_PHASE(pg8::EpiRope2D, pg8::StaticOrder, AY, ws + W_WAIN, 1536, 1024, SO_INIT(1536), (bf16*)(ws + BIG_QKV), 1536, 5, r2cl, r2sl) PHASE_END
    PHASE_BEGIN { for (int L = blockIdx.x; L < 16 * 4 * 68; L += G) { const int bg = L / 68, blk = L - bg * 68;
            att::wa_unit((const bf16*)(ws + BIG_QKV), (bf16*)(ws + BIG_O), bg >> 2, bg & 3, blk, (const float*)(ws + WS_SMALL) + SM_SINK, (char*)lds + RING_OFF, WV); } } PHASE_END
    PHASE_BEGIN GEMM_PHASE(pg8::EpiPlain, pg8::StaticOrder, ws + BIG_O, ws + W_WAOUT, 1024, 1024, SO_INIT(1024), AY, 1024, 4, 0) PHASE_END
    PHASE_BEGIN resid_phase<1, true, false, true>(ws, args.out, nullptr, nullptr, ldsl, AY, 1, 0, 1, 1, 0, G, WV); PHASE_END
    MOE_FFN(0)
    PHASE_BEGIN resid_phase<2, false, false, (PROJ_FP8 & 1) != 0>(ws, args.out, nullptr, nullptr, ldsl, AY, 1, 1, 2, 0, 0, G, WV); PHASE_END

#if PROJ_FP8 & 1
    PHASE_BEGIN GEMM_PHASE8(FP8_GU, pg8::EpiRope1D, pg8::StaticOrder, (unsigned char*)args.out + A8_OFF, ws + W_RETIN, 6144, 512, SO_INIT(6144), (bf16*)(ws + BIG_RQ), 6144, 8, r1c, r1s) PHASE_END
#else
    PHASE_BEGIN GEMM_PHASE(pg8::EpiRope1D, pg8::StaticOrder, AY, ws + W_RETIN, 6144, 1024, SO_INIT(6144), (bf16*)(ws + BIG_RQ), 6144, 8, r1c, r1s) PHASE_END
#endif
    PHASE_BEGIN { for (int L = blockIdx.x; L < 256; L += G) ret::ret_unit2((const bf16*)(ws + BIG_RQ), (bf16*)(ws + BIG_RO), (bf16*)args.out, (bf16*)(ws + WS_OBC), (const float*)(ws + WS_SMALL) + SM_DECAY, L >> 4, (L >> 2) & 3, (L >> 1) & 1, L & 1, (char*)lds + RING_OFF, WV); } PHASE_END
    PHASE_BEGIN ret::ret_finish2((const bf16*)(ws + BIG_RQ), (bf16*)(ws + BIG_RO), (const bf16*)args.out, (const bf16*)(ws + WS_OBC), RETOUT_FP8 ? ws + WS_RO8 : nullptr, G, WV); PHASE_END
#if RETOUT_FP8
    PHASE_BEGIN GEMM_PHASE8(FP8_AO, pg8::EpiPlain, pg8::StaticOrder, ws + WS_RO8, ws + W_RETOUT, 1024, 1024, SO_INIT(1024), AY, 1024, 4, 0) PHASE_END
#else
    PHASE_BEGIN GEMM_PHASE(pg8::EpiPlain, pg8::StaticOrder, ws + BIG_RO, ws + W_RETOUT, 1024, 2048, SO_INIT(1024), AY, 1024, 4, 0) PHASE_END
#endif
    PHASE_BEGIN resid_phase<1, false, false, (DENSE_FP8 & 2) != 0>(ws, args.out, nullptr, nullptr, ldsl, AY, 2, 0, 2, 1, 0, G, WV); PHASE_END
#if DENSE_FP8 & 2
    DENSE_FFN8(1)
#else
    DENSE_FFN(1)
#endif
    PHASE_BEGIN resid_phase<1, false, false, (PROJ_FP8 & 4) != 0>(ws, args.out, nullptr, nullptr, ldsl, AY, 2, 1, 3, 0, 0, G, WV); PHASE_END

#if PROJ_FP8 & 4
    DA_INPROJ8(1)
#else
    DA_INPROJ(1)
#endif
    DA_LAYER(1, 0.55605820f)
    PHASE_BEGIN resid_phase<1, true, false, true, true>(ws, args.out, nullptr, nullptr, ldsl, AY, 3, 0, 3, 1, 1, G, WV); PHASE_END
    MOE_FFN(1)
    PHASE_BEGIN resid_phase<2, false, true>(ws, args.out, nullptr, nullptr, ldsl, AY, 3, 1, 3, 0, 1, G, WV); PHASE_END
#undef PHASE_BEGIN
#undef PHASE_END
}
constexpr int N_PHASES = 33;

extern "C" void kernel_launch(void* const* d_in, const int* in_sizes, int n_in, void* d_out, int out_size, void* d_ws, size_t ws_size, hipStream_t stream) {
    static int grid = 0;
    if (grid == 0) {
        if (n_in != 22 || in_sizes[0] != NBATCH * SEQL * DM || out_size != NBATCH * SEQL * DM || ws_size < WS_END) {
            fprintf(stderr, "kernel_launch: shape mismatch (n_in %d, in0 %d, out %d, ws %zu; need ws >= %zu); nothing launched\n", n_in, n_in > 0 ? in_sizes[0] : -1, out_size, ws_size, (size_t)WS_END); grid = -1; return; }
        int dev = 0, cus = 0, per_cu = 0;
        if (hipGetDevice(&dev) != hipSuccess || hipDeviceGetAttribute(&cus, hipDeviceAttributeMultiprocessorCount, dev) != hipSuccess) { fprintf(stderr, "kernel_launch: device query failed\n"); grid = -1; return; }
        if (hipFuncSetAttribute((const void*)hybrid_fwd, hipFuncAttributeMaxDynamicSharedMemorySize, LDS_BYTES) != hipSuccess) { fprintf(stderr, "kernel_launch: hipFuncSetAttribute failed\n"); grid = -1; return; }
        if (hipOccupancyMaxActiveBlocksPerMultiprocessor(&per_cu, (const void*)hybrid_fwd, NWAVES * 64, LDS_BYTES) != hipSuccess || per_cu < 1) {
            fprintf(stderr, "kernel_launch: occupancy query reports %d workgroups per CU\n", per_cu); }
        (void)hipGetLastError();
        if ((long)cus * NWAVES * 40 < (long)TA) { fprintf(stderr, "kernel_launch: %d CUs are too few for the routing phase's per-wave row table; nothing launched\n", cus); grid = -1; return; }
        grid = cus;
        if (grid != 256) fprintf(stderr, "kernel_launch: note: %d CUs (built and tuned for 256)\n", grid);
    }
    if (grid < 0) return;
    if (hipMemsetAsync((char*)d_ws + WS_CTL, 0, CTL_ZERO_BYTES, stream) != hipSuccess) { fprintf(stderr, "kernel_launch: memset failed\n"); return; }
    Args a{};
    for (int i = 0; i < 22; ++i) a.in[i] = (const float*)d_in[i];
    a.out = (float*)d_out; a.ws = (unsigned char*)d_ws;
#if MK_MULTI
    for (int p = 0; p < N_PHASES; ++p) { a.ph_lo = p; a.ph_hi = p + 1; hipLaunchKernelGGL(hybrid_fwd, dim3(grid), dim3(NWAVES * 64), LDS_BYTES, stream, a); }
#else
    a.ph_lo = 0; a.ph_hi = N_PHASES;
    hipLaunchKernelGGL(hybrid_fwd, dim3(grid), dim3(NWAVES * 64), LDS_BYTES, stream, a);
#endif
    const hipError_t le = hipPeekAtLastError();
    if (le != hipSuccess) fprintf(stderr, "kernel_launch: launch failed: %s\n", hipGetErrorName(le));
}
```
